# Optimizing an MI355X kernel written in HIP

```python
import math
import jax, jax.numpy as jnp
from jax import lax
import numpy as np

D_MODEL = 2048
BATCH = 1
SEQ = 8192
DEPTH = 1
DEC_BATCH = 4
DEC_SEQ = 8192
PAST_LEN = 128

N_HEADS = 16
QK_NOPE_DIM = 128
QK_ROPE_DIM = 64
V_HEAD_DIM = 128
Q_LORA_RANK = 512
KV_LORA_RANK = 512
ROPE_BASE = 10000.0
Q_BLOCK = 128
LRU_WIDTH = D_MODEL
LRU_BLOCKS = 16
LRU_BLOCK_W = LRU_WIDTH // LRU_BLOCKS
CONV_WIDTH = 4
CONV_LEFT = 2
LRU_C = 8.0
D_FF = ((8 * D_MODEL // 3 + 255) // 256) * 256
RMS_EPS = 1e-6
N_IN = Q_LORA_RANK + KV_LORA_RANK + QK_ROPE_DIM + 2 * LRU_WIDTH + 2 * D_MODEL
SPLIT_POINTS = tuple(int(v) for v in np.cumsum(
    [Q_LORA_RANK, KV_LORA_RANK, QK_ROPE_DIM, LRU_WIDTH, LRU_WIDTH]))

kernel_name = "hybrid_mla_rglru_macaron_encoder"


def rms_norm(x, g):
    xf = x.astype(jnp.float32)
    y = xf * lax.rsqrt(jnp.mean(xf * xf, axis=-1, keepdims=True) + RMS_EPS)
    return (y * g.astype(jnp.float32)).astype(x.dtype)


def swiglu_ffn(x, g, w_gate, w_up, w_down):
    h = rms_norm(x, g)
    return (jax.nn.silu(h @ w_gate) * (h @ w_up)) @ w_down


def rope_tables(seq_len, dtype):
    pos = jnp.arange(seq_len, dtype=jnp.float32)
    inv_freq = ROPE_BASE ** (-jnp.arange(0, QK_ROPE_DIM, 2, dtype=jnp.float32) / QK_ROPE_DIM)
    ang = pos[:, None] * inv_freq[None, :]
    return jnp.cos(ang).astype(dtype), jnp.sin(ang).astype(dtype)


def apply_rope(x, cos, sin):
    half = QK_ROPE_DIM // 2
    x1, x2 = x[..., :half], x[..., half:]
    return jnp.concatenate([x1 * cos - x2 * sin, x2 * cos + x1 * sin], axis=-1)


def mla_attention(q_nope, q_pe, k_nope, k_pe, v):
    B, S = q_nope.shape[0], q_nope.shape[1]
    nq = S // Q_BLOCK
    scale = (QK_NOPE_DIM + QK_ROPE_DIM) ** -0.5
    qn = q_nope.reshape(B, nq, Q_BLOCK, N_HEADS, QK_NOPE_DIM).transpose(1, 0, 2, 3, 4)
    qp = q_pe.reshape(B, nq, Q_BLOCK, N_HEADS, QK_ROPE_DIM).transpose(1, 0, 2, 3, 4)

    def block(args):
        qn_b, qp_b = args
        s = (jnp.einsum('bqhd,bkhd->bhqk', qn_b, k_nope)
             + jnp.einsum('bqhr,bkr->bhqk', qp_b, k_pe)).astype(jnp.float32) * scale
        p = jax.nn.softmax(s, axis=-1).astype(v.dtype)
        return jnp.einsum('bhqk,bkhd->bqhd', p, v)

    o = lax.map(block, (qn, qp))
    return o.transpose(1, 0, 2, 3, 4).reshape(B, S, N_HEADS * V_HEAD_DIM)


def centred_depthwise_conv(x, w, b):
    S = x.shape[1]
    xp = jnp.pad(x, ((0, 0), (CONV_LEFT, CONV_WIDTH - 1 - CONV_LEFT), (0, 0)))
    y = b
    for k in range(CONV_WIDTH):
        y = y + xp[:, k:k + S] * w[k]
    return y


def _lin_combine(e1, e2):
    a1, b1 = e1
    a2, b2 = e2
    return a1 * a2, a2 * b1 + b2


def rglru_direction(xc, w_a, b_a, w_i, b_i, lam, reverse):
    B, S, W = xc.shape
    xb = xc.reshape(B, S, LRU_BLOCKS, LRU_BLOCK_W)
    r = jax.nn.sigmoid((jnp.einsum('bsnk,nkj->bsnj', xb, w_a).reshape(B, S, W) + b_a).astype(jnp.float32))
    i = jax.nn.sigmoid((jnp.einsum('bsnk,nkj->bsnj', xb, w_i).reshape(B, S, W) + b_i).astype(jnp.float32))
    log_a = -LRU_C * r * jax.nn.softplus(-lam.astype(jnp.float32))
    a = jnp.exp(log_a)
    u = jnp.sqrt(-jnp.expm1(2.0 * log_a)) * (i * xc.astype(jnp.float32))
    _, h = lax.associative_scan(_lin_combine, (a, u), axis=1, reverse=reverse)
    return h


def gated_parallel_mixer(x, mix_norm, w_in, q_norm, w_uq, kv_norm, w_ukv, w_o_attn,
                         conv_w, conv_b, rg_w_a, rg_b_a, rg_w_i, rg_b_i, rg_lambda,
                         w_o_rec, w_out):
    B, S, _ = x.shape
    h = rms_norm(x, mix_norm)
    proj = h @ w_in
    c_q, c_kv, k_pe, x_rec, g_rec, gates = jnp.split(proj, SPLIT_POINTS, axis=-1)

    q = (rms_norm(c_q, q_norm) @ w_uq).reshape(B, S, N_HEADS, QK_NOPE_DIM + QK_ROPE_DIM)
    q_nope, q_pe = q[..., :QK_NOPE_DIM], q[..., QK_NOPE_DIM:]
    kv = (rms_norm(c_kv, kv_norm) @ w_ukv).reshape(B, S, N_HEADS, QK_NOPE_DIM + V_HEAD_DIM)
    k_nope, v = kv[..., :QK_NOPE_DIM], kv[..., QK_NOPE_DIM:]
    cos, sin = rope_tables(S, x.dtype)
    q_pe = apply_rope(q_pe, cos[:, None, :], sin[:, None, :])
    k_pe = apply_rope(k_pe, cos, sin)
    y_attn = mla_attention(q_nope, q_pe, k_nope, k_pe, v) @ w_o_attn

    xc = centred_depthwise_conv(x_rec, conv_w, conv_b)
    h_rec = (rglru_direction(xc, rg_w_a[0], rg_b_a[0], rg_w_i[0], rg_b_i[0], rg_lambda[0], False)
             + rglru_direction(xc, rg_w_a[1], rg_b_a[1], rg_w_i[1], rg_b_i[1], rg_lambda[1], True))
    y_rec = (jax.nn.gelu(g_rec) * h_rec.astype(x.dtype)) @ w_o_rec

    g_attn, g_r = jnp.split(jax.nn.sigmoid(gates), 2, axis=-1)
    return (g_attn * y_attn + g_r * y_rec) @ w_out


def encoder(x, ffn1_norm, ffn1_w_gate, ffn1_w_up, ffn1_w_down,
            mix_norm, w_in, q_norm, w_uq, kv_norm, w_ukv, w_o_attn,
            conv_w, conv_b, rg_w_a, rg_b_a, rg_w_i, rg_b_i, rg_lambda, w_o_rec, w_out,
            ffn2_norm, ffn2_w_gate, ffn2_w_up, ffn2_w_down, final_norm):
    for l in range(DEPTH):
        x = x + 0.5 * swiglu_ffn(x, ffn1_norm[l], ffn1_w_gate[l], ffn1_w_up[l], ffn1_w_down[l])
        x = x + gated_parallel_mixer(
            x, mix_norm[l], w_in[l], q_norm[l], w_uq[l], kv_norm[l], w_ukv[l], w_o_attn[l],
            conv_w[l], conv_b[l], rg_w_a[l], rg_b_a[l], rg_w_i[l], rg_b_i[l], rg_lambda[l],
            w_o_rec[l], w_out[l])
        x = x + 0.5 * swiglu_ffn(x, ffn2_norm[l], ffn2_w_gate[l], ffn2_w_up[l], ffn2_w_down[l])
    return rms_norm(x, final_norm)


def setup_inputs(seed: int = 0) -> dict:
    key = jax.random.key(seed)
    ks = jax.random.split(key, 32)
    f32 = jnp.float32

    def nrm(k, shape, fan_in):
        return jax.random.normal(k, shape, f32) * (fan_in ** -0.5)

    def gain(k, shape):
        return 1.0 + 0.02 * jax.random.normal(k, shape, f32)

    def bias(k, shape):
        return 0.02 * jax.random.normal(k, shape, f32)

    L = DEPTH
    u = jax.random.uniform(ks[20], (L, 2, LRU_WIDTH), f32, minval=0.9, maxval=0.999)
    s = u ** (1.0 / LRU_C)
    rg_lambda = jnp.log(s) - jnp.log1p(-s)
    return {
        "x_prompt": jax.random.normal(ks[0], (BATCH, SEQ, D_MODEL), f32),
        "x_sample": jax.random.normal(ks[1], (DEC_BATCH, DEC_SEQ, D_MODEL), f32),
        "ffn1_norm": gain(ks[2], (L, D_MODEL)),
        "ffn1_w_gate": nrm(ks[3], (L, D_MODEL, D_FF), D_MODEL),
        "ffn1_w_up": nrm(ks[4], (L, D_MODEL, D_FF), D_MODEL),
        "ffn1_w_down": nrm(ks[5], (L, D_FF, D_MODEL), D_FF),
        "mix_norm": gain(ks[6], (L, D_MODEL)),
        "w_in": nrm(ks[7], (L, D_MODEL, N_IN), D_MODEL),
        "q_norm": gain(ks[8], (L, Q_LORA_RANK)),
        "w_uq": nrm(ks[9], (L, Q_LORA_RANK, N_HEADS * (QK_NOPE_DIM + QK_ROPE_DIM)), Q_LORA_RANK),
        "kv_norm": gain(ks[10], (L, KV_LORA_RANK)),
        "w_ukv": nrm(ks[11], (L, KV_LORA_RANK, N_HEADS * (QK_NOPE_DIM + V_HEAD_DIM)), KV_LORA_RANK),
        "w_o_attn": nrm(ks[12], (L, N_HEADS * V_HEAD_DIM, D_MODEL), N_HEADS * V_HEAD_DIM),
        "conv_w": nrm(ks[13], (L, CONV_WIDTH, LRU_WIDTH), CONV_WIDTH),
        "conv_b": bias(ks[14], (L, LRU_WIDTH)),
        "rg_w_a": nrm(ks[15], (L, 2, LRU_BLOCKS, LRU_BLOCK_W, LRU_BLOCK_W), LRU_BLOCK_W),
        "rg_b_a": bias(ks[16], (L, 2, LRU_WIDTH)),
        "rg_w_i": nrm(ks[17], (L, 2, LRU_BLOCKS, LRU_BLOCK_W, LRU_BLOCK_W), LRU_BLOCK_W),
        "rg_b_i": bias(ks[18], (L, 2, LRU_WIDTH)),
        "rg_lambda": rg_lambda,
        "w_o_rec": nrm(ks[19], (L, LRU_WIDTH, D_MODEL), LRU_WIDTH),
        "w_out": nrm(ks[21], (L, D_MODEL, D_MODEL), D_MODEL),
        "ffn2_norm": gain(ks[22], (L, D_MODEL)),
        "ffn2_w_gate": nrm(ks[23], (L, D_MODEL, D_FF), D_MODEL),
        "ffn2_w_up": nrm(ks[24], (L, D_MODEL, D_FF), D_MODEL),
        "ffn2_w_down": nrm(ks[25], (L, D_FF, D_MODEL), D_FF),
        "final_norm": gain(ks[26], (D_MODEL,)),
    }


def reference(x_prompt, x_sample, ffn1_norm, ffn1_w_gate, ffn1_w_up, ffn1_w_down,
              mix_norm, w_in, q_norm, w_uq, kv_norm, w_ukv, w_o_attn,
              conv_w, conv_b, rg_w_a, rg_b_a, rg_w_i, rg_b_i, rg_lambda, w_o_rec, w_out,
              ffn2_norm, ffn2_w_gate, ffn2_w_up, ffn2_w_down, final_norm):
    y_prompt = encoder(x_prompt, ffn1_norm, ffn1_w_gate, ffn1_w_up, ffn1_w_down,
                       mix_norm, w_in, q_norm, w_uq, kv_norm, w_ukv, w_o_attn,
                       conv_w, conv_b, rg_w_a, rg_b_a, rg_w_i, rg_b_i, rg_lambda, w_o_rec, w_out,
                       ffn2_norm, ffn2_w_gate, ffn2_w_up, ffn2_w_down, final_norm)
    y_sample = encoder(x_sample, ffn1_norm, ffn1_w_gate, ffn1_w_up, ffn1_w_down,
                       mix_norm, w_in, q_norm, w_uq, kv_norm, w_ukv, w_o_attn,
                       conv_w, conv_b, rg_w_a, rg_b_a, rg_w_i, rg_b_i, rg_lambda, w_o_rec, w_out,
                       ffn2_norm, ffn2_w_gate, ffn2_w_up, ffn2_w_down, final_norm)
    return (y_prompt, y_sample)
```

```cpp
#include <hip/hip_runtime.h>
#include <hip/hip_cooperative_groups.h>
#include <cstdio>
#include <cstdint>
namespace cg = cooperative_groups;

#ifndef MK_ONE_LAUNCH
#define MK_ONE_LAUNCH 1
#endif
#ifndef PH_MASK
#define PH_MASK 0xffffffffu
#endif
#define PHM(k) (((PH_MASK) >> (k)) & 1u)
#define LAUNDER_IDS int tidx_ = wv_ * 64 + (int)__builtin_amdgcn_mbcnt_hi(~0u, __builtin_amdgcn_mbcnt_lo(~0u, 0u)), bidx_ = blockIdx.x; asm volatile("" : "+v"(tidx_), "+s"(bidx_))

#define LAS __attribute__((address_space(3)))
typedef unsigned short bf16_t;
typedef short bf16x8 __attribute__((ext_vector_type(8)));
typedef short s16x4 __attribute__((ext_vector_type(4)));
typedef float f32x4 __attribute__((ext_vector_type(4)));
typedef float f32x2 __attribute__((ext_vector_type(2)));
typedef float f32x16 __attribute__((ext_vector_type(16)));
typedef unsigned u32x4 __attribute__((ext_vector_type(4)));
typedef unsigned u32x2 __attribute__((ext_vector_type(2)));

constexpr int DM = 2048, SEQ = 8192, NSEQ = 5, MTOT = NSEQ * SEQ, DFF = 5632;
constexpr int NIN = 9280, NINP = 9472;
constexpr int NQ = 3072, NKV = 4096;
constexpr int C_CQ = 0, C_CKV = 512, C_KPE = 1024, C_XREC = 1088, C_GREC = 3136, C_GA = 5184, C_GR = 7232;
constexpr float RMS_EPS = 1e-6f;
constexpr float QSCALE = 0.07216878364870322f * 1.4426950408889634f;

constexpr size_t MiB = 1u << 20;
constexpr size_t WS_COS = 0, WS_SIN = 1 * MiB, WS_C8 = 2 * MiB, WS_CTL = 3 * MiB, CTL_BYTES = 16384;
constexpr size_t WS_W1GU = 4 * MiB, WS_W1D = 48 * MiB, WS_W2GU = 70 * MiB, WS_W2D = 114 * MiB, WS_WIN = 136 * MiB, WS_WUQ = 173 * MiB,
                 WS_WUKV = 176 * MiB, WS_WOA = 180 * MiB, WS_WOR = 188 * MiB, WS_WOUT = 196 * MiB, WS_WG = 204 * MiB;
constexpr size_t WS_H = 206 * MiB, WS_ACT = 366 * MiB;
constexpr size_t WS_PROJ = 366 * MiB, WS_CQN = 514 * MiB, WS_CKVN = 522 * MiB, WS_KPE = 530 * MiB, WS_XC = 532 * MiB, WS_MERGED = 532 * MiB,
                 WS_Q = 564 * MiB, WS_KV = 612 * MiB, WS_T1 = 564 * MiB, WS_AF = 676 * MiB, WS_UF = 740 * MiB, WS_AB = 804 * MiB, WS_UB = 868 * MiB,
                 WS_ATTO = 932 * MiB, WS_YG = 964 * MiB, WS_AGGA = 996 * MiB, WS_AGGB = 1000 * MiB, WS_CARRY = 1004 * MiB, WS_END = 1008 * MiB;

constexpr int LDS_BYTES = 135168;
constexpr int NPH = 44;

__device__ __forceinline__ float bf2f(unsigned b) { return __uint_as_float(b << 16); }
__device__ __forceinline__ unsigned cvt_pk_bf16(float lo, float hi) { unsigned r; asm volatile("v_cvt_pk_bf16_f32 %0, %1, %2" : "=v"(r) : "v"(lo), "v"(hi)); return r; }
__device__ __forceinline__ float fsigmoid(float x) { return __builtin_amdgcn_rcpf(1.0f + __expf(-x)); }
__device__ __forceinline__ float wave_sum(float v) {
    v += __int_as_float(__builtin_amdgcn_ds_swizzle(__float_as_int(v), 0x041f));
    v += __int_as_float(__builtin_amdgcn_ds_swizzle(__float_as_int(v), 0x081f));
    v += __int_as_float(__builtin_amdgcn_ds_swizzle(__float_as_int(v), 0x101f));
    v += __int_as_float(__builtin_amdgcn_ds_swizzle(__float_as_int(v), 0x201f));
    v += __int_as_float(__builtin_amdgcn_ds_swizzle(__float_as_int(v), 0x401f));
    auto rr = __builtin_amdgcn_permlane32_swap(__float_as_uint(v), __float_as_uint(v), false, false);
    return __uint_as_float(rr[0]) + __uint_as_float(rr[1]);
}
__device__ __forceinline__ float gelu_tanh(float x) {
    const float z = 0.7978845608028654f * (x + 0.044715f * x * x * x);
    const float e = __expf(2.0f * z);
    const float t = 1.0f - 2.0f * __builtin_amdgcn_rcpf(1.0f + e);
    return 0.5f * x * (1.0f + t);
}

namespace pg8 {
constexpr int BM = 256, BK = 64, HALF = 128, HTB = HALF * BK * 2, STAGE_BYTES = 8 * HTB, NXCD = 8, WGM = 4;
__host__ __device__ __forceinline__ int lds_byte(int r, int c) { const int st = (r >> 4) * 2 + (c >> 5), rr = r & 15, cc = c & 31, ob = rr * 64 + cc * 2; return st * 1024 + (ob ^ (((ob >> 9) & 1) << 5)); }
__host__ __device__ __forceinline__ void stage_rc(int b, int& R, int& C) { const int st = b / 1024, sb = b % 1024, swz = sb ^ (((sb >> 9) & 1) << 5); R = (st >> 1) * 16 + swz / 64; C = (st & 1) * 32 + (swz % 64) / 2; }
__host__ __device__ __forceinline__ int perm32(int rho) { const int n = rho >> 4, i = rho & 15; return 8 * (i >> 2) + 4 * n + (i & 3); }

struct Unit { int pm, pn; };
struct Gemm { const bf16_t* A; const bf16_t* Bt; };

struct StaticOrder {
    int nM, nN, nwg, G, c;
    __device__ void init(int M, int N, int G_, int c_) { nM = M / BM; nN = N / BM; nwg = nM * nN; G = G_; c = c_; }
    __device__ bool next(int i, Unit& u) const {
        const long L = (long)i * G + c; if (L >= nwg) return false;
        int wgid = (int)L; { const int q = nwg / NXCD, r = nwg % NXCD, xcd = wgid % NXCD, off = wgid / NXCD; wgid = (xcd < r ? xcd * (q + 1) : r * (q + 1) + (xcd - r) * q) + off; }
        const int nig = WGM * nN, gid = wgid / nig, fm = gid * WGM, gsz = (nM - fm) < WGM ? (nM - fm) : WGM;
        u.pm = fm + ((wgid % nig) % gsz); u.pn = (wgid % nig) / gsz; return true;
    }
};

template <class Epi, int GM, int GN, int GK, int LDA, int AMOD, int ASTRIDE>
__device__ __forceinline__ void gemm_phase(LAS unsigned char* lds, const Gemm g, const Epi& E, int wv_) {
    int tid_ = wv_ * 64 + (int)__builtin_amdgcn_mbcnt_hi(~0u, __builtin_amdgcn_mbcnt_lo(~0u, 0u)), bid_ = blockIdx.x; asm volatile("" : "+v"(tid_), "+s"(bid_));
    const int tid = tid_, wid = __builtin_amdgcn_readfirstlane(tid >> 6), lane = tid & 63, wr = wid >> 2, wc = wid & 3, fr = lane & 15, fq = lane >> 4;
    constexpr int K = GK, lda = LDA; int nt = K / BK; asm volatile("" : "+s"(nt));
    StaticOrder S; S.init(GM, GN, (int)gridDim.x, bid_);
    unsigned voffA[2], voffB[2];
#pragma unroll
    for (int i = 0; i < 2; ++i) { int R, C; stage_rc(tid * 16 + i * 8192, R, C); const int Rb = Epi::PERM ? ((R & ~31) + perm32(R & 31)) : R;
        voffA[i] = (unsigned)(R * lda + C) * 2u; voffB[i] = (unsigned)(Rb * K + C) * 2u; }
    const size_t kstep = (size_t)(BK * 2);
    const size_t hstepA = (size_t)HALF * lda * 2, tstepA = 2 * hstepA;
    const size_t hstepB = (size_t)HALF * K * 2, tstepB = 2 * hstepB;
    const unsigned ldsw = (unsigned)wid * 1024u;
    const int aoff = lds_byte(wr * 64 + fr, fq * 8), boff = lds_byte(wc * 32 + fr, fq * 8);
#define PG8_SA(b, h) (((b) * 2 + (h)) * HTB)
#define PG8_SB(b, h) ((4 + (b) * 2 + (h)) * HTB)
#define PG8_STAGE(bufoff, gbase, voff) do { _Pragma("unroll") for (int _i = 0; _i < 2; ++_i) \
        __builtin_amdgcn_global_load_lds((const unsigned*)((const char*)(gbase) + (voff)[_i]), (LAS unsigned*)(lds + (bufoff) + ldsw + _i * 8192), 16, 0, 0); } while (0)
#define PG8_LDA(dst, b, h) do { _Pragma("unroll") for (int m = 0; m < 4; ++m) _Pragma("unroll") for (int k = 0; k < 2; ++k) dst[m][k] = *(const LAS bf16x8*)(lds + PG8_SA(b, h) + aoff + m * 2048 + k * 1024); } while (0)
#define PG8_LDB(dst, b, h) do { _Pragma("unroll") for (int n = 0; n < 2; ++n) _Pragma("unroll") for (int k = 0; k < 2; ++k) dst[n][k] = *(const LAS bf16x8*)(lds + PG8_SB(b, h) + boff + n * 2048 + k * 1024); } while (0)
#define PG8_MMA(ai, bj, At, Bt) do { __builtin_amdgcn_s_setprio(1); _Pragma("unroll") for (int m = 0; m < 4; ++m) _Pragma("unroll") for (int n = 0; n < 2; ++n) _Pragma("unroll") for (int k = 0; k < 2; ++k) \
        acc[ai][bj][m][n] = __builtin_amdgcn_mfma_f32_16x16x32_bf16(Bt[n][k], At[m][k], acc[ai][bj][m][n], 0, 0, 0); __builtin_amdgcn_s_setprio(0); } while (0)
#define PG8_WAIT_V(n) asm volatile("s_waitcnt vmcnt(" #n ")" ::: "memory")
#define PG8_WAIT_L(n) asm volatile("s_waitcnt lgkmcnt(" #n ")" ::: "memory")
#define PG8_BAR __builtin_amdgcn_s_barrier()
#define PG8_SCHED __builtin_amdgcn_sched_barrier(0)
#define PG8_AOFF(pn) (AMOD ? (size_t)((pn) % (AMOD ? AMOD : 1)) * (size_t)ASTRIDE * 2 : (size_t)0)
    Unit cur, nxt; int ui = 0;
    if (!S.next(0, cur)) return;
    f32x4 acc[2][2][4][2];
#pragma unroll
    for (int a = 0; a < 2; ++a)
#pragma unroll
        for (int b = 0; b < 2; ++b)
#pragma unroll
            for (int m = 0; m < 4; ++m)
#pragma unroll
                for (int n = 0; n < 2; ++n) acc[a][b][m][n] = (f32x4){0.f, 0.f, 0.f, 0.f};
    bf16x8 At[4][2], B0[2][2], B1[2][2];
    const char* cA = (const char*)g.A + (size_t)cur.pm * tstepA + PG8_AOFF(cur.pn); const char* cB = (const char*)g.Bt + (size_t)cur.pn * tstepB;
    PG8_STAGE(PG8_SB(0, 0), cB, voffB); PG8_STAGE(PG8_SB(0, 1), cB + hstepB, voffB); PG8_STAGE(PG8_SA(0, 0), cA, voffA); PG8_STAGE(PG8_SA(0, 1), cA + hstepA, voffA);
    if (wr == 1) PG8_BAR;
    PG8_WAIT_V(2); PG8_BAR;
    PG8_STAGE(PG8_SB(1, 0), cB + kstep, voffB); PG8_STAGE(PG8_SA(1, 0), cA + kstep, voffA); PG8_STAGE(PG8_SB(1, 1), cB + hstepB + kstep, voffB);
    PG8_WAIT_V(6); PG8_BAR;
    for (;;) {
        const bool has_next = S.next(ui + 1, nxt);
        const char* nA = has_next ? (const char*)g.A + (size_t)nxt.pm * tstepA + PG8_AOFF(nxt.pn) : cA; const char* nB = has_next ? (const char*)g.Bt + (size_t)nxt.pn * tstepB : cB;
        for (int t = 0; t < nt; t += 2) {
            const bool last = (t == nt - 2);
            const char* a1 = cA + (size_t)(t + 1) * kstep;
            const char* a2 = last ? nA : cA + (size_t)(t + 2) * kstep; const char* b2 = last ? nB : cB + (size_t)(t + 2) * kstep;
            const char* a3 = a2 + kstep; const char* b3 = b2 + kstep;
            PG8_LDB(B0, 0, 0); PG8_LDB(B1, 0, 1); PG8_SCHED; PG8_LDA(At, 0, 0); PG8_STAGE(PG8_SA(1, 1), a1 + hstepA, voffA);
            PG8_WAIT_V(8); PG8_WAIT_L(0); PG8_BAR; PG8_MMA(0, 0, At, B0); PG8_MMA(0, 1, At, B1); PG8_BAR; PG8_SCHED;
            PG8_LDA(At, 0, 1); PG8_STAGE(PG8_SB(0, 0), b2, voffB); PG8_STAGE(PG8_SB(0, 1), b2 + hstepB, voffB); PG8_STAGE(PG8_SA(0, 0), a2, voffA);
            PG8_WAIT_V(8); PG8_WAIT_L(0); PG8_BAR; PG8_MMA(1, 0, At, B0); PG8_MMA(1, 1, At, B1); PG8_BAR; PG8_SCHED;
            PG8_LDB(B0, 1, 0); PG8_LDB(B1, 1, 1); PG8_SCHED; PG8_LDA(At, 1, 0); PG8_STAGE(PG8_SA(0, 1), a2 + hstepA, voffA);
            PG8_WAIT_V(8); PG8_WAIT_L(0); PG8_BAR; PG8_MMA(0, 0, At, B0); PG8_MMA(0, 1, At, B1); PG8_BAR; PG8_SCHED;
            PG8_LDA(At, 1, 1); PG8_STAGE(PG8_SB(1, 0), b3, voffB); PG8_STAGE(PG8_SB(1, 1), b3 + hstepB, voffB); PG8_STAGE(PG8_SA(1, 0), a3, voffA);
            PG8_WAIT_V(8); PG8_WAIT_L(0); PG8_BAR; PG8_MMA(1, 0, At, B0); PG8_MMA(1, 1, At, B1); PG8_BAR; PG8_SCHED;
        }
        if (wr == 0) PG8_BAR;
        { int fr2 = fr, fq2 = fq; asm volatile("" : "+v"(fr2), "+v"(fq2)); E(acc, cur, wr, wc, fr2, fq2); }
        if (!has_next) break;
#pragma unroll
        for (int a = 0; a < 2; ++a)
#pragma unroll
            for (int b = 0; b < 2; ++b)
#pragma unroll
                for (int m = 0; m < 4; ++m)
#pragma unroll
                    for (int n = 0; n < 2; ++n) acc[a][b][m][n] = (f32x4){0.f, 0.f, 0.f, 0.f};
        cur = nxt; cA = nA; cB = nB; ++ui;
        if (wr == 1) PG8_BAR;
    }
    PG8_WAIT_V(0);
    PG8_BAR;
#undef PG8_SA
#undef PG8_SB
#undef PG8_STAGE
#undef PG8_LDA
#undef PG8_LDB
#undef PG8_MMA
#undef PG8_WAIT_V
#undef PG8_WAIT_L
#undef PG8_BAR
#undef PG8_SCHED
#undef PG8_AOFF
}

typedef f32x4 Acc[2][2][4][2];

struct EpiBf16 {
    static constexpr bool PERM = true;
    bf16_t* O; int ldc;
    __device__ __forceinline__ void operator()(const Acc& acc, const Unit& u, int wr, int wc, int fr, int fq) const {
        const int row0 = u.pm * BM + wr * 64 + fr, col0 = u.pn * BM + wc * 32 + 8 * fq;
#pragma unroll
        for (int ai = 0; ai < 2; ++ai)
#pragma unroll
            for (int m = 0; m < 4; ++m) { bf16_t* rowp = O + (size_t)(row0 + ai * HALF + m * 16) * ldc + col0;
#pragma unroll
                for (int bj = 0; bj < 2; ++bj) { const f32x4 v0 = acc[ai][bj][m][0], v1 = acc[ai][bj][m][1];
                    u32x4 w; w.x = cvt_pk_bf16(v0[0], v0[1]); w.y = cvt_pk_bf16(v0[2], v0[3]); w.z = cvt_pk_bf16(v1[0], v1[1]); w.w = cvt_pk_bf16(v1[2], v1[3]);
                    *(u32x4*)(rowp + bj * HALF) = w; } asm volatile("" ::: "memory"); }
    }
};
struct EpiSwiglu {
    static constexpr bool PERM = true;
    bf16_t* O; int ldc;
    __device__ __forceinline__ void operator()(const Acc& acc, const Unit& u, int wr, int wc, int fr, int fq) const {
        const int row0 = u.pm * BM + wr * 64 + fr, col0 = u.pn * HALF + wc * 32 + 8 * fq;
#pragma unroll
        for (int ai = 0; ai < 2; ++ai)
#pragma unroll
            for (int m = 0; m < 4; ++m) { bf16_t* rowp = O + (size_t)(row0 + ai * HALF + m * 16) * ldc + col0;
                float r[8];
#pragma unroll
                for (int n = 0; n < 2; ++n)
#pragma unroll
                    for (int j = 0; j < 4; ++j) { const float gv = acc[ai][0][m][n][j], uv = acc[ai][1][m][n][j]; r[n * 4 + j] = gv * fsigmoid(gv) * uv; }
                u32x4 w; w.x = cvt_pk_bf16(r[0], r[1]); w.y = cvt_pk_bf16(r[2], r[3]); w.z = cvt_pk_bf16(r[4], r[5]); w.w = cvt_pk_bf16(r[6], r[7]);
                *(u32x4*)rowp = w; asm volatile("" ::: "memory"); }
    }
};
struct EpiResid {
    static constexpr bool PERM = false;
    const float* res0; const float* res1; int split; float* out; float alpha; int row_base;
    __device__ __forceinline__ void operator()(const Acc& acc, const Unit& u, int wr, int wc, int fr, int fq) const {
        const int grow0 = row_base + u.pm * BM; const float* rb = grow0 < split ? res0 + (size_t)grow0 * DM : res1 + (size_t)(grow0 - split) * DM;
        float* ob = out + (size_t)grow0 * DM; const int col0 = u.pn * BM + wc * 32 + 4 * fq;
#pragma unroll
        for (int ai = 0; ai < 2; ++ai)
#pragma unroll
            for (int m = 0; m < 4; ++m) { const size_t off = (size_t)(ai * HALF + wr * 64 + m * 16 + fr) * DM + col0;
#pragma unroll
                for (int bj = 0; bj < 2; ++bj)
#pragma unroll
                    for (int n = 0; n < 2; ++n) { const f32x4 bs = *(const f32x4*)(rb + off + bj * HALF + n * 16); *(f32x4*)(ob + off + bj * HALF + n * 16) = bs + acc[ai][bj][m][n] * alpha; } asm volatile("" ::: "memory"); }
    }
};
struct EpiQ {
    static constexpr bool PERM = true;
    bf16_t* O; const float* cosT; const float* sinT;
    __device__ __forceinline__ void operator()(const Acc& acc, const Unit& u, int wr, int wc, int fr, int fq) const {
        const int row0 = u.pm * BM + wr * 64 + fr;
#pragma unroll
        for (int bj = 0; bj < 2; ++bj) { const int col0 = u.pn * BM + bj * HALF + wc * 32 + 8 * fq; const int d = col0 % 192; const bool rope = d >= 128; const int jp0 = (d - 128) >> 1;
#pragma unroll
            for (int ai = 0; ai < 2; ++ai)
#pragma unroll
                for (int m = 0; m < 4; ++m) { const int row = row0 + ai * HALF + m * 16; f32x4 v0 = acc[ai][bj][m][0], v1 = acc[ai][bj][m][1];
                    if (rope) { const f32x4 c = *(const f32x4*)(cosT + (size_t)row * 32 + jp0), s = *(const f32x4*)(sinT + (size_t)row * 32 + jp0);
                        const f32x4 a0 = v0, a1 = v1;
                        v0[0] = a0[0] * c[0] - a0[1] * s[0]; v0[1] = a0[1] * c[0] + a0[0] * s[0]; v0[2] = a0[2] * c[1] - a0[3] * s[1]; v0[3] = a0[3] * c[1] + a0[2] * s[1];
                        v1[0] = a1[0] * c[2] - a1[1] * s[2]; v1[1] = a1[1] * c[2] + a1[0] * s[2]; v1[2] = a1[2] * c[3] - a1[3] * s[3]; v1[3] = a1[3] * c[3] + a1[2] * s[3]; }
                    v0 = v0 * QSCALE; v1 = v1 * QSCALE;
                    u32x4 w; w.x = cvt_pk_bf16(v0[0], v0[1]); w.y = cvt_pk_bf16(v0[2], v0[3]); w.z = cvt_pk_bf16(v1[0], v1[1]); w.w = cvt_pk_bf16(v1[2], v1[3]);
                    *(u32x4*)(O + (size_t)row * NQ + col0) = w; asm volatile("" ::: "memory"); } }
    }
};
struct EpiGates {
    static constexpr bool PERM = true;
    const bf16_t* xc; const float* b_a; const float* b_i; const float* c8; bf16_t* Aout; bf16_t* Uout; size_t dir_stride;
    __device__ __forceinline__ void operator()(const Acc& acc, const Unit& u, int wr, int wc, int fr, int fq) const {
        const int dir = u.pn >> 4, blk = u.pn & 15; const int row0 = u.pm * BM + wr * 64 + fr; const int ch0 = blk * HALF + wc * 32 + 8 * fq;
        bf16_t* Ao = Aout + (size_t)dir * dir_stride; bf16_t* Uo = Uout + (size_t)dir * dir_stride;
        f32x4 ba[2], bi[2], cc[2];
#pragma unroll
        for (int n = 0; n < 2; ++n) { ba[n] = *(const f32x4*)(b_a + dir * DM + ch0 + 4 * n); bi[n] = *(const f32x4*)(b_i + dir * DM + ch0 + 4 * n); cc[n] = *(const f32x4*)(c8 + dir * DM + ch0 + 4 * n); }
#pragma unroll
        for (int ai = 0; ai < 2; ++ai)
#pragma unroll
            for (int m = 0; m < 4; ++m) { const int row = row0 + ai * HALF + m * 16; const size_t off = (size_t)row * DM + ch0;
                const u32x4 xw = *(const u32x4*)(xc + off);
                const float xv[8] = {bf2f(xw.x & 0xffffu), bf2f(xw.x >> 16), bf2f(xw.y & 0xffffu), bf2f(xw.y >> 16), bf2f(xw.z & 0xffffu), bf2f(xw.z >> 16), bf2f(xw.w & 0xffffu), bf2f(xw.w >> 16)};
                float om[8], uv[8];
#pragma unroll
                for (int n = 0; n < 2; ++n)
#pragma unroll
                    for (int j = 0; j < 4; ++j) { const float r = fsigmoid(acc[ai][0][m][n][j] + ba[n][j]), ig = fsigmoid(acc[ai][1][m][n][j] + bi[n][j]);
                        const float y = r * cc[n][j];
                        float o1 = y * (1.0f - y * (0.5f - y * (0.16666667f - y * (0.041666668f - y * 0.008333334f))));
                        if (__builtin_expect(__any(y >= 0.125f), 0)) { const float ome = 1.0f - __expf(-y); o1 = y < 0.125f ? o1 : ome; }
                        om[n * 4 + j] = o1; uv[n * 4 + j] = sqrtf(o1 * (2.0f - o1)) * (ig * xv[n * 4 + j]); }
                u32x4 wa, wu; wa.x = cvt_pk_bf16(om[0], om[1]); wa.y = cvt_pk_bf16(om[2], om[3]); wa.z = cvt_pk_bf16(om[4], om[5]); wa.w = cvt_pk_bf16(om[6], om[7]);
                wu.x = cvt_pk_bf16(uv[0], uv[1]); wu.y = cvt_pk_bf16(uv[2], uv[3]); wu.z = cvt_pk_bf16(uv[4], uv[5]); wu.w = cvt_pk_bf16(uv[6], uv[7]);
                *(u32x4*)(Ao + off) = wa; *(u32x4*)(Uo + off) = wu; asm volatile("" ::: "memory"); }
    }
};
struct EpiT1 {
    static constexpr bool PERM = true;
    const bf16_t* gate; int ldg; bf16_t* O;
    __device__ __forceinline__ void operator()(const Acc& acc, const Unit& u, int wr, int wc, int fr, int fq) const {
        const int row0 = u.pm * BM + wr * 64 + fr;
#pragma unroll
        for (int ai = 0; ai < 2; ++ai)
#pragma unroll
            for (int m = 0; m < 4; ++m) { const int row = row0 + ai * HALF + m * 16;
#pragma unroll
                for (int bj = 0; bj < 2; ++bj) { const int col0 = u.pn * BM + bj * HALF + wc * 32 + 8 * fq;
                    const u32x4 gw = *(const u32x4*)(gate + (size_t)row * ldg + col0); f32x4 v0 = acc[ai][bj][m][0], v1 = acc[ai][bj][m][1];
                    v0[0] *= fsigmoid(bf2f(gw.x & 0xffffu)); v0[1] *= fsigmoid(bf2f(gw.x >> 16)); v0[2] *= fsigmoid(bf2f(gw.y & 0xffffu)); v0[3] *= fsigmoid(bf2f(gw.y >> 16));
                    v1[0] *= fsigmoid(bf2f(gw.z & 0xffffu)); v1[1] *= fsigmoid(bf2f(gw.z >> 16)); v1[2] *= fsigmoid(bf2f(gw.w & 0xffffu)); v1[3] *= fsigmoid(bf2f(gw.w >> 16));
                    u32x4 w; w.x = cvt_pk_bf16(v0[0], v0[1]); w.y = cvt_pk_bf16(v0[2], v0[3]); w.z = cvt_pk_bf16(v1[0], v1[1]); w.w = cvt_pk_bf16(v1[2], v1[3]);
                    *(u32x4*)(O + (size_t)row * DM + col0) = w; } asm volatile("" ::: "memory"); }
    }
};
struct EpiMerge {
    static constexpr bool PERM = true;
    const bf16_t* gate; int ldg; const bf16_t* T1; bf16_t* O;
    __device__ __forceinline__ void operator()(const Acc& acc, const Unit& u, int wr, int wc, int fr, int fq) const {
        const int row0 = u.pm * BM + wr * 64 + fr;
#pragma unroll
        for (int ai = 0; ai < 2; ++ai)
#pragma unroll
            for (int m = 0; m < 4; ++m) { const int row = row0 + ai * HALF + m * 16;
#pragma unroll
                for (int bj = 0; bj < 2; ++bj) { const int col0 = u.pn * BM + bj * HALF + wc * 32 + 8 * fq;
                    const u32x4 gw = *(const u32x4*)(gate + (size_t)row * ldg + col0); const u32x4 tw = *(const u32x4*)(T1 + (size_t)row * DM + col0);
                    f32x4 v0 = acc[ai][bj][m][0], v1 = acc[ai][bj][m][1];
                    const f32x4 t0 = {bf2f(tw.x & 0xffffu), bf2f(tw.x >> 16), bf2f(tw.y & 0xffffu), bf2f(tw.y >> 16)}, t1 = {bf2f(tw.z & 0xffffu), bf2f(tw.z >> 16), bf2f(tw.w & 0xffffu), bf2f(tw.w >> 16)};
                    v0[0] = t0[0] + v0[0] * fsigmoid(bf2f(gw.x & 0xffffu)); v0[1] = t0[1] + v0[1] * fsigmoid(bf2f(gw.x >> 16)); v0[2] = t0[2] + v0[2] * fsigmoid(bf2f(gw.y & 0xffffu)); v0[3] = t0[3] + v0[3] * fsigmoid(bf2f(gw.y >> 16));
                    v1[0] = t1[0] + v1[0] * fsigmoid(bf2f(gw.z & 0xffffu)); v1[1] = t1[1] + v1[1] * fsigmoid(bf2f(gw.z >> 16)); v1[2] = t1[2] + v1[2] * fsigmoid(bf2f(gw.w & 0xffffu)); v1[3] = t1[3] + v1[3] * fsigmoid(bf2f(gw.w >> 16));
                    u32x4 w; w.x = cvt_pk_bf16(v0[0], v0[1]); w.y = cvt_pk_bf16(v0[2], v0[3]); w.z = cvt_pk_bf16(v1[0], v1[1]); w.w = cvt_pk_bf16(v1[2], v1[3]);
                    *(u32x4*)(O + (size_t)row * DM + col0) = w; } asm volatile("" ::: "memory"); }
    }
};
}

namespace att {
constexpr int NW = 8, QBLK = 32, KVBLK = 64;
constexpr int LDQ = NQ, LDKV = NKV, LDO = DM;
constexpr int SLOT_K = 24576, SLOT_V = 16384, KR_OFF = 16384;
constexpr int OFF_K = 0, OFF_V = 3 * SLOT_K, OFF_WS = OFF_V + 3 * SLOT_V;
constexpr float THRL = 11.0f;
#define KNSWZ(row, colB) ((row) * 256 + ((colB) ^ (((row) & 15) << 4)))
#define KRSWZ(row, colB) ((row) * 128 + ((colB) ^ ((((row) >> 1) & 7) << 4)))
#define SBAR() __builtin_amdgcn_sched_barrier(0)
__device__ __forceinline__ int crow(int r, int hi) { return (r & 3) + 8 * (r >> 2) + 4 * hi; }

__device__ __forceinline__ void partialSM(f32x16& p0, f32x16& p1, float& m_reg, float& mn, float& alpha) {
    float pmax = p0[0];
#pragma unroll
    for (int r = 1; r < 16; ++r) pmax = fmaxf(pmax, p0[r]);
#pragma unroll
    for (int r = 0; r < 16; ++r) pmax = fmaxf(pmax, p1[r]);
    { auto rr = __builtin_amdgcn_permlane32_swap(__float_as_uint(pmax), __float_as_uint(pmax), false, false);
      pmax = fmaxf(__uint_as_float(rr[0]), __uint_as_float(rr[1])); }
    if (__builtin_expect(__all(pmax - m_reg <= THRL), 1)) { mn = m_reg; alpha = 1.f; }
    else { mn = fmaxf(m_reg, pmax); alpha = __builtin_amdgcn_exp2f(m_reg - mn); m_reg = mn; }
#pragma unroll
    for (int r = 0; r < 16; ++r) p0[r] = p0[r] - mn;
#pragma unroll
    for (int r = 0; r < 16; ++r) p1[r] = p1[r] - mn;
#pragma unroll
    for (int r = 0; r < 16; ++r) p0[r] = __builtin_amdgcn_exp2f(p0[r]);
}
__device__ __forceinline__ void finishSM(f32x16& p0, f32x16& p1, float alpha, float& l_reg, bf16x8& pa0, bf16x8& pa1, bf16x8& pa2, bf16x8& pa3) {
#pragma unroll
    for (int r = 0; r < 16; ++r) p1[r] = __builtin_amdgcn_exp2f(p1[r]);
    float ps = 0;
#pragma unroll
    for (int r = 0; r < 16; ++r) ps += p0[r];
#pragma unroll
    for (int r = 0; r < 16; ++r) ps += p1[r];
    { auto rr = __builtin_amdgcn_permlane32_swap(__float_as_uint(ps), __float_as_uint(ps), false, false);
      ps = __uint_as_float(rr[0]) + __uint_as_float(rr[1]); }
    l_reg = l_reg * alpha + ps;
#define PK4(P, BASE, OUT) do { unsigned a0 = cvt_pk_bf16(P[BASE + 0], P[BASE + 1]), a1 = cvt_pk_bf16(P[BASE + 2], P[BASE + 3]);   \
    unsigned b0 = cvt_pk_bf16(P[BASE + 4], P[BASE + 5]), b1 = cvt_pk_bf16(P[BASE + 6], P[BASE + 7]);                              \
    auto r0 = __builtin_amdgcn_permlane32_swap(a0, b0, false, false); auto r1 = __builtin_amdgcn_permlane32_swap(a1, b1, false, false); \
    u32x4 w = {r0[0], r1[0], r0[1], r1[1]}; OUT = *reinterpret_cast<bf16x8*>(&w); } while (0)
    PK4(p0, 0, pa0); PK4(p0, 8, pa1); PK4(p1, 0, pa2); PK4(p1, 8, pa3);
#undef PK4
}
__device__ __forceinline__ void qkt(f32x16& p0, f32x16& p1, const char* Kn, const bf16x8* qr, int r32, int hi) {
    const char* Kr = Kn + KR_OFF;
    p0 = f32x16{}; p1 = f32x16{};
    __builtin_amdgcn_s_setprio(1);
#pragma unroll
    for (int d0 = 0; d0 < 8; ++d0) { const int cb = (d0 * 16 + hi * 8) * 2;
        const bf16x8 b0 = *reinterpret_cast<const bf16x8*>(Kn + KNSWZ(r32, cb));
        const bf16x8 b1 = *reinterpret_cast<const bf16x8*>(Kn + KNSWZ(32 + r32, cb));
        p0 = __builtin_amdgcn_mfma_f32_32x32x16_bf16(b0, qr[d0], p0, 0, 0, 0);
        p1 = __builtin_amdgcn_mfma_f32_32x32x16_bf16(b1, qr[d0], p1, 0, 0, 0); }
#pragma unroll
    for (int d0 = 0; d0 < 4; ++d0) { const int cb = (d0 * 16 + hi * 8) * 2;
        const bf16x8 b0 = *reinterpret_cast<const bf16x8*>(Kr + KRSWZ(r32, cb));
        const bf16x8 b1 = *reinterpret_cast<const bf16x8*>(Kr + KRSWZ(32 + r32, cb));
        p0 = __builtin_amdgcn_mfma_f32_32x32x16_bf16(b0, qr[8 + d0], p0, 0, 0, 0);
        p1 = __builtin_amdgcn_mfma_f32_32x32x16_bf16(b1, qr[8 + d0], p1, 0, 0, 0); }
}
__device__ __forceinline__ int v_st(int k, int c) { const int kk = (k & ~0xC) | ((k & 4) << 1) | ((k & 8) >> 1); return ((kk >> 3) * 4 + (c >> 5)) * 512 + ((kk & 7) * 32 + (c & 31)) * 2; }
__device__ __forceinline__ int v_rd_base(int lane) { return ((lane & 3) << 3) | (((lane >> 2) & 3) << 6) | (((lane >> 4) & 1) << 5) | (((lane >> 5) & 1) << 8); }
constexpr int v_rd_off(int d0, int ks, int half) { return d0 * 512 + ks * 4096 + half * 2048; }
template <int OFF> __device__ __forceinline__ s16x4 tr_read(int vb) {
    s16x4 r; asm volatile("ds_read_b64_tr_b16 %0, %1 offset:%2" : "=&v"(r) : "v"(vb), "i"(OFF) : "memory"); return r;
}
template <int D0> __device__ __forceinline__ void pv_one(f32x16& od, int vb, bf16x8 pa0, bf16x8 pa1, bf16x8 pa2, bf16x8 pa3) {
    const s16x4 l0 = tr_read<v_rd_off(D0, 0, 0)>(vb), h0 = tr_read<v_rd_off(D0, 0, 1)>(vb), l1 = tr_read<v_rd_off(D0, 1, 0)>(vb), h1 = tr_read<v_rd_off(D0, 1, 1)>(vb);
    const s16x4 l2 = tr_read<v_rd_off(D0, 2, 0)>(vb), h2 = tr_read<v_rd_off(D0, 2, 1)>(vb), l3 = tr_read<v_rd_off(D0, 3, 0)>(vb), h3 = tr_read<v_rd_off(D0, 3, 1)>(vb);
    asm volatile("s_waitcnt lgkmcnt(0)" ::: "memory"); SBAR();
#define PK(L, H) (bf16x8){L[0], L[1], L[2], L[3], H[0], H[1], H[2], H[3]}
    od = __builtin_amdgcn_mfma_f32_32x32x16_bf16(pa0, PK(l0, h0), od, 0, 0, 0);
    od = __builtin_amdgcn_mfma_f32_32x32x16_bf16(pa1, PK(l1, h1), od, 0, 0, 0);
    od = __builtin_amdgcn_mfma_f32_32x32x16_bf16(pa2, PK(l2, h2), od, 0, 0, 0);
    od = __builtin_amdgcn_mfma_f32_32x32x16_bf16(pa3, PK(l3, h3), od, 0, 0, 0);
#undef PK
}
__device__ __forceinline__ void pv_d0(f32x16* o, int vb, bf16x8 pa0, bf16x8 pa1, bf16x8 pa2, bf16x8 pa3) {
    pv_one<0>(o[0], vb, pa0, pa1, pa2, pa3); pv_one<1>(o[1], vb, pa0, pa1, pa2, pa3); pv_one<2>(o[2], vb, pa0, pa1, pa2, pa3); pv_one<3>(o[3], vb, pa0, pa1, pa2, pa3);
}

__device__ __forceinline__ void attn_unit(const bf16_t* __restrict__ Qb, const bf16_t* __restrict__ Kn, const bf16_t* __restrict__ Vh, const bf16_t* __restrict__ Kr,
                                          bf16_t* __restrict__ Ob, int seq, char* lds, int wv_) { LAUNDER_IDS;
    const int tid = tidx_, wid = __builtin_amdgcn_readfirstlane(tid >> 6), lane = tid & 63, r32 = lane & 31, hi = lane >> 5;
    LAS unsigned char* lds3 = (LAS unsigned char*)lds;
    float* ws = (float*)(lds + OFF_WS) + wid * 64; float* li_l = ws; float* al_l = ws + 32;
    float m_reg = -1e30f, l_reg = 0; f32x16 o[4] = {}; bf16x8 qr[12];
    const bf16_t* Qw = Qb + (long)(wid * QBLK + r32) * LDQ + hi * 8;
#pragma unroll
    for (int d0 = 0; d0 < 12; ++d0) qr[d0] = *reinterpret_cast<const bf16x8*>(Qw + d0 * 16);
    unsigned gkn[2], gv[2], gkr;
#pragma unroll
    for (int i = 0; i < 2; ++i) { const int c = wid * 2 + i; const int row = c * 4 + (lane >> 4), slot = lane & 15; gkn[i] = (unsigned)(row * (LDKV * 2) + ((slot ^ (row & 15)) << 4));
        const int st = c * 2 + (lane >> 5), kk = (st >> 2) * 8 + ((lane & 31) >> 2), k = (kk & ~0xC) | ((kk & 4) << 1) | ((kk & 8) >> 1), col = (st & 3) * 32 + (lane & 3) * 8; gv[i] = (unsigned)(k * (LDKV * 2) + col * 2); }
    { const int row = wid * 8 + (lane >> 3), slot = lane & 7; gkr = (unsigned)(row * 128 + ((slot ^ ((row >> 1) & 7)) << 4)); }
    const int vb0 = (int)(uintptr_t)(lds + OFF_V) + v_rd_base(lane);
#define DMA(t, slot) do { const char* kt_ = (const char*)Kn + (size_t)(t) * (KVBLK * LDKV * 2); const char* vt_ = (const char*)Vh + (size_t)(t) * (KVBLK * LDKV * 2); const char* rt_ = (const char*)Kr + (size_t)(t) * (KVBLK * 128); \
    _Pragma("unroll") for (int i_ = 0; i_ < 2; ++i_) { \
      __builtin_amdgcn_global_load_lds((const unsigned*)(kt_ + gkn[i_]), (LAS unsigned*)(lds3 + OFF_K + (slot) * SLOT_K + (wid * 2 + i_) * 1024), 16, 0, 0); \
      __builtin_amdgcn_global_load_lds((const unsigned*)(vt_ + gv[i_]), (LAS unsigned*)(lds3 + OFF_V + (slot) * SLOT_V + (wid * 2 + i_) * 1024), 16, 0, 0); } \
    __builtin_amdgcn_global_load_lds((const unsigned*)(rt_ + gkr), (LAS unsigned*)(lds3 + OFF_K + (slot) * SLOT_K + KR_OFF + wid * 1024), 16, 0, 0); } while (0)
#define WAIT_BAR() asm volatile("s_waitcnt vmcnt(0) lgkmcnt(0)\n\ts_barrier" ::: "memory")
#define RESC(a) do { if (__any((a) < 1.f)) { if (hi == 0) al_l[r32] = (a); asm volatile("s_waitcnt lgkmcnt(0)" ::: "memory"); \
    _Pragma("unroll") for (int d = 0; d < 4; ++d) _Pragma("unroll") for (int r = 0; r < 16; ++r) o[d][r] *= al_l[crow(r, hi)]; } } while (0)
    f32x16 pA0, pA1, pB0, pB1; float mnA, mnB, alA, alB; bf16x8 pa0, pa1, pa2, pa3; const int NT = seq / KVBLK;
    DMA(0, 0); DMA(1, 1); WAIT_BAR();
    qkt(pA0, pA1, lds + OFF_K, qr, r32, hi); __builtin_amdgcn_s_setprio(0); partialSM(pA0, pA1, m_reg, mnA, alA);
    int s_prev = 0, s_cur = 1, s_next = 2;
#define ROT() do { const int t_ = s_prev; s_prev = s_cur; s_cur = s_next; s_next = t_; } while (0)
    for (int j = 1; j + 1 < NT; j += 2) {
        DMA(j + 1, s_next); SBAR();
        qkt(pB0, pB1, lds + OFF_K + s_cur * SLOT_K, qr, r32, hi);
        finishSM(pA0, pA1, alA, l_reg, pa0, pa1, pa2, pa3); __builtin_amdgcn_s_setprio(0); SBAR();
        pv_d0(o, vb0 + s_prev * SLOT_V, pa0, pa1, pa2, pa3); partialSM(pB0, pB1, m_reg, mnB, alB);
        RESC(alB); WAIT_BAR(); ROT();
        DMA(j + 2, s_next); SBAR();
        qkt(pA0, pA1, lds + OFF_K + s_cur * SLOT_K, qr, r32, hi);
        finishSM(pB0, pB1, alB, l_reg, pa0, pa1, pa2, pa3); __builtin_amdgcn_s_setprio(0); SBAR();
        pv_d0(o, vb0 + s_prev * SLOT_V, pa0, pa1, pa2, pa3); partialSM(pA0, pA1, m_reg, mnA, alA);
        RESC(alA); WAIT_BAR(); ROT();
    }
    SBAR(); qkt(pB0, pB1, lds + OFF_K + s_cur * SLOT_K, qr, r32, hi);
    finishSM(pA0, pA1, alA, l_reg, pa0, pa1, pa2, pa3); __builtin_amdgcn_s_setprio(0); SBAR();
    pv_d0(o, vb0 + s_prev * SLOT_V, pa0, pa1, pa2, pa3); partialSM(pB0, pB1, m_reg, mnB, alB);
    RESC(alB);
    finishSM(pB0, pB1, alB, l_reg, pa0, pa1, pa2, pa3); __builtin_amdgcn_s_setprio(0); SBAR();
    pv_d0(o, vb0 + s_cur * SLOT_V, pa0, pa1, pa2, pa3);
    if (hi == 0) li_l[r32] = l_reg; asm volatile("s_waitcnt lgkmcnt(0)" ::: "memory");
    float rli[16];
#pragma unroll
    for (int r = 0; r < 16; ++r) rli[r] = __builtin_amdgcn_rcpf(li_l[crow(r, hi)]);
    bf16_t* Ow = Ob + (long)(wid * QBLK) * LDO;
#pragma unroll
    for (int r = 0; r < 16; ++r) { const int orow = crow(r, hi);
#pragma unroll
        for (int d0 = 0; d0 < 4; ++d0) Ow[(long)orow * LDO + d0 * 32 + r32] = (bf16_t)(cvt_pk_bf16(o[d0][r] * rli[r], 0.f) & 0xffffu); }
    WAIT_BAR();
#undef DMA
#undef WAIT_BAR
#undef RESC
#undef ROT
}
}


#define XB_TMO      128
#define XB_XCNT(j)  (256  + 64 * (j))
#define XB_XSUB(j)  (1280 + 64 * (j))
#define XB_XGEN(j)  (2304 + 64 * (j))
#define XB_TOP      3328
#define XB_TOPGEN   3392
#define XCD_BAR_WORDS 3456
#define XB_SPIN_CAP (1u << 22)
__device__ __forceinline__ unsigned xb_ld(unsigned* p)              { return __hip_atomic_load(p, __ATOMIC_RELAXED, __HIP_MEMORY_SCOPE_AGENT); }
__device__ __forceinline__ unsigned xb_add(unsigned* p, unsigned v) { return __hip_atomic_fetch_add(p, v, __ATOMIC_RELAXED, __HIP_MEMORY_SCOPE_AGENT); }
__device__ __forceinline__ unsigned xb_xcc_id() { return (unsigned)__builtin_amdgcn_s_getreg((3 << 11) | 20) & 0xFu; }
#define XB_SPIN(cond, bar) do { unsigned _sp = 0; while (cond) { __builtin_amdgcn_s_sleep(1); \
    if ((++_sp & 255u) == 0u) { if (xb_ld(&(bar)[XB_TMO])) break; if (_sp > XB_SPIN_CAP) { atomicAdd(&(bar)[XB_TMO], 1u); break; } } } } while (0)
struct XcdBarrier { unsigned* bar; unsigned x; volatile LAS unsigned* st; };
__device__ __forceinline__ XcdBarrier xcd_barrier_post(unsigned* bar, volatile LAS unsigned* st) {
    XcdBarrier b; b.bar = bar; b.x = xb_xcc_id(); b.st = st;
    if (threadIdx.x == 0) (void)xb_add(&bar[XB_XCNT(b.x)], 1u);
    return b;
}
__device__ __forceinline__ void xcd_barrier_complete(unsigned* bar, unsigned x, unsigned& nloc, unsigned& nx) {
    const unsigned G = gridDim.x * gridDim.y * gridDim.z;
    unsigned sum, cnt, mine, sp = 0u;
    for (;;) {
        sum = 0u; cnt = 0u; mine = 0u;
#pragma unroll
        for (unsigned j = 0; j < 16; ++j) { const unsigned c = xb_ld(&bar[XB_XCNT(j)]); sum += c; cnt += (c > 0u) ? 1u : 0u; mine = (j == x) ? c : mine; }
        if (sum == G) break;
        __builtin_amdgcn_s_sleep(1);
        if ((++sp & 255u) == 0u) { if (xb_ld(&bar[XB_TMO])) break; if (sp > XB_SPIN_CAP) { atomicAdd(&bar[XB_TMO], 1u); break; } }
    }
    nloc = mine > 0u ? mine : 1u; nx = cnt > 0u ? cnt : 1u;
}
__device__ __forceinline__ void xcd_barrier(const XcdBarrier& b) {
    asm volatile("s_waitcnt vmcnt(0)" ::: "memory");
    __syncthreads();
    if (threadIdx.x == 0) {
        unsigned* bar = b.bar;
        __builtin_amdgcn_s_waitcnt(0);
        unsigned nloc = b.st[0], nx = b.st[1];
        if (nloc == 0u) { xcd_barrier_complete(bar, b.x, nloc, nx); b.st[0] = nloc; b.st[1] = nx; }
        const unsigned old = xb_add(&bar[XB_XSUB(b.x)], 1u);
        const unsigned gen = old / nloc;
        if (old + 1u == (gen + 1u) * nloc) {
            __builtin_amdgcn_fence(__ATOMIC_RELEASE, "agent");
            asm volatile("s_waitcnt vmcnt(0)" ::: "memory");
            const unsigned og = xb_add(&bar[XB_TOP], 1u);
            const unsigned tg = og / nx;
            if (og + 1u == (tg + 1u) * nx) xb_add(&bar[XB_TOPGEN], 1u);
            else XB_SPIN(xb_ld(&bar[XB_TOPGEN]) == tg, bar);
            __builtin_amdgcn_fence(__ATOMIC_ACQUIRE, "agent");
            xb_add(&bar[XB_XGEN(b.x)], 1u);
            asm volatile("s_waitcnt vmcnt(0)" ::: "memory");
        } else {
            XB_SPIN(xb_ld(&bar[XB_XGEN(b.x)]) == gen, bar);
            __builtin_amdgcn_fence(__ATOMIC_ACQUIRE, "agent");
            asm volatile("s_waitcnt vmcnt(0)" ::: "memory");
        }
    }
    __syncthreads();
}

struct Args { const float* in[27]; float* out; unsigned char* ws; int ph_lo, ph_hi; };

__device__ __forceinline__ int map_row(int mode, int row_off, int n) {
    if (mode == 0) return row_off + n;
    if (mode == 1) return (n >> 7) * 256 + row_off + (n & 127);
    if (mode == 2) { if (n >= C_KPE && n < C_KPE + 64) { const int j = n - C_KPE; return C_KPE + (j < 32 ? 2 * j : 2 * (j - 32) + 1); } return n; }
    { const int h = n / 192, d = n % 192; if (d < 128) return n; const int j = d - 128; return h * 192 + 128 + (j < 32 ? 2 * j : 2 * (j - 32) + 1); }
}
__device__ __forceinline__ void transpose_item(const float* W, int K, int N, bf16_t* WT, int mode, int row_off, LAS float* scr, int item, int lane) {
    const int nblk = N / 32, kb = item / nblk, nb = item % nblk, k0 = 64 * kb, n0 = 32 * nb;
    float wv[32];
#pragma unroll
    for (int i = 0; i < 32; ++i) { const int kk = 2 * i + (lane >> 5); wv[i] = W[(size_t)(k0 + kk) * N + n0 + (lane & 31)]; }
#pragma unroll
    for (int i = 0; i < 32; ++i) { const int kk = 2 * i + (lane >> 5); scr[kk * 33 + (lane & 31)] = wv[i]; }
    asm volatile("s_waitcnt lgkmcnt(0)" ::: "memory");
    const int c = lane & 7;
#pragma unroll
    for (int j = 0; j < 4; ++j) { const int n = (lane >> 3) + 8 * j; const LAS float* s = scr + (8 * c) * 33 + n;
        u32x4 o; o.x = cvt_pk_bf16(s[0 * 33], s[1 * 33]); o.y = cvt_pk_bf16(s[2 * 33], s[3 * 33]); o.z = cvt_pk_bf16(s[4 * 33], s[5 * 33]); o.w = cvt_pk_bf16(s[6 * 33], s[7 * 33]);
        *(u32x4*)(WT + (size_t)map_row(mode, row_off, n0 + n) * K + k0 + 8 * c) = o; }
    asm volatile("s_waitcnt lgkmcnt(0)" ::: "memory");
}

__device__ __forceinline__ void rms_row_bf16(const float* xrow, const float* g, bf16_t* orow, int lane) {
    const f32x4* xr = (const f32x4*)xrow + lane; const f32x4* gr = (const f32x4*)g + lane;
    f32x4 v[8]; float s = 0.f;
#pragma unroll
    for (int j = 0; j < 8; ++j) { v[j] = xr[64 * j]; s += (v[j].x * v[j].x + v[j].y * v[j].y) + (v[j].z * v[j].z + v[j].w * v[j].w); }
    const float rstd = rsqrtf(wave_sum(s) * (1.f / DM) + RMS_EPS);
    u32x2* o8 = (u32x2*)orow + lane;
#pragma unroll
    for (int j = 0; j < 8; ++j) { const f32x4 gg = gr[64 * j]; u32x2 w; w.x = cvt_pk_bf16(v[j].x * rstd * gg.x, v[j].y * rstd * gg.y); w.y = cvt_pk_bf16(v[j].z * rstd * gg.z, v[j].w * rstd * gg.w); o8[64 * j] = w; }
}
__device__ __forceinline__ void rms_row_f32_inplace(float* xrow, const float* g, int lane) {
    f32x4* xr = (f32x4*)xrow + lane; const f32x4* gr = (const f32x4*)g + lane;
    f32x4 v[8]; float s = 0.f;
#pragma unroll
    for (int j = 0; j < 8; ++j) { v[j] = xr[64 * j]; s += (v[j].x * v[j].x + v[j].y * v[j].y) + (v[j].z * v[j].z + v[j].w * v[j].w); }
    const float rstd = rsqrtf(wave_sum(s) * (1.f / DM) + RMS_EPS);
#pragma unroll
    for (int j = 0; j < 8; ++j) { const f32x4 gg = gr[64 * j]; xr[64 * j] = v[j] * rstd * gg; }
}

__device__ __forceinline__ void phase_prologue(const Args& a, LAS unsigned char* lds, int wv_) { LAUNDER_IDS;
    const int tid = tidx_, lane = tid & 63, wave = tid >> 6;
    unsigned char* ws = a.ws;
    LAS float* scr = (LAS float*)(lds + wave * 16384);
    const int gw = bidx_ * 8 + wave, NGW = gridDim.x * 8;
    constexpr int I_GU = (DM / 64) * (DFF / 32), I_D = (DFF / 64) * (DM / 32), I_IN = (DM / 64) * (NIN / 32), I_UQ = (512 / 64) * (NQ / 32), I_UKV = (512 / 64) * (NKV / 32),
                  I_SQ = (DM / 64) * (DM / 32), I_G = 64 * 8;
    constexpr int NITEMS = 4 * I_GU + 2 * I_D + I_IN + I_UQ + I_UKV + 3 * I_SQ + I_G;
    for (int it = gw; it < NITEMS; it += NGW) {
        int r = it;
        if (r < I_GU) { transpose_item(a.in[3], DM, DFF, (bf16_t*)(ws + WS_W1GU), 1, 0, scr, r, lane); continue; } r -= I_GU;
        if (r < I_GU) { transpose_item(a.in[4], DM, DFF, (bf16_t*)(ws + WS_W1GU), 1, 128, scr, r, lane); continue; } r -= I_GU;
        if (r < I_GU) { transpose_item(a.in[23], DM, DFF, (bf16_t*)(ws + WS_W2GU), 1, 0, scr, r, lane); continue; } r -= I_GU;
        if (r < I_GU) { transpose_item(a.in[24], DM, DFF, (bf16_t*)(ws + WS_W2GU), 1, 128, scr, r, lane); continue; } r -= I_GU;
        if (r < I_D) { transpose_item(a.in[5], DFF, DM, (bf16_t*)(ws + WS_W1D), 0, 0, scr, r, lane); continue; } r -= I_D;
        if (r < I_D) { transpose_item(a.in[25], DFF, DM, (bf16_t*)(ws + WS_W2D), 0, 0, scr, r, lane); continue; } r -= I_D;
        if (r < I_IN) { transpose_item(a.in[7], DM, NIN, (bf16_t*)(ws + WS_WIN), 2, 0, scr, r, lane); continue; } r -= I_IN;
        if (r < I_UQ) { transpose_item(a.in[9], 512, NQ, (bf16_t*)(ws + WS_WUQ), 3, 0, scr, r, lane); continue; } r -= I_UQ;
        if (r < I_UKV) { transpose_item(a.in[11], 512, NKV, (bf16_t*)(ws + WS_WUKV), 0, 0, scr, r, lane); continue; } r -= I_UKV;
        if (r < I_SQ) { transpose_item(a.in[12], DM, DM, (bf16_t*)(ws + WS_WOA), 0, 0, scr, r, lane); continue; } r -= I_SQ;
        if (r < I_SQ) { transpose_item(a.in[20], DM, DM, (bf16_t*)(ws + WS_WOR), 0, 0, scr, r, lane); continue; } r -= I_SQ;
        if (r < I_SQ) { transpose_item(a.in[21], DM, DM, (bf16_t*)(ws + WS_WOUT), 0, 0, scr, r, lane); continue; } r -= I_SQ;
        { const int mat = r >> 3, sub = r & 7, type = mat & 1, db = mat >> 1;
          transpose_item((type ? a.in[17] : a.in[15]) + (size_t)db * 128 * 128, 128, 128, (bf16_t*)(ws + WS_WG), 0, mat * 128, scr, sub, lane); }
    }
    { const int gt = bidx_ * 512 + tid, NT = gridDim.x * 512; u32x4* p = (u32x4*)((bf16_t*)(ws + WS_WIN) + (size_t)NIN * DM);
      for (int i = gt; i < (NINP - NIN) * DM / 8; i += NT) p[i] = (u32x4){0u, 0u, 0u, 0u}; }
    { const int gt = bidx_ * 512 + tid, NT = gridDim.x * 512; float* cosT = (float*)(ws + WS_COS); float* sinT = (float*)(ws + WS_SIN); float* c8 = (float*)(ws + WS_C8);
      for (int i = gt; i < SEQ * 32; i += NT) { const int pos = i >> 5, j = i & 31; const float inv = powf(10000.0f, -(float)(2 * j) / 64.0f); const float ang = (float)pos * inv; cosT[i] = cosf(ang); sinT[i] = sinf(ang); }
      for (int i = gt; i < 2 * DM; i += NT) { const float l = a.in[19][i]; const float sp = (-l > 20.f) ? -l : log1pf(expf(-l)); c8[i] = 8.0f * sp; } }
    for (int m = gw; m < MTOT; m += NGW) { const float* xr = m < SEQ ? a.in[0] + (size_t)m * DM : a.in[1] + (size_t)(m - SEQ) * DM; rms_row_bf16(xr, a.in[2], (bf16_t*)(ws + WS_H) + (size_t)m * DM, lane); }
}

__device__ __forceinline__ void phase_norm(const Args& a, const float* g, int wv_) { LAUNDER_IDS;
    const int lane = tidx_ & 63, gw = bidx_ * 8 + (tidx_ >> 6), NGW = gridDim.x * 8;
    for (int m = gw; m < MTOT; m += NGW) rms_row_bf16(a.out + (size_t)m * DM, g, (bf16_t*)(a.ws + WS_H) + (size_t)m * DM, lane);
}
__device__ __forceinline__ void phase_final_norm(const Args& a, int wv_) { LAUNDER_IDS;
    const int lane = tidx_ & 63, gw = bidx_ * 8 + (tidx_ >> 6), NGW = gridDim.x * 8;
    for (int m = gw; m < MTOT; m += NGW) rms_row_f32_inplace(a.out + (size_t)m * DM, a.in[26], lane);
}

__device__ __forceinline__ void phase_small(const Args& a, int wv_) { LAUNDER_IDS;
    unsigned char* ws = a.ws; const int tid = tidx_, lane = tid & 63, gw = bidx_ * 8 + (tid >> 6), NGW = gridDim.x * 8;
    const bf16_t* proj = (const bf16_t*)(ws + WS_PROJ);
    for (int task = gw; task < 2 * SEQ; task += NGW) {
        const int row = task >> 1, which = task & 1;
        const bf16_t* src = proj + (size_t)row * NINP + (which ? C_CKV : C_CQ) + lane * 8;
        const u32x4 w = *(const u32x4*)src; float v[8] = {bf2f(w.x & 0xffffu), bf2f(w.x >> 16), bf2f(w.y & 0xffffu), bf2f(w.y >> 16), bf2f(w.z & 0xffffu), bf2f(w.z >> 16), bf2f(w.w & 0xffffu), bf2f(w.w >> 16)};
        float s = 0.f;
#pragma unroll
        for (int j = 0; j < 8; ++j) s += v[j] * v[j];
        const float rstd = rsqrtf(wave_sum(s) * (1.f / 512.f) + RMS_EPS);
        const float* g = (which ? a.in[10] : a.in[8]) + lane * 8; const f32x4 g0 = *(const f32x4*)g, g1 = *(const f32x4*)(g + 4);
        u32x4 o; o.x = cvt_pk_bf16(v[0] * rstd * g0.x, v[1] * rstd * g0.y); o.y = cvt_pk_bf16(v[2] * rstd * g0.z, v[3] * rstd * g0.w);
        o.z = cvt_pk_bf16(v[4] * rstd * g1.x, v[5] * rstd * g1.y); o.w = cvt_pk_bf16(v[6] * rstd * g1.z, v[7] * rstd * g1.w);
        *(u32x4*)((bf16_t*)(ws + (which ? WS_CKVN : WS_CQN)) + (size_t)row * 512 + lane * 8) = o;
        if (which && lane < 32) {
            const unsigned pw = *(const unsigned*)(proj + (size_t)row * NINP + C_KPE + 2 * lane); const float x1 = bf2f(pw & 0xffffu), x2 = bf2f(pw >> 16);
            const float c = ((const float*)(ws + WS_COS))[row * 32 + lane], sn = ((const float*)(ws + WS_SIN))[row * 32 + lane];
            *(unsigned*)((bf16_t*)(ws + WS_KPE) + (size_t)row * 64 + 2 * lane) = cvt_pk_bf16(x1 * c - x2 * sn, x2 * c + x1 * sn);
        }
    }
    const int gt = bidx_ * 512 + tid, NT = gridDim.x * 512; bf16_t* xc = (bf16_t*)(ws + WS_XC);
    for (int i = gt; i < SEQ * (DM / 8); i += NT) {
        const int row = i >> 8, c0 = (i & 255) * 8; float accv[8];
        { const f32x4 b0 = *(const f32x4*)(a.in[14] + c0), b1 = *(const f32x4*)(a.in[14] + c0 + 4); accv[0] = b0.x; accv[1] = b0.y; accv[2] = b0.z; accv[3] = b0.w; accv[4] = b1.x; accv[5] = b1.y; accv[6] = b1.z; accv[7] = b1.w; }
#pragma unroll
        for (int k = 0; k < 4; ++k) { const int t = row + k - 2; if (t < 0 || t >= SEQ) continue;
            const u32x4 w = *(const u32x4*)(proj + (size_t)t * NINP + C_XREC + c0); const f32x4 w0 = *(const f32x4*)(a.in[13] + k * DM + c0), w1 = *(const f32x4*)(a.in[13] + k * DM + c0 + 4);
            accv[0] += bf2f(w.x & 0xffffu) * w0.x; accv[1] += bf2f(w.x >> 16) * w0.y; accv[2] += bf2f(w.y & 0xffffu) * w0.z; accv[3] += bf2f(w.y >> 16) * w0.w;
            accv[4] += bf2f(w.z & 0xffffu) * w1.x; accv[5] += bf2f(w.z >> 16) * w1.y; accv[6] += bf2f(w.w & 0xffffu) * w1.z; accv[7] += bf2f(w.w >> 16) * w1.w; }
        u32x4 o; o.x = cvt_pk_bf16(accv[0], accv[1]); o.y = cvt_pk_bf16(accv[2], accv[3]); o.z = cvt_pk_bf16(accv[4], accv[5]); o.w = cvt_pk_bf16(accv[6], accv[7]);
        *(u32x4*)(xc + (size_t)row * DM + c0) = o;
    }
}

__device__ __forceinline__ void phase_scan1(const Args& a, int wv_) { LAUNDER_IDS;
    unsigned char* ws = a.ws; const int tid = tidx_;
    for (int it = bidx_; it < 1024; it += gridDim.x) {
        const int half = it & 1, dir = (it >> 1) & 1, c = it >> 2, ch = half * 1024 + tid * 2;
        const bf16_t* A = (const bf16_t*)(ws + (dir ? WS_AB : WS_AF)) + ch; const bf16_t* U = (const bf16_t*)(ws + (dir ? WS_UB : WS_UF)) + ch;
        f32x2 P = {1.f, 1.f}, Hh = {0.f, 0.f};
#pragma unroll 8
        for (int i = 0; i < 32; ++i) { const int t = dir ? (c * 32 + 31 - i) : (c * 32 + i); const unsigned aw = *(const unsigned*)(A + (size_t)t * DM), uw = *(const unsigned*)(U + (size_t)t * DM);
            const f32x2 av = {1.0f - bf2f(aw & 0xffffu), 1.0f - bf2f(aw >> 16)}, uv = {bf2f(uw & 0xffffu), bf2f(uw >> 16)}; Hh = av * Hh + uv; P = P * av; }
        *(f32x2*)((float*)(ws + WS_AGGA) + (size_t)(dir * 256 + c) * DM + ch) = P; *(f32x2*)((float*)(ws + WS_AGGB) + (size_t)(dir * 256 + c) * DM + ch) = Hh;
    }
}
__device__ __forceinline__ void phase_scan15(const Args& a, int wv_) { LAUNDER_IDS;
    unsigned char* ws = a.ws; const int gid = bidx_ * 512 + tidx_; if (gid >= 2048) return;
    const int dir = gid >> 10, ch = (gid & 1023) * 2;
    const float* GA = (const float*)(ws + WS_AGGA) + (size_t)dir * 256 * DM + ch; const float* GB = (const float*)(ws + WS_AGGB) + (size_t)dir * 256 * DM + ch; float* CR = (float*)(ws + WS_CARRY) + (size_t)dir * 256 * DM + ch;
    f32x2 carry = {0.f, 0.f};
#pragma unroll 8
    for (int i = 0; i < 256; ++i) { const int c = dir ? 255 - i : i; *(f32x2*)(CR + (size_t)c * DM) = carry; const f32x2 av = *(const f32x2*)(GA + (size_t)c * DM), bv = *(const f32x2*)(GB + (size_t)c * DM); carry = av * carry + bv; }
}
__device__ __forceinline__ void phase_scan2(const Args& a, int wv_) { LAUNDER_IDS;
    unsigned char* ws = a.ws; const int tid = tidx_;
    const bf16_t* proj = (const bf16_t*)(ws + WS_PROJ); bf16_t* yg = (bf16_t*)(ws + WS_YG);
    for (int it = bidx_; it < 512; it += gridDim.x) {
        const int half = it & 1, c = it >> 1, ch = half * 1024 + tid * 2;
        const bf16_t* AF = (const bf16_t*)(ws + WS_AF) + ch; const bf16_t* UF = (const bf16_t*)(ws + WS_UF) + ch; const bf16_t* AB = (const bf16_t*)(ws + WS_AB) + ch; const bf16_t* UB = (const bf16_t*)(ws + WS_UB) + ch;
        f32x2 hf[32]; f32x2 h = *(const f32x2*)((const float*)(ws + WS_CARRY) + (size_t)c * DM + ch);
#pragma unroll
        for (int i = 0; i < 32; ++i) { const int t = c * 32 + i; const unsigned aw = *(const unsigned*)(AF + (size_t)t * DM), uw = *(const unsigned*)(UF + (size_t)t * DM);
            const f32x2 av = {1.0f - bf2f(aw & 0xffffu), 1.0f - bf2f(aw >> 16)}, uv = {bf2f(uw & 0xffffu), bf2f(uw >> 16)}; h = av * h + uv; hf[i] = h; }
        h = *(const f32x2*)((const float*)(ws + WS_CARRY) + (size_t)(256 + c) * DM + ch);
#pragma unroll
        for (int i = 31; i >= 0; --i) { const int t = c * 32 + i; const unsigned aw = *(const unsigned*)(AB + (size_t)t * DM), uw = *(const unsigned*)(UB + (size_t)t * DM);
            const f32x2 av = {1.0f - bf2f(aw & 0xffffu), 1.0f - bf2f(aw >> 16)}, uv = {bf2f(uw & 0xffffu), bf2f(uw >> 16)}; h = av * h + uv;
            const unsigned gw = *(const unsigned*)(proj + (size_t)t * NINP + C_GREC + ch); const f32x2 hs = hf[i] + h;
            *(unsigned*)(yg + (size_t)t * DM + ch) = cvt_pk_bf16(gelu_tanh(bf2f(gw & 0xffffu)) * hs.x, gelu_tanh(bf2f(gw >> 16)) * hs.y); }
    }
}

__device__ __forceinline__ void phase_attention(const Args& a, char* lds, int wv_) { LAUNDER_IDS;
    unsigned char* ws = a.ws; const int G = gridDim.x, bx = bidx_; const int vcu = (G % 8 == 0) ? (bx % 8) * (G / 8) + bx / 8 : bx;
    const bf16_t* Q = (const bf16_t*)(ws + WS_Q); const bf16_t* KV = (const bf16_t*)(ws + WS_KV); const bf16_t* KPE = (const bf16_t*)(ws + WS_KPE); bf16_t* O = (bf16_t*)(ws + WS_ATTO);
    for (int u = vcu; u < 512; u += G) { const int h = u >> 5, qb = u & 31;
        att::attn_unit(Q + (size_t)qb * 256 * NQ + h * 192, KV + h * 256, KV + h * 256 + 128, KPE, O + (size_t)qb * 256 * DM + h * 128, SEQ, lds, wv_); }
}

__device__ __forceinline__ void phase_ffn_up(const Args& a, LAS unsigned char* lds, int which, int wv_) {
    pg8::Gemm g{(const bf16_t*)(a.ws + WS_H), (const bf16_t*)(a.ws + (which ? WS_W2GU : WS_W1GU))};
    pg8::EpiSwiglu E{(bf16_t*)(a.ws + WS_ACT), DFF};
    pg8::gemm_phase<pg8::EpiSwiglu, MTOT, 2 * DFF, DM, DM, 0, 0>(lds, g, E, wv_);
}
__device__ __forceinline__ void phase_ffn_down(const Args& a, LAS unsigned char* lds, int which, int wv_) {
    pg8::Gemm g{(const bf16_t*)(a.ws + WS_ACT), (const bf16_t*)(a.ws + (which ? WS_W2D : WS_W1D))};
    pg8::EpiResid E{which ? a.out : a.in[0], which ? a.out : a.in[1], which ? MTOT : SEQ, a.out, 0.5f, 0};
    pg8::gemm_phase<pg8::EpiResid, MTOT, DM, DFF, DFF, 0, 0>(lds, g, E, wv_);
}
__device__ __forceinline__ void phase_wout(const Args& a, LAS unsigned char* lds, int s, int wv_) {
    pg8::Gemm g{(const bf16_t*)(a.ws + WS_H), (const bf16_t*)(a.ws + WS_WOUT)};
    pg8::EpiResid E{a.out, a.out, MTOT, a.out, 1.0f, 0};
    pg8::gemm_phase<pg8::EpiResid, MTOT, DM, DM, DM, 0, 0>(lds, g, E, wv_);
}
__device__ __forceinline__ void phase_win(const Args& a, LAS unsigned char* lds, int s, int wv_) {
    pg8::Gemm g{(const bf16_t*)(a.ws + WS_H) + (size_t)s * SEQ * DM, (const bf16_t*)(a.ws + WS_WIN)}; pg8::EpiBf16 E{(bf16_t*)(a.ws + WS_PROJ), NINP};
    pg8::gemm_phase<pg8::EpiBf16, SEQ, NINP, DM, DM, 0, 0>(lds, g, E, wv_);
}
__device__ __forceinline__ void phase_kv(const Args& a, LAS unsigned char* lds, int wv_) {
    pg8::Gemm g{(const bf16_t*)(a.ws + WS_CKVN), (const bf16_t*)(a.ws + WS_WUKV)}; pg8::EpiBf16 E{(bf16_t*)(a.ws + WS_KV), NKV};
    pg8::gemm_phase<pg8::EpiBf16, SEQ, NKV, 512, 512, 0, 0>(lds, g, E, wv_);
}

__device__ __forceinline__ void run_phase(const Args& a, int ph, unsigned char* lds_g, int wv_) {
    LAS unsigned char* lds = (LAS unsigned char*)lds_g; unsigned char* ws = a.ws;
    if (ph == 0) { if (PHM(0)) phase_prologue(a, lds, wv_); return; }
    if (ph == 1 || ph == 41) { if (PHM(1)) phase_ffn_up(a, lds, ph == 41, wv_); return; }
    if (ph == 2 || ph == 42) { if (PHM(2)) phase_ffn_down(a, lds, ph == 42, wv_); return; }
    if (ph == 3) { if (PHM(3)) phase_norm(a, a.in[6], wv_); return; }
    if (ph == 40) { if (PHM(3)) phase_norm(a, a.in[22], wv_); return; }
    if (ph == 39) { if (PHM(16)) phase_wout(a, lds, 0, wv_); return; }
    if (ph == 43) { if (PHM(4)) phase_final_norm(a, wv_); return; }
    const int s = (ph - 4) / 7, sub = (ph - 4) % 7;
    switch (sub) {
    case 0: if (PHM(5)) phase_win(a, lds, s, wv_); break;
    case 1: if (PHM(6)) phase_small(a, wv_); break;
    case 2: {
        if (PHM(7)) { pg8::Gemm g{(const bf16_t*)(ws + WS_CQN), (const bf16_t*)(ws + WS_WUQ)}; pg8::EpiQ E{(bf16_t*)(ws + WS_Q), (const float*)(ws + WS_COS), (const float*)(ws + WS_SIN)};
          pg8::gemm_phase<pg8::EpiQ, SEQ, NQ, 512, 512, 0, 0>(lds, g, E, wv_); }
        if (PHM(15)) phase_kv(a, lds, wv_);
        if (PHM(8)) { pg8::Gemm g{(const bf16_t*)(ws + WS_XC), (const bf16_t*)(ws + WS_WG)};
          pg8::EpiGates E{(const bf16_t*)(ws + WS_XC), a.in[16], a.in[18], (const float*)(ws + WS_C8), (bf16_t*)(ws + WS_AF), (bf16_t*)(ws + WS_UF), (size_t)(WS_AB - WS_AF) / 2};
          pg8::gemm_phase<pg8::EpiGates, SEQ, 8192, 128, DM, 16, 128>(lds, g, E, wv_); }
        break; }
    case 3: if (PHM(9)) phase_attention(a, (char*)lds_g, wv_); if (PHM(10)) phase_scan1(a, wv_); break;
    case 4: {
        if (PHM(11)) phase_scan15(a, wv_);
        if (PHM(12)) { pg8::Gemm g{(const bf16_t*)(ws + WS_ATTO), (const bf16_t*)(ws + WS_WOA)}; pg8::EpiT1 E{(const bf16_t*)(ws + WS_PROJ) + C_GA, NINP, (bf16_t*)(ws + WS_T1)};
        pg8::gemm_phase<pg8::EpiT1, SEQ, DM, DM, DM, 0, 0>(lds, g, E, wv_); } break; }
    case 5: if (PHM(13)) phase_scan2(a, wv_); break;
    case 6: {
        if (PHM(14)) { pg8::Gemm g{(const bf16_t*)(ws + WS_YG), (const bf16_t*)(ws + WS_WOR)}; pg8::EpiMerge E{(const bf16_t*)(ws + WS_PROJ) + C_GR, NINP, (const bf16_t*)(ws + WS_T1), (bf16_t*)(ws + WS_H) + (size_t)s * SEQ * DM};
        pg8::gemm_phase<pg8::EpiMerge, SEQ, DM, DM, DM, 0, 0>(lds, g, E, wv_); } break; }
    default: break;
    }
}

__global__ void __launch_bounds__(512, 2) mega(Args a) {
    extern __shared__ __attribute__((aligned(16))) unsigned char lds[];
    cg::grid_group grid = cg::this_grid();
    const int wv_ = __builtin_amdgcn_readfirstlane(threadIdx.x >> 6);
    volatile LAS unsigned* misc = (volatile LAS unsigned*)((LAS unsigned char*)lds + (LDS_BYTES - 64));
    if (threadIdx.x < 2) misc[threadIdx.x] = 0u;
    __syncthreads();
    XcdBarrier bar = xcd_barrier_post((unsigned*)(a.ws + WS_CTL), misc);
    for (int ph = a.ph_lo; ph < a.ph_hi; ++ph) {
#ifdef PROBE_REPEAT
        if (PROBE_REPEAT(ph)) { run_phase(a, ph, lds, wv_); xcd_barrier(bar); }
#endif
        run_phase(a, ph, lds, wv_);
        if (ph + 1 < a.ph_hi) { if (ph == a.ph_lo) grid.sync(); else xcd_barrier(bar); }
    }
}

extern "C" void kernel_launch(void* const* d_in, const int* in_sizes, int n_in, void* d_out, int out_size, void* d_ws, size_t ws_size, hipStream_t stream) {
    static int grid = 0;
    if (grid == 0) {
        if (n_in != 27 || out_size != MTOT * DM || ws_size < WS_END) { fprintf(stderr, "kernel_launch: unexpected shapes: n_in %d out %d ws %zu (need %zu)\n", n_in, out_size, ws_size, (size_t)WS_END); grid = -1; return; }
        int dev = 0, cus = 0, per_cu = 0;
        (void)hipGetDevice(&dev); (void)hipDeviceGetAttribute(&cus, hipDeviceAttributeMultiprocessorCount, dev);
        if (hipFuncSetAttribute((const void*)mega, hipFuncAttributeMaxDynamicSharedMemorySize, LDS_BYTES) != hipSuccess) { fprintf(stderr, "kernel_launch: hipFuncSetAttribute failed\n"); grid = -1; return; }
        (void)hipOccupancyMaxActiveBlocksPerMultiprocessor(&per_cu, (const void*)mega, 512, LDS_BYTES);
        if (per_cu < 1) { fprintf(stderr, "kernel_launch: occupancy query says %d blocks/CU\n", per_cu); per_cu = 1; }
        (void)hipGetLastError();
        grid = cus;
    }
    if (grid < 0) return;
    if (hipMemsetAsync((char*)d_ws + WS_CTL, 0, CTL_BYTES, stream) != hipSuccess) { fprintf(stderr, "kernel_launch: hipMemsetAsync failed\n"); return; }
    Args a{};
    for (int i = 0; i < 27; ++i) a.in[i] = (const float*)d_in[i];
    a.out = (float*)d_out; a.ws = (unsigned char*)d_ws;
#if MK_ONE_LAUNCH
    a.ph_lo = 0; a.ph_hi = NPH;
    { void* args[] = {&a}; hipError_t e = hipLaunchCooperativeKernel((const void*)mega, dim3(grid), dim3(512), args, LDS_BYTES, stream);
      if (e != hipSuccess) fprintf(stderr, "cooperative launch failed: %s (grid %d)\n", hipGetErrorString(e), grid); }
#else
    for (int ph = 0; ph < NPH; ++ph) {
        a.ph_lo = ph; a.ph_hi = ph + 1;
        void* args[] = {&a}; hipError_t e = hipLaunchCooperativeKernel((const void*)mega, dim3(grid), dim3(512), args, LDS_BYTES, stream);
        if (e != hipSuccess) { fprintf(stderr, "cooperative launch %d failed: %s (grid %d)\n", ph, hipGetErrorString(e), grid); break; }
    }
#endif
}
```

```cpp
#include <hip/hip_runtime.h>
#include <hip/hip_cooperative_groups.h>
#include <cstdio>
#include <cstdint>
namespace cg = cooperative_groups;

#ifndef MK_ONE_LAUNCH
#define MK_ONE_LAUNCH 1
#endif
#ifndef PH_MASK
#define PH_MASK 0xffffffffu
#endif
#define PHM(k) (((PH_MASK) >> (k)) & 1u)
#define LAUNDER_IDS int tidx_ = wv_ * 64 + (int)__builtin_amdgcn_mbcnt_hi(~0u, __builtin_amdgcn_mbcnt_lo(~0u, 0u)), bidx_ = blockIdx.x; asm volatile("" : "+v"(tidx_), "+s"(bidx_))

#define LAS __attribute__((address_space(3)))
typedef unsigned short bf16_t;
typedef short bf16x8 __attribute__((ext_vector_type(8)));
typedef short s16x4 __attribute__((ext_vector_type(4)));
typedef float f32x4 __attribute__((ext_vector_type(4)));
typedef float f32x2 __attribute__((ext_vector_type(2)));
typedef float f32x16 __attribute__((ext_vector_type(16)));
typedef unsigned u32x4 __attribute__((ext_vector_type(4)));
typedef unsigned u32x2 __attribute__((ext_vector_type(2)));

constexpr int DM = 2048, SEQ = 8192, NSEQ = 5, MTOT = NSEQ * SEQ, DFF = 5632;
constexpr int NIN = 9280, NINP = 9472;
constexpr int NQ = 3072, NKV = 4096;
constexpr int C_CQ = 0, C_CKV = 512, C_KPE = 1024, C_XREC = 1088, C_GREC = 3136, C_GA = 5184, C_GR = 7232;
constexpr float RMS_EPS = 1e-6f;
constexpr float QSCALE = 0.07216878364870322f * 1.4426950408889634f;

constexpr size_t MiB = 1u << 20;
constexpr size_t WS_COS = 0, WS_SIN = 1 * MiB, WS_C8 = 2 * MiB, WS_CTL = 3 * MiB, CTL_BYTES = 16384;
constexpr size_t WS_W1GU = 4 * MiB, WS_W1D = 48 * MiB, WS_W2GU = 70 * MiB, WS_W2D = 114 * MiB, WS_WIN = 136 * MiB, WS_WUQ = 173 * MiB,
                 WS_WUKV = 176 * MiB, WS_WOA = 180 * MiB, WS_WOR = 188 * MiB, WS_WOUT = 196 * MiB, WS_WG = 204 * MiB;
constexpr size_t WS_H = 206 * MiB, WS_ACT = 366 * MiB;
constexpr size_t WS_PROJ = 366 * MiB, WS_CQN = 514 * MiB, WS_CKVN = 522 * MiB, WS_KPE = 530 * MiB, WS_XC = 532 * MiB, WS_MERGED = 532 * MiB,
                 WS_Q = 564 * MiB, WS_KV = 612 * MiB, WS_T1 = 564 * MiB, WS_AF = 676 * MiB, WS_UF = 740 * MiB, WS_AB = 804 * MiB, WS_UB = 868 * MiB,
                 WS_ATTO = 932 * MiB, WS_YG = 964 * MiB, WS_AGGA = 996 * MiB, WS_AGGB = 1000 * MiB, WS_CARRY = 1004 * MiB, WS_END = 1008 * MiB;

constexpr int LDS_BYTES = 135168;
constexpr int NPH = 44;

__device__ __forceinline__ float bf2f(unsigned b) { return __uint_as_float(b << 16); }
__device__ __forceinline__ unsigned cvt_pk_bf16(float lo, float hi) { unsigned r; asm volatile("v_cvt_pk_bf16_f32 %0, %1, %2" : "=v"(r) : "v"(lo), "v"(hi)); return r; }
__device__ __forceinline__ float fsigmoid(float x) { return __builtin_amdgcn_rcpf(1.0f + __expf(-x)); }
__device__ __forceinline__ float wave_sum(float v) {
    v += __int_as_float(__builtin_amdgcn_ds_swizzle(__float_as_int(v), 0x041f));
    v += __int_as_float(__builtin_amdgcn_ds_swizzle(__float_as_int(v), 0x081f));
    v += __int_as_float(__builtin_amdgcn_ds_swizzle(__float_as_int(v), 0x101f));
    v += __int_as_float(__builtin_amdgcn_ds_swizzle(__float_as_int(v), 0x201f));
    v += __int_as_float(__builtin_amdgcn_ds_swizzle(__float_as_int(v), 0x401f));
    auto rr = __builtin_amdgcn_permlane32_swap(__float_as_uint(v), __float_as_uint(v), false, false);
    return __uint_as_float(rr[0]) + __uint_as_float(rr[1]);
}
__device__ __forceinline__ float gelu_tanh(float x) {
    const float z = 0.7978845608028654f * (x + 0.044715f * x * x * x);
    const float e = __expf(2.0f * z);
    const float t = 1.0f - 2.0f * __builtin_amdgcn_rcpf(1.0f + e);
    return 0.5f * x * (1.0f + t);
}

namespace pg8 {
constexpr int BM = 256, BK = 64, HALF = 128, HTB = HALF * BK * 2, STAGE_BYTES = 8 * HTB, NXCD = 8, WGM = 4;
__host__ __device__ __forceinline__ int lds_byte(int r, int c) { const int st = (r >> 4) * 2 + (c >> 5), rr = r & 15, cc = c & 31, ob = rr * 64 + cc * 2; return st * 1024 + (ob ^ (((ob >> 9) & 1) << 5)); }
__host__ __device__ __forceinline__ void stage_rc(int b, int& R, int& C) { const int st = b / 1024, sb = b % 1024, swz = sb ^ (((sb >> 9) & 1) << 5); R = (st >> 1) * 16 + swz / 64; C = (st & 1) * 32 + (swz % 64) / 2; }
__host__ __device__ __forceinline__ int perm32(int rho) { const int n = rho >> 4, i = rho & 15; return 8 * (i >> 2) + 4 * n + (i & 3); }

struct Unit { int pm, pn; };
struct Gemm { const bf16_t* A; const bf16_t* Bt; };

struct StaticOrder {
    int nM, nN, nwg, G, c;
    __device__ void init(int M, int N, int G_, int c_) { nM = M / BM; nN = N / BM; nwg = nM * nN; G = G_; c = c_; }
    __device__ bool next(int i, Unit& u) const {
        const long L = (long)i * G + c; if (L >= nwg) return false;
        int wgid = (int)L; { const int q = nwg / NXCD, r = nwg % NXCD, xcd = wgid % NXCD, off = wgid / NXCD; wgid = (xcd < r ? xcd * (q + 1) : r * (q + 1) + (xcd - r) * q) + off; }
        const int nig = WGM * nN, gid = wgid / nig, fm = gid * WGM, gsz = (nM - fm) < WGM ? (nM - fm) : WGM;
        u.pm = fm + ((wgid % nig) % gsz); u.pn = (wgid % nig) / gsz; return true;
    }
};

template <class Epi, int GM, int GN, int GK, int LDA, int AMOD, int ASTRIDE>
__device__ __forceinline__ void gemm_phase(LAS unsigned char* lds, const Gemm g, const Epi& E, int wv_) {
    int tid_ = wv_ * 64 + (int)__builtin_amdgcn_mbcnt_hi(~0u, __builtin_amdgcn_mbcnt_lo(~0u, 0u)), bid_ = blockIdx.x; asm volatile("" : "+v"(tid_), "+s"(bid_));
    const int tid = tid_, wid = __builtin_amdgcn_readfirstlane(tid >> 6), lane = tid & 63, wr = wid >> 2, wc = wid & 3, fr = lane & 15, fq = lane >> 4;
    constexpr int K = GK, lda = LDA; int nt = K / BK; asm volatile("" : "+s"(nt));
    StaticOrder S; S.init(GM, GN, (int)gridDim.x, bid_);
    unsigned voffA[2], voffB[2];
#pragma unroll
    for (int i = 0; i < 2; ++i) { int R, C; stage_rc(tid * 16 + i * 8192, R, C); const int Rb = Epi::PERM ? ((R & ~31) + perm32(R & 31)) : R;
        voffA[i] = (unsigned)(R * lda + C) * 2u; voffB[i] = (unsigned)(Rb * K + C) * 2u; }
    const size_t kstep = (size_t)(BK * 2);
    const size_t hstepA = (size_t)HALF * lda * 2, tstepA = 2 * hstepA;
    const size_t hstepB = (size_t)HALF * K * 2, tstepB = 2 * hstepB;
    const unsigned ldsw = (unsigned)wid * 1024u;
    const int aoff = lds_byte(wr * 64 + fr, fq * 8), boff = lds_byte(wc * 32 + fr, fq * 8);
#define PG8_SA(b, h) (((b) * 2 + (h)) * HTB)
#define PG8_SB(b, h) ((4 + (b) * 2 + (h)) * HTB)
#define PG8_STAGE(bufoff, gbase, voff) do { _Pragma("unroll") for (int _i = 0; _i < 2; ++_i) \
        __builtin_amdgcn_global_load_lds((const unsigned*)((const char*)(gbase) + (voff)[_i]), (LAS unsigned*)(lds + (bufoff) + ldsw + _i * 8192), 16, 0, 0); } while (0)
#define PG8_LDA(dst, b, h) do { _Pragma("unroll") for (int m = 0; m < 4; ++m) _Pragma("unroll") for (int k = 0; k < 2; ++k) dst[m][k] = *(const LAS bf16x8*)(lds + PG8_SA(b, h) + aoff + m * 2048 + k * 1024); } while (0)
#define PG8_LDB(dst, b, h) do { _Pragma("unroll") for (int n = 0; n < 2; ++n) _Pragma("unroll") for (int k = 0; k < 2; ++k) dst[n][k] = *(const LAS bf16x8*)(lds + PG8_SB(b, h) + boff + n * 2048 + k * 1024); } while (0)
#define PG8_MMA(ai, bj, At, Bt) do { __builtin_amdgcn_s_setprio(1); _Pragma("unroll") for (int m = 0; m < 4; ++m) _Pragma("unroll") for (int n = 0; n < 2; ++n) _Pragma("unroll") for (int k = 0; k < 2; ++k) \
        acc[ai][bj][m][n] = __builtin_amdgcn_mfma_f32_16x16x32_bf16(Bt[n][k], At[m][k], acc[ai][bj][m][n], 0, 0, 0); __builtin_amdgcn_s_setprio(0); } while (0)
#define PG8_WAIT_V(n) asm volatile("s_waitcnt vmcnt(" #n ")" ::: "memory")
#define PG8_WAIT_L(n) asm volatile("s_waitcnt lgkmcnt(" #n ")" ::: "memory")
#define PG8_BAR __builtin_amdgcn_s_barrier()
#define PG8_SCHED __builtin_amdgcn_sched_barrier(0)
#define PG8_AOFF(pn) (AMOD ? (size_t)((pn) % (AMOD ? AMOD : 1)) * (size_t)ASTRIDE * 2 : (size_t)0)
    Unit cur, nxt; int ui = 0;
    if (!S.next(0, cur)) return;
    f32x4 acc[2][2][4][2];
#pragma unroll
    for (int a = 0; a < 2; ++a)
#pragma unroll
        for (int b = 0; b < 2; ++b)
#pragma unroll
            for (int m = 0; m < 4; ++m)
#pragma unroll
                for (int n = 0; n < 2; ++n) acc[a][b][m][n] = (f32x4){0.f, 0.f, 0.f, 0.f};
    bf16x8 At[4][2], B0[2][2], B1[2][2];
    const char* cA = (const char*)g.A + (size_t)cur.pm * tstepA + PG8_AOFF(cur.pn); const char* cB = (const char*)g.Bt + (size_t)cur.pn * tstepB;
    PG8_STAGE(PG8_SB(0, 0), cB, voffB); PG8_STAGE(PG8_SB(0, 1), cB + hstepB, voffB); PG8_STAGE(PG8_SA(0, 0), cA, voffA); PG8_STAGE(PG8_SA(0, 1), cA + hstepA, voffA);
    if (wr == 1) PG8_BAR;
    PG8_WAIT_V(2); PG8_BAR;
    PG8_STAGE(PG8_SB(1, 0), cB + kstep, voffB); PG8_STAGE(PG8_SA(1, 0), cA + kstep, voffA); PG8_STAGE(PG8_SB(1, 1), cB + hstepB + kstep, voffB);
    PG8_WAIT_V(6); PG8_BAR;
    for (;;) {
        const bool has_next = S.next(ui + 1, nxt);
        const char* nA = has_next ? (const char*)g.A + (size_t)nxt.pm * tstepA + PG8_AOFF(nxt.pn) : cA; const char* nB = has_next ? (const char*)g.Bt + (size_t)nxt.pn * tstepB : cB;
        for (int t = 0; t < nt; t += 2) {
            const bool last = (t == nt - 2);
            const char* a1 = cA + (size_t)(t + 1) * kstep;
            const char* a2 = last ? nA : cA + (size_t)(t + 2) * kstep; const char* b2 = last ? nB : cB + (size_t)(t + 2) * kstep;
            const char* a3 = a2 + kstep; const char* b3 = b2 + kstep;
            PG8_LDB(B0, 0, 0); PG8_LDB(B1, 0, 1); PG8_SCHED; PG8_LDA(At, 0, 0); PG8_STAGE(PG8_SA(1, 1), a1 + hstepA, voffA);
            PG8_WAIT_V(8); PG8_WAIT_L(0); PG8_BAR; PG8_MMA(0, 0, At, B0); PG8_MMA(0, 1, At, B1); PG8_BAR; PG8_SCHED;
            PG8_LDA(At, 0, 1); PG8_STAGE(PG8_SB(0, 0), b2, voffB); PG8_STAGE(PG8_SB(0, 1), b2 + hstepB, voffB); PG8_STAGE(PG8_SA(0, 0), a2, voffA);
            PG8_WAIT_V(8); PG8_WAIT_L(0); PG8_BAR; PG8_MMA(1, 0, At, B0); PG8_MMA(1, 1, At, B1); PG8_BAR; PG8_SCHED;
            PG8_LDB(B0, 1, 0); PG8_LDB(B1, 1, 1); PG8_SCHED; PG8_LDA(At, 1, 0); PG8_STAGE(PG8_SA(0, 1), a2 + hstepA, voffA);
            PG8_WAIT_V(8); PG8_WAIT_L(0); PG8_BAR; PG8_MMA(0, 0, At, B0); PG8_MMA(0, 1, At, B1); PG8_BAR; PG8_SCHED;
            PG8_LDA(At, 1, 1); PG8_STAGE(PG8_SB(1, 0), b3, voffB); PG8_STAGE(PG8_SB(1, 1), b3 + hstepB, voffB); PG8_STAGE(PG8_SA(1, 0), a3, voffA);
            PG8_WAIT_V(8); PG8_WAIT_L(0); PG8_BAR; PG8_MMA(1, 0, At, B0); PG8_MMA(1, 1, At, B1); PG8_BAR; PG8_SCHED;
        }
        if (wr == 0) PG8_BAR;
        { int fr2 = fr, fq2 = fq; asm volatile("" : "+v"(fr2), "+v"(fq2)); E(acc, cur, wr, wc, fr2, fq2); }
        if (!has_next) break;
#pragma unroll
        for (int a = 0; a < 2; ++a)
#pragma unroll
            for (int b = 0; b < 2; ++b)
#pragma unroll
                for (int m = 0; m < 4; ++m)
#pragma unroll
                    for (int n = 0; n < 2; ++n) acc[a][b][m][n] = (f32x4){0.f, 0.f, 0.f, 0.f};
        cur = nxt; cA = nA; cB = nB; ++ui;
        if (wr == 1) PG8_BAR;
    }
    PG8_WAIT_V(0);
    PG8_BAR;
#undef PG8_SA
#undef PG8_SB
#undef PG8_STAGE
#undef PG8_LDA
#undef PG8_LDB
#undef PG8_MMA
#undef PG8_WAIT_V
#undef PG8_WAIT_L
#undef PG8_BAR
#undef PG8_SCHED
#undef PG8_AOFF
}

typedef f32x4 Acc[2][2][4][2];

struct EpiBf16 {
    static constexpr bool PERM = true;
    bf16_t* O; int ldc;
    __device__ __forceinline__ void operator()(const Acc& acc, const Unit& u, int wr, int wc, int fr, int fq) const {
        const int row0 = u.pm * BM + wr * 64 + fr, col0 = u.pn * BM + wc * 32 + 8 * fq;
#pragma unroll
        for (int ai = 0; ai < 2; ++ai)
#pragma unroll
            for (int m = 0; m < 4; ++m) { bf16_t* rowp = O + (size_t)(row0 + ai * HALF + m * 16) * ldc + col0;
#pragma unroll
                for (int bj = 0; bj < 2; ++bj) { const f32x4 v0 = acc[ai][bj][m][0], v1 = acc[ai][bj][m][1];
                    u32x4 w; w.x = cvt_pk_bf16(v0[0], v0[1]); w.y = cvt_pk_bf16(v0[2], v0[3]); w.z = cvt_pk_bf16(v1[0], v1[1]); w.w = cvt_pk_bf16(v1[2], v1[3]);
                    *(u32x4*)(rowp + bj * HALF) = w; } asm volatile("" ::: "memory"); }
    }
};
struct EpiSwiglu {
    static constexpr bool PERM = true;
    bf16_t* O; int ldc;
    __device__ __forceinline__ void operator()(const Acc& acc, const Unit& u, int wr, int wc, int fr, int fq) const {
        const int row0 = u.pm * BM + wr * 64 + fr, col0 = u.pn * HALF + wc * 32 + 8 * fq;
#pragma unroll
        for (int ai = 0; ai < 2; ++ai)
#pragma unroll
            for (int m = 0; m < 4; ++m) { bf16_t* rowp = O + (size_t)(row0 + ai * HALF + m * 16) * ldc + col0;
                float r[8];
#pragma unroll
                for (int n = 0; n < 2; ++n)
#pragma unroll
                    for (int j = 0; j < 4; ++j) { const float gv = acc[ai][0][m][n][j], uv = acc[ai][1][m][n][j]; r[n * 4 + j] = gv * fsigmoid(gv) * uv; }
                u32x4 w; w.x = cvt_pk_bf16(r[0], r[1]); w.y = cvt_pk_bf16(r[2], r[3]); w.z = cvt_pk_bf16(r[4], r[5]); w.w = cvt_pk_bf16(r[6], r[7]);
                *(u32x4*)rowp = w; asm volatile("" ::: "memory"); }
    }
};
struct EpiResid {
    static constexpr bool PERM = false;
    const float* res0; const float* res1; int split; float* out; float alpha; int row_base;
    __device__ __forceinline__ void operator()(const Acc& acc, const Unit& u, int wr, int wc, int fr, int fq) const {
        const int grow0 = row_base + u.pm * BM; const float* rb = grow0 < split ? res0 + (size_t)grow0 * DM : res1 + (size_t)(grow0 - split) * DM;
        float* ob = out + (size_t)grow0 * DM; const int col0 = u.pn * BM + wc * 32 + 4 * fq;
#pragma unroll
        for (int ai = 0; ai < 2; ++ai)
#pragma unroll
            for (int m = 0; m < 4; ++m) { const size_t off = (size_t)(ai * HALF + wr * 64 + m * 16 + fr) * DM + col0;
#pragma unroll
                for (int bj = 0; bj < 2; ++bj)
#pragma unroll
                    for (int n = 0; n < 2; ++n) { const f32x4 bs = *(const f32x4*)(rb + off + bj * HALF + n * 16); *(f32x4*)(ob + off + bj * HALF + n * 16) = bs + acc[ai][bj][m][n] * alpha; } asm volatile("" ::: "memory"); }
    }
};
struct EpiQ {
    static constexpr bool PERM = true;
    bf16_t* O; const float* cosT; const float* sinT;
    __device__ __forceinline__ void operator()(const Acc& acc, const Unit& u, int wr, int wc, int fr, int fq) const {
        const int row0 = u.pm * BM + wr * 64 + fr;
#pragma unroll
        for (int bj = 0; bj < 2; ++bj) { const int col0 = u.pn * BM + bj * HALF + wc * 32 + 8 * fq; const int d = col0 % 192; const bool rope = d >= 128; const int jp0 = (d - 128) >> 1;
#pragma unroll
            for (int ai = 0; ai < 2; ++ai)
#pragma unroll
                for (int m = 0; m < 4; ++m) { const int row = row0 + ai * HALF + m * 16; f32x4 v0 = acc[ai][bj][m][0], v1 = acc[ai][bj][m][1];
                    if (rope) { const f32x4 c = *(const f32x4*)(cosT + (size_t)row * 32 + jp0), s = *(const f32x4*)(sinT + (size_t)row * 32 + jp0);
                        const f32x4 a0 = v0, a1 = v1;
                        v0[0] = a0[0] * c[0] - a0[1] * s[0]; v0[1] = a0[1] * c[0] + a0[0] * s[0]; v0[2] = a0[2] * c[1] - a0[3] * s[1]; v0[3] = a0[3] * c[1] + a0[2] * s[1];
                        v1[0] = a1[0] * c[2] - a1[1] * s[2]; v1[1] = a1[1] * c[2] + a1[0] * s[2]; v1[2] = a1[2] * c[3] - a1[3] * s[3]; v1[3] = a1[3] * c[3] + a1[2] * s[3]; }
                    v0 = v0 * QSCALE; v1 = v1 * QSCALE;
                    u32x4 w; w.x = cvt_pk_bf16(v0[0], v0[1]); w.y = cvt_pk_bf16(v0[2], v0[3]); w.z = cvt_pk_bf16(v1[0], v1[1]); w.w = cvt_pk_bf16(v1[2], v1[3]);
                    *(u32x4*)(O + (size_t)row * NQ + col0) = w; asm volatile("" ::: "memory"); } }
    }
};
struct EpiGates {
    static constexpr bool PERM = true;
    const bf16_t* xc; const float* b_a; const float* b_i; const float* c8; bf16_t* Aout; bf16_t* Uout; size_t dir_stride;
    __device__ __forceinline__ void operator()(const Acc& acc, const Unit& u, int wr, int wc, int fr, int fq) const {
        const int dir = u.pn >> 4, blk = u.pn & 15; const int row0 = u.pm * BM + wr * 64 + fr; const int ch0 = blk * HALF + wc * 32 + 8 * fq;
        bf16_t* Ao = Aout + (size_t)dir * dir_stride; bf16_t* Uo = Uout + (size_t)dir * dir_stride;
        f32x4 ba[2], bi[2], cc[2];
#pragma unroll
        for (int n = 0; n < 2; ++n) { ba[n] = *(const f32x4*)(b_a + dir * DM + ch0 + 4 * n); bi[n] = *(const f32x4*)(b_i + dir * DM + ch0 + 4 * n); cc[n] = *(const f32x4*)(c8 + dir * DM + ch0 + 4 * n); }
#pragma unroll
        for (int ai = 0; ai < 2; ++ai)
#pragma unroll
            for (int m = 0; m < 4; ++m) { const int row = row0 + ai * HALF + m * 16; const size_t off = (size_t)row * DM + ch0;
                const u32x4 xw = *(const u32x4*)(xc + off);
                const float xv[8] = {bf2f(xw.x & 0xffffu), bf2f(xw.x >> 16), bf2f(xw.y & 0xffffu), bf2f(xw.y >> 16), bf2f(xw.z & 0xffffu), bf2f(xw.z >> 16), bf2f(xw.w & 0xffffu), bf2f(xw.w >> 16)};
                float om[8], uv[8];
#pragma unroll
                for (int n = 0; n < 2; ++n)
#pragma unroll
                    for (int j = 0; j < 4; ++j) { const float r = fsigmoid(acc[ai][0][m][n][j] + ba[n][j]), ig = fsigmoid(acc[ai][1][m][n][j] + bi[n][j]);
                        const float y = r * cc[n][j];
                        float o1 = y * (1.0f - y * (0.5f - y * (0.16666667f - y * (0.041666668f - y * 0.008333334f))));
                        if (__builtin_expect(__any(y >= 0.125f), 0)) { const float ome = 1.0f - __expf(-y); o1 = y < 0.125f ? o1 : ome; }
                        om[n * 4 + j] = o1; uv[n * 4 + j] = sqrtf(o1 * (2.0f - o1)) * (ig * xv[n * 4 + j]); }
                u32x4 wa, wu; wa.x = cvt_pk_bf16(om[0], om[1]); wa.y = cvt_pk_bf16(om[2], om[3]); wa.z = cvt_pk_bf16(om[4], om[5]); wa.w = cvt_pk_bf16(om[6], om[7]);
                wu.x = cvt_pk_bf16(uv[0], uv[1]); wu.y = cvt_pk_bf16(uv[2], uv[3]); wu.z = cvt_pk_bf16(uv[4], uv[5]); wu.w = cvt_pk_bf16(uv[6], uv[7]);
                *(u32x4*)(Ao + off) = wa; *(u32x4*)(Uo + off) = wu; asm volatile("" ::: "memory"); }
    }
};
struct EpiT1 {
    static constexpr bool PERM = true;
    const bf16_t* gate; int ldg; bf16_t* O;
    __device__ __forceinline__ void operator()(const Acc& acc, const Unit& u, int wr, int wc, int fr, int fq) const {
        const int row0 = u.pm * BM + wr * 64 + fr;
#pragma unroll
        for (int ai = 0; ai < 2; ++ai)
#pragma unroll
            for (int m = 0; m < 4; ++m) { const int row = row0 + ai * HALF + m * 16;
#pragma unroll
                for (int bj = 0; bj < 2; ++bj) { const int col0 = u.pn * BM + bj * HALF + wc * 32 + 8 * fq;
                    const u32x4 gw = *(const u32x4*)(gate + (size_t)row * ldg + col0); f32x4 v0 = acc[ai][bj][m][0], v1 = acc[ai][bj][m][1];
                    v0[0] *= fsigmoid(bf2f(gw.x & 0xffffu)); v0[1] *= fsigmoid(bf2f(gw.x >> 16)); v0[2] *= fsigmoid(bf2f(gw.y & 0xffffu)); v0[3] *= fsigmoid(bf2f(gw.y >> 16));
                    v1[0] *= fsigmoid(bf2f(gw.z & 0xffffu)); v1[1] *= fsigmoid(bf2f(gw.z >> 16)); v1[2] *= fsigmoid(bf2f(gw.w & 0xffffu)); v1[3] *= fsigmoid(bf2f(gw.w >> 16));
                    u32x4 w; w.x = cvt_pk_bf16(v0[0], v0[1]); w.y = cvt_pk_bf16(v0[2], v0[3]); w.z = cvt_pk_bf16(v1[0], v1[1]); w.w = cvt_pk_bf16(v1[2], v1[3]);
                    *(u32x4*)(O + (size_t)row * DM + col0) = w; } asm volatile("" ::: "memory"); }
    }
};
struct EpiMerge {
    static constexpr bool PERM = true;
    const bf16_t* gate; int ldg; const bf16_t* T1; bf16_t* O;
    __device__ __forceinline__ void operator()(const Acc& acc, const Unit& u, int wr, int wc, int fr, int fq) const {
        const int row0 = u.pm * BM + wr * 64 + fr;
#pragma unroll
        for (int ai = 0; ai < 2; ++ai)
#pragma unroll
            for (int m = 0; m < 4; ++m) { const int row = row0 + ai * HALF + m * 16;
#pragma unroll
                for (int bj = 0; bj < 2; ++bj) { const int col0 = u.pn * BM + bj * HALF + wc * 32 + 8 * fq;
                    const u32x4 gw = *(const u32x4*)(gate + (size_t)row * ldg + col0); const u32x4 tw = *(const u32x4*)(T1 + (size_t)row * DM + col0);
                    f32x4 v0 = acc[ai][bj][m][0], v1 = acc[ai][bj][m][1];
                    const f32x4 t0 = {bf2f(tw.x & 0xffffu), bf2f(tw.x >> 16), bf2f(tw.y & 0xffffu), bf2f(tw.y >> 16)}, t1 = {bf2f(tw.z & 0xffffu), bf2f(tw.z >> 16), bf2f(tw.w & 0xffffu), bf2f(tw.w >> 16)};
                    v0[0] = t0[0] + v0[0] * fsigmoid(bf2f(gw.x & 0xffffu)); v0[1] = t0[1] + v0[1] * fsigmoid(bf2f(gw.x >> 16)); v0[2] = t0[2] + v0[2] * fsigmoid(bf2f(gw.y & 0xffffu)); v0[3] = t0[3] + v0[3] * fsigmoid(bf2f(gw.y >> 16));
                    v1[0] = t1[0] + v1[0] * fsigmoid(bf2f(gw.z & 0xffffu)); v1[1] = t1[1] + v1[1] * fsigmoid(bf2f(gw.z >> 16)); v1[2] = t1[2] + v1[2] * fsigmoid(bf2f(gw.w & 0xffffu)); v1[3] = t1[3] + v1[3] * fsigmoid(bf2f(gw.w >> 16));
                    u32x4 w; w.x = cvt_pk_bf16(v0[0], v0[1]); w.y = cvt_pk_bf16(v0[2], v0[3]); w.z = cvt_pk_bf16(v1[0], v1[1]); w.w = cvt_pk_bf16(v1[2], v1[3]);
                    *(u32x4*)(O + (size_t)row * DM + col0) = w; } asm volatile("" ::: "memory"); }
    }
};
}

namespace att {
constexpr int NW = 8, QBLK = 32, KVBLK = 64;
constexpr int LDQ = NQ, LDKV = NKV, LDO = DM;
constexpr int SLOT_K = 24576, SLOT_V = 16384, KR_OFF = 16384;
constexpr int OFF_K = 0, OFF_V = 3 * SLOT_K, OFF_WS = OFF_V + 3 * SLOT_V;
constexpr float THRL = 11.0f;
#define KNSWZ(row, colB) ((row) * 256 + ((colB) ^ (((row) & 15) << 4)))
#define KRSWZ(row, colB) ((row) * 128 + ((colB) ^ ((((row) >> 1) & 7) << 4)))
#define SBAR() __builtin_amdgcn_sched_barrier(0)
__device__ __forceinline__ int crow(int r, int hi) { return (r & 3) + 8 * (r >> 2) + 4 * hi; }

__device__ __forceinline__ void partialSM(f32x16& p0, f32x16& p1, float& m_reg, float& mn, float& alpha) {
    float pmax = p0[0];
#pragma unroll
    for (int r = 1; r < 16; ++r) pmax = fmaxf(pmax, p0[r]);
#pragma unroll
    for (int r = 0; r < 16; ++r) pmax = fmaxf(pmax, p1[r]);
    { auto rr = __builtin_amdgcn_permlane32_swap(__float_as_uint(pmax), __float_as_uint(pmax), false, false);
      pmax = fmaxf(__uint_as_float(rr[0]), __uint_as_float(rr[1])); }
    if (__builtin_expect(__all(pmax - m_reg <= THRL), 1)) { mn = m_reg; alpha = 1.f; }
    else { mn = fmaxf(m_reg, pmax); alpha = __builtin_amdgcn_exp2f(m_reg - mn); m_reg = mn; }
#pragma unroll
    for (int r = 0; r < 16; ++r) p0[r] = p0[r] - mn;
#pragma unroll
    for (int r = 0; r < 16; ++r) p1[r] = p1[r] - mn;
#pragma unroll
    for (int r = 0; r < 16; ++r) p0[r] = __builtin_amdgcn_exp2f(p0[r]);
}
__device__ __forceinline__ void finishSM(f32x16& p0, f32x16& p1, float alpha, float& l_reg, bf16x8& pa0, bf16x8& pa1, bf16x8& pa2, bf16x8& pa3) {
#pragma unroll
    for (int r = 0; r < 16; ++r) p1[r] = __builtin_amdgcn_exp2f(p1[r]);
    float ps = 0;
#pragma unroll
    for (int r = 0; r < 16; ++r) ps += p0[r];
#pragma unroll
    for (int r = 0; r < 16; ++r) ps += p1[r];
    { auto rr = __builtin_amdgcn_permlane32_swap(__float_as_uint(ps), __float_as_uint(ps), false, false);
      ps = __uint_as_float(rr[0]) + __uint_as_float(rr[1]); }
    l_reg = l_reg * alpha + ps;
#define PK4(P, BASE, OUT) do { unsigned a0 = cvt_pk_bf16(P[BASE + 0], P[BASE + 1]), a1 = cvt_pk_bf16(P[BASE + 2], P[BASE + 3]);   \
    unsigned b0 = cvt_pk_bf16(P[BASE + 4], P[BASE + 5]), b1 = cvt_pk_bf16(P[BASE + 6], P[BASE + 7]);                              \
    auto r0 = __builtin_amdgcn_permlane32_swap(a0, b0, false, false); auto r1 = __builtin_amdgcn_permlane32_swap(a1, b1, false, false); \
    u32x4 w = {r0[0], r1[0], r0[1], r1[1]}; OUT = *reinterpret_cast<bf16x8*>(&w); } while (0)
    PK4(p0, 0, pa0); PK4(p0, 8, pa1); PK4(p1, 0, pa2); PK4(p1, 8, pa3);
#undef PK4
}
__device__ __forceinline__ void qkt(f32x16& p0, f32x16& p1, const char* Kn, const bf16x8* qr, int r32, int hi) {
    const char* Kr = Kn + KR_OFF;
    p0 = f32x16{}; p1 = f32x16{};
    __builtin_amdgcn_s_setprio(1);
#pragma unroll
    for (int d0 = 0; d0 < 8; ++d0) { const int cb = (d0 * 16 + hi * 8) * 2;
        const bf16x8 b0 = *reinterpret_cast<const bf16x8*>(Kn + KNSWZ(r32, cb));
        const bf16x8 b1 = *reinterpret_cast<const bf16x8*>(Kn + KNSWZ(32 + r32, cb));
        p0 = __builtin_amdgcn_mfma_f32_32x32x16_bf16(b0, qr[d0], p0, 0, 0, 0);
        p1 = __builtin_amdgcn_mfma_f32_32x32x16_bf16(b1, qr[d0], p1, 0, 0, 0); }
#pragma unroll
    for (int d0 = 0; d0 < 4; ++d0) { const int cb = (d0 * 16 + hi * 8) * 2;
        const bf16x8 b0 = *reinterpret_cast<const bf16x8*>(Kr + KRSWZ(r32, cb));
        const bf16x8 b1 = *reinterpret_cast<const bf16x8*>(Kr + KRSWZ(32 + r32, cb));
        p0 = __builtin_amdgcn_mfma_f32_32x32x16_bf16(b0, qr[8 + d0], p0, 0, 0, 0);
        p1 = __builtin_amdgcn_mfma_f32_32x32x16_bf16(b1, qr[8 + d0], p1, 0, 0, 0); }
}
__device__ __forceinline__ int v_st(int k, int c) { const int kk = (k & ~0xC) | ((k & 4) << 1) | ((k & 8) >> 1); return ((kk >> 3) * 4 + (c >> 5)) * 512 + ((kk & 7) * 32 + (c & 31)) * 2; }
__device__ __forceinline__ int v_rd_base(int lane) { return ((lane & 3) << 3) | (((lane >> 2) & 3) << 6) | (((lane >> 4) & 1) << 5) | (((lane >> 5) & 1) << 8); }
constexpr int v_rd_off(int d0, int ks, int half) { return d0 * 512 + ks * 4096 + half * 2048; }
template <int OFF> __device__ __forceinline__ s16x4 tr_read(int vb) {
    s16x4 r; asm volatile("ds_read_b64_tr_b16 %0, %1 offset:%2" : "=&v"(r) : "v"(vb), "i"(OFF) : "memory"); return r;
}
template <int D0> __device__ __forceinline__ void pv_one(f32x16& od, int vb, bf16x8 pa0, bf16x8 pa1, bf16x8 pa2, bf16x8 pa3) {
    const s16x4 l0 = tr_read<v_rd_off(D0, 0, 0)>(vb), h0 = tr_read<v_rd_off(D0, 0, 1)>(vb), l1 = tr_read<v_rd_off(D0, 1, 0)>(vb), h1 = tr_read<v_rd_off(D0, 1, 1)>(vb);
    const s16x4 l2 = tr_read<v_rd_off(D0, 2, 0)>(vb), h2 = tr_read<v_rd_off(D0, 2, 1)>(vb), l3 = tr_read<v_rd_off(D0, 3, 0)>(vb), h3 = tr_read<v_rd_off(D0, 3, 1)>(vb);
    asm volatile("s_waitcnt lgkmcnt(0)" ::: "memory"); SBAR();
#define PK(L, H) (bf16x8){L[0], L[1], L[2], L[3], H[0], H[1], H[2], H[3]}
    od = __builtin_amdgcn_mfma_f32_32x32x16_bf16(pa0, PK(l0, h0), od, 0, 0, 0);
    od = __builtin_amdgcn_mfma_f32_32x32x16_bf16(pa1, PK(l1, h1), od, 0, 0, 0);
    od = __builtin_amdgcn_mfma_f32_32x32x16_bf16(pa2, PK(l2, h2), od, 0, 0, 0);
    od = __builtin_amdgcn_mfma_f32_32x32x16_bf16(pa3, PK(l3, h3), od, 0, 0, 0);
#undef PK
}
__device__ __forceinline__ void pv_d0(f32x16* o, int vb, bf16x8 pa0, bf16x8 pa1, bf16x8 pa2, bf16x8 pa3) {
    pv_one<0>(o[0], vb, pa0, pa1, pa2, pa3); pv_one<1>(o[1], vb, pa0, pa1, pa2, pa3); pv_one<2>(o[2], vb, pa0, pa1, pa2, pa3); pv_one<3>(o[3], vb, pa0, pa1, pa2, pa3);
}

__device__ __forceinline__ void attn_unit(const bf16_t* __restrict__ Qb, const bf16_t* __restrict__ Kn, const bf16_t* __restrict__ Vh, const bf16_t* __restrict__ Kr,
                                          bf16_t* __restrict__ Ob, int seq, char* lds, int wv_) { LAUNDER_IDS;
    const int tid = tidx_, wid = __builtin_amdgcn_readfirstlane(tid >> 6), lane = tid & 63, r32 = lane & 31, hi = lane >> 5;
    LAS unsigned char* lds3 = (LAS unsigned char*)lds;
    float* ws = (float*)(lds + OFF_WS) + wid * 64; float* li_l = ws; float* al_l = ws + 32;
    float m_reg = -1e30f, l_reg = 0; f32x16 o[4] = {}; bf16x8 qr[12];
    const bf16_t* Qw = Qb + (long)(wid * QBLK + r32) * LDQ + hi * 8;
#pragma unroll
    for (int d0 = 0; d0 < 12; ++d0) qr[d0] = *reinterpret_cast<const bf16x8*>(Qw + d0 * 16);
    unsigned gkn[2], gv[2], gkr;
#pragma unroll
    for (int i = 0; i < 2; ++i) { const int c = wid * 2 + i; const int row = c * 4 + (lane >> 4), slot = lane & 15; gkn[i] = (unsigned)(row * (LDKV * 2) + ((slot ^ (row & 15)) << 4));
        const int st = c * 2 + (lane >> 5), kk = (st >> 2) * 8 + ((lane & 31) >> 2), k = (kk & ~0xC) | ((kk & 4) << 1) | ((kk & 8) >> 1), col = (st & 3) * 32 + (lane & 3) * 8; gv[i] = (unsigned)(k * (LDKV * 2) + col * 2); }
    { const int row = wid * 8 + (lane >> 3), slot = lane & 7; gkr = (unsigned)(row * 128 + ((slot ^ ((row >> 1) & 7)) << 4)); }
    const int vb0 = (int)(uintptr_t)(lds + OFF_V) + v_rd_base(lane);
#define DMA(t, slot) do { const char* kt_ = (const char*)Kn + (size_t)(t) * (KVBLK * LDKV * 2); const char* vt_ = (const char*)Vh + (size_t)(t) * (KVBLK * LDKV * 2); const char* rt_ = (const char*)Kr + (size_t)(t) * (KVBLK * 128); \
    _Pragma("unroll") for (int i_ = 0; i_ < 2; ++i_) { \
      __builtin_amdgcn_global_load_lds((const unsigned*)(kt_ + gkn[i_]), (LAS unsigned*)(lds3 + OFF_K + (slot) * SLOT_K + (wid * 2 + i_) * 1024), 16, 0, 0); \
      __builtin_amdgcn_global_load_lds((const unsigned*)(vt_ + gv[i_]), (LAS unsigned*)(lds3 + OFF_V + (slot) * SLOT_V + (wid * 2 + i_) * 1024), 16, 0, 0); } \
    __builtin_amdgcn_global_load_lds((const unsigned*)(rt_ + gkr), (LAS unsigned*)(lds3 + OFF_K + (slot) * SLOT_K + KR_OFF + wid * 1024), 16, 0, 0); } while (0)
#define WAIT_BAR() asm volatile("s_waitcnt vmcnt(0) lgkmcnt(0)\n\ts_barrier" ::: "memory")
#define RESC(a) do { if (__any((a) < 1.f)) { if (hi == 0) al_l[r32] = (a); asm volatile("s_waitcnt lgkmcnt(0)" ::: "memory"); \
    _Pragma("unroll") for (int d = 0; d < 4; ++d) _Pragma("unroll") for (int r = 0; r < 16; ++r) o[d][r] *= al_l[crow(r, hi)]; } } while (0)
    f32x16 pA0, pA1, pB0, pB1; float mnA, mnB, alA, alB; bf16x8 pa0, pa1, pa2, pa3; const int NT = seq / KVBLK;
    DMA(0, 0); DMA(1, 1); WAIT_BAR();
    qkt(pA0, pA1, lds + OFF_K, qr, r32, hi); __builtin_amdgcn_s_setprio(0); partialSM(pA0, pA1, m_reg, mnA, alA);
    int s_prev = 0, s_cur = 1, s_next = 2;
#define ROT() do { const int t_ = s_prev; s_prev = s_cur; s_cur = s_next; s_next = t_; } while (0)
    for (int j = 1; j + 1 < NT; j += 2) {
        DMA(j + 1, s_next); SBAR();
        qkt(pB0, pB1, lds + OFF_K + s_cur * SLOT_K, qr, r32, hi);
        finishSM(pA0, pA1, alA, l_reg, pa0, pa1, pa2, pa3); __builtin_amdgcn_s_setprio(0); SBAR();
        pv_d0(o, vb0 + s_prev * SLOT_V, pa0, pa1, pa2, pa3); partialSM(pB0, pB1, m_reg, mnB, alB);
        RESC(alB); WAIT_BAR(); ROT();
        DMA(j + 2, s_next); SBAR();
        qkt(pA0, pA1, lds + OFF_K + s_cur * SLOT_K, qr, r32, hi);
        finishSM(pB0, pB1, alB, l_reg, pa0, pa1, pa2, pa3); __builtin_amdgcn_s_setprio(0); SBAR();
        pv_d0(o, vb0 + s_prev * SLOT_V, pa0, pa1, pa2, pa3); partialSM(pA0, pA1, m_reg, mnA, alA);
        RESC(alA); WAIT_BAR(); ROT();
    }
    SBAR(); qkt(pB0, pB1, lds + OFF_K + s_cur * SLOT_K, qr, r32, hi);
    finishSM(pA0, pA1, alA, l_reg, pa0, pa1, pa2, pa3); __builtin_amdgcn_s_setprio(0); SBAR();
    pv_d0(o, vb0 + s_prev * SLOT_V, pa0, pa1, pa2, pa3); partialSM(pB0, pB1, m_reg, mnB, alB);
    RESC(alB);
    finishSM(pB0, pB1, alB, l_reg, pa0, pa1, pa2, pa3); __builtin_amdgcn_s_setprio(0); SBAR();
    pv_d0(o, vb0 + s_cur * SLOT_V, pa0, pa1, pa2, pa3);
    if (hi == 0) li_l[r32] = l_reg; asm volatile("s_waitcnt lgkmcnt(0)" ::: "memory");
    float rli[16];
#pragma unroll
    for (int r = 0; r < 16; ++r) rli[r] = __builtin_amdgcn_rcpf(li_l[crow(r, hi)]);
    bf16_t* Ow = Ob + (long)(wid * QBLK) * LDO;
#pragma unroll
    for (int r = 0; r < 16; ++r) { const int orow = crow(r, hi);
#pragma unroll
        for (int d0 = 0; d0 < 4; ++d0) Ow[(long)orow * LDO + d0 * 32 + r32] = (bf16_t)(cvt_pk_bf16(o[d0][r] * rli[r], 0.f) & 0xffffu); }
    WAIT_BAR();
#undef DMA
#undef WAIT_BAR
#undef RESC
#undef ROT
}
}


#define XB_TMO      128
#define XB_XCNT(j)  (256  + 64 * (j))
#define XB_XSUB(j)  (1280 + 64 * (j))
#define XB_XGEN(j)  (2304 + 64 * (j))
#define XB_TOP      3328
#define XB_TOPGEN   3392
#define XCD_BAR_WORDS 3456
#define XB_SPIN_CAP (1u << 22)
__device__ __forceinline__ unsigned xb_ld(unsigned* p)              { return __hip_atomic_load(p, __ATOMIC_RELAXED, __HIP_MEMORY_SCOPE_AGENT); }
__device__ __forceinline__ unsigned xb_add(unsigned* p, unsigned v) { return __hip_atomic_fetch_add(p, v, __ATOMIC_RELAXED, __HIP_MEMORY_SCOPE_AGENT); }
__device__ __forceinline__ unsigned xb_xcc_id() { return (unsigned)__builtin_amdgcn_s_getreg((3 << 11) | 20) & 0xFu; }
#define XB_SPIN(cond, bar) do { unsigned _sp = 0; while (cond) { __builtin_amdgcn_s_sleep(1); \
    if ((++_sp & 255u) == 0u) { if (xb_ld(&(bar)[XB_TMO])) break; if (_sp > XB_SPIN_CAP) { atomicAdd(&(bar)[XB_TMO], 1u); break; } } } } while (0)
struct XcdBarrier { unsigned* bar; unsigned x; volatile LAS unsigned* st; };
__device__ __forceinline__ XcdBarrier xcd_barrier_post(unsigned* bar, volatile LAS unsigned* st) {
    XcdBarrier b; b.bar = bar; b.x = xb_xcc_id(); b.st = st;
    if (threadIdx.x == 0) (void)xb_add(&bar[XB_XCNT(b.x)], 1u);
    return b;
}
__device__ __forceinline__ void xcd_barrier_complete(unsigned* bar, unsigned x, unsigned& nloc, unsigned& nx) {
    const unsigned G = gridDim.x * gridDim.y * gridDim.z;
    unsigned sum, cnt, mine, sp = 0u;
    for (;;) {
        sum = 0u; cnt = 0u; mine = 0u;
#pragma unroll
        for (unsigned j = 0; j < 16; ++j) { const unsigned c = xb_ld(&bar[XB_XCNT(j)]); sum += c; cnt += (c > 0u) ? 1u : 0u; mine = (j == x) ? c : mine; }
        if (sum == G) break;
        __builtin_amdgcn_s_sleep(1);
        if ((++sp & 255u) == 0u) { if (xb_ld(&bar[XB_TMO])) break; if (sp > XB_SPIN_CAP) { atomicAdd(&bar[XB_TMO], 1u); break; } }
    }
    nloc = mine > 0u ? mine : 1u; nx = cnt > 0u ? cnt : 1u;
}
__device__ __forceinline__ void xcd_barrier(const XcdBarrier& b) {
    asm volatile("s_waitcnt vmcnt(0)" ::: "memory");
    __syncthreads();
    if (threadIdx.x == 0) {
        unsigned* bar = b.bar;
        __builtin_amdgcn_s_waitcnt(0);
        unsigned nloc = b.st[0], nx = b.st[1];
        if (nloc == 0u) { xcd_barrier_complete(bar, b.x, nloc, nx); b.st[0] = nloc; b.st[1] = nx; }
        const unsigned old = xb_add(&bar[XB_XSUB(b.x)], 1u);
        const unsigned gen = old / nloc;
        if (old + 1u == (gen + 1u) * nloc) {
            __builtin_amdgcn_fence(__ATOMIC_RELEASE, "agent");
            asm volatile("s_waitcnt vmcnt(0)" ::: "memory");
            const unsigned og = xb_add(&bar[XB_TOP], 1u);
            const unsigned tg = og / nx;
            if (og + 1u == (tg + 1u) * nx) xb_add(&bar[XB_TOPGEN], 1u);
            else XB_SPIN(xb_ld(&bar[XB_TOPGEN]) == tg, bar);
            __builtin_amdgcn_fence(__ATOMIC_ACQUIRE, "agent");
            xb_add(&bar[XB_XGEN(b.x)], 1u);
            asm volatile("s_waitcnt vmcnt(0)" ::: "memory");
        } else {
            XB_SPIN(xb_ld(&bar[XB_XGEN(b.x)]) == gen, bar);
            __builtin_amdgcn_fence(__ATOMIC_ACQUIRE, "agent");
            asm volatile("s_waitcnt vmcnt(0)" ::: "memory");
        }
    }
    __syncthreads();
}

struct Args { const float* in[27]; float* out; unsigned char* ws; int ph_lo, ph_hi; };

__device__ __forceinline__ int map_row(int mode, int row_off, int n) {
    if (mode == 0) return row_off + n;
    if (mode == 1) return (n >> 7) * 256 + row_off + (n & 127);
    if (mode == 2) { if (n >= C_KPE && n < C_KPE + 64) { const int j = n - C_KPE; return C_KPE + (j < 32 ? 2 * j : 2 * (j - 32) + 1); } return n; }
    { const int h = n / 192, d = n % 192; if (d < 128) return n; const int j = d - 128; return h * 192 + 128 + (j < 32 ? 2 * j : 2 * (j - 32) + 1); }
}
__device__ __forceinline__ void transpose_item(const float* W, int K, int N, bf16_t* WT, int mode, int row_off, LAS float* scr, int item, int lane) {
    const int nblk = N / 32, kb = item / nblk, nb = item % nblk, k0 = 64 * kb, n0 = 32 * nb;
    float wv[32];
#pragma unroll
    for (int i = 0; i < 32; ++i) { const int kk = 2 * i + (lane >> 5); wv[i] = W[(size_t)(k0 + kk) * N + n0 + (lane & 31)]; }
#pragma unroll
    for (int i = 0; i < 32; ++i) { const int kk = 2 * i + (lane >> 5); scr[kk * 33 + (lane & 31)] = wv[i]; }
    asm volatile("s_waitcnt lgkmcnt(0)" ::: "memory");
    const int c = lane & 7;
#pragma unroll
    for (int j = 0; j < 4; ++j) { const int n = (lane >> 3) + 8 * j; const LAS float* s = scr + (8 * c) * 33 + n;
        u32x4 o; o.x = cvt_pk_bf16(s[0 * 33], s[1 * 33]); o.y = cvt_pk_bf16(s[2 * 33], s[3 * 33]); o.z = cvt_pk_bf16(s[4 * 33], s[5 * 33]); o.w = cvt_pk_bf16(s[6 * 33], s[7 * 33]);
        *(u32x4*)(WT + (size_t)map_row(mode, row_off, n0 + n) * K + k0 + 8 * c) = o; }
    asm volatile("s_waitcnt lgkmcnt(0)" ::: "memory");
}

__device__ __forceinline__ void rms_row_bf16(const float* xrow, const float* g, bf16_t* orow, int lane) {
    const f32x4* xr = (const f32x4*)xrow + lane; const f32x4* gr = (const f32x4*)g + lane;
    f32x4 v[8]; float s = 0.f;
#pragma unroll
    for (int j = 0; j < 8; ++j) { v[j] = xr[64 * j]; s += (v[j].x * v[j].x + v[j].y * v[j].y) + (v[j].z * v[j].z + v[j].w * v[j].w); }
    const float rstd = rsqrtf(wave_sum(s) * (1.f / DM) + RMS_EPS);
    u32x2* o8 = (u32x2*)orow + lane;
#pragma unroll
    for (int j = 0; j < 8; ++j) { const f32x4 gg = gr[64 * j]; u32x2 w; w.x = cvt_pk_bf16(v[j].x * rstd * gg.x, v[j].y * rstd * gg.y); w.y = cvt_pk_bf16(v[j].z * rstd * gg.z, v[j].w * rstd * gg.w); o8[64 * j] = w; }
}
__device__ __forceinline__ void rms_row_f32_inplace(float* xrow, const float* g, int lane) {
    f32x4* xr = (f32x4*)xrow + lane; const f32x4* gr = (const f32x4*)g + lane;
    f32x4 v[8]; float s = 0.f;
#pragma unroll
    for (int j = 0; j < 8; ++j) { v[j] = xr[64 * j]; s += (v[j].x * v[j].x + v[j].y * v[j].y) + (v[j].z * v[j].z + v[j].w * v[j].w); }
    const float rstd = rsqrtf(wave_sum(s) * (1.f / DM) + RMS_EPS);
#pragma unroll
    for (int j = 0; j < 8; ++j) { const f32x4 gg = gr[64 * j]; xr[64 * j] = v[j] * rstd * gg; }
}

__device__ __forceinline__ void phase_prologue(const Args& a, LAS unsigned char* lds, int wv_) { LAUNDER_IDS;
    const int tid = tidx_, lane = tid & 63, wave = tid >> 6;
    unsigned char* ws = a.ws;
    LAS float* scr = (LAS float*)(lds + wave * 16384);
    const int gw = bidx_ * 8 + wave, NGW = gridDim.x * 8;
    constexpr int I_GU = (DM / 64) * (DFF / 32), I_D = (DFF / 64) * (DM / 32), I_IN = (DM / 64) * (NIN / 32), I_UQ = (512 / 64) * (NQ / 32), I_UKV = (512 / 64) * (NKV / 32),
                  I_SQ = (DM / 64) * (DM / 32), I_G = 64 * 8;
    constexpr int NITEMS = 4 * I_GU + 2 * I_D + I_IN + I_UQ + I_UKV + 3 * I_SQ + I_G;
    for (int it = gw; it < NITEMS; it += NGW) {
        int r = it;
        if (r < I_GU) { transpose_item(a.in[3], DM, DFF, (bf16_t*)(ws + WS_W1GU), 1, 0, scr, r, lane); continue; } r -= I_GU;
        if (r < I_GU) { transpose_item(a.in[4], DM, DFF, (bf16_t*)(ws + WS_W1GU), 1, 128, scr, r, lane); continue; } r -= I_GU;
        if (r < I_GU) { transpose_item(a.in[23], DM, DFF, (bf16_t*)(ws + WS_W2GU), 1, 0, scr, r, lane); continue; } r -= I_GU;
        if (r < I_GU) { transpose_item(a.in[24], DM, DFF, (bf16_t*)(ws + WS_W2GU), 1, 128, scr, r, lane); continue; } r -= I_GU;
        if (r < I_D) { transpose_item(a.in[5], DFF, DM, (bf16_t*)(ws + WS_W1D), 0, 0, scr, r, lane); continue; } r -= I_D;
        if (r < I_D) { transpose_item(a.in[25], DFF, DM, (bf16_t*)(ws + WS_W2D), 0, 0, scr, r, lane); continue; } r -= I_D;
        if (r < I_IN) { transpose_item(a.in[7], DM, NIN, (bf16_t*)(ws + WS_WIN), 2, 0, scr, r, lane); continue; } r -= I_IN;
        if (r < I_UQ) { transpose_item(a.in[9], 512, NQ, (bf16_t*)(ws + WS_WUQ), 3, 0, scr, r, lane); continue; } r -= I_UQ;
        if (r < I_UKV) { transpose_item(a.in[11], 512, NKV, (bf16_t*)(ws + WS_WUKV), 0, 0, scr, r, lane); continue; } r -= I_UKV;
        if (r < I_SQ) { transpose_item(a.in[12], DM, DM, (bf16_t*)(ws + WS_WOA), 0, 0, scr, r, lane); continue; } r -= I_SQ;
        if (r < I_SQ) { transpose_item(a.in[20], DM, DM, (bf16_t*)(ws + WS_WOR), 0, 0, scr, r, lane); continue; } r -= I_SQ;
        if (r < I_SQ) { transpose_item(a.in[21], DM, DM, (bf16_t*)(ws + WS_WOUT), 0, 0, scr, r, lane); continue; } r -= I_SQ;
        { const int mat = r >> 3, sub = r & 7, type = mat & 1, db = mat >> 1;
          transpose_item((type ? a.in[17] : a.in[15]) + (size_t)db * 128 * 128, 128, 128, (bf16_t*)(ws + WS_WG), 0, mat * 128, scr, sub, lane); }
    }
    { const int gt = bidx_ * 512 + tid, NT = gridDim.x * 512; u32x4* p = (u32x4*)((bf16_t*)(ws + WS_WIN) + (size_t)NIN * DM);
      for (int i = gt; i < (NINP - NIN) * DM / 8; i += NT) p[i] = (u32x4){0u, 0u, 0u, 0u}; }
    { const int gt = bidx_ * 512 + tid, NT = gridDim.x * 512; float* cosT = (float*)(ws + WS_COS); float* sinT = (float*)(ws + WS_SIN); float* c8 = (float*)(ws + WS_C8);
      for (int i = gt; i < SEQ * 32; i += NT) { const int pos = i >> 5, j = i & 31; const float inv = powf(10000.0f, -(float)(2 * j) / 64.0f); const float ang = (float)pos * inv; cosT[i] = cosf(ang); sinT[i] = sinf(ang); }
      for (int i = gt; i < 2 * DM; i += NT) { const float l = a.in[19][i]; const float sp = (-l > 20.f) ? -l : log1pf(expf(-l)); c8[i] = 8.0f * sp; } }
    for (int m = gw; m < MTOT; m += NGW) { const float* xr = m < SEQ ? a.in[0] + (size_t)m * DM : a.in[1] + (size_t)(m - SEQ) * DM; rms_row_bf16(xr, a.in[2], (bf16_t*)(ws + WS_H) + (size_t)m * DM, lane); }
}

__device__ __forceinline__ void phase_norm(const Args& a, const float* g, int wv_) { LAUNDER_IDS;
    const int lane = tidx_ & 63, gw = bidx_ * 8 + (tidx_ >> 6), NGW = gridDim.x * 8;
    for (int m = gw; m < MTOT; m += NGW) rms_row_bf16(a.out + (size_t)m * DM, g, (bf16_t*)(a.ws + WS_H) + (size_t)m * DM, lane);
}
__device__ __forceinline__ void phase_final_norm(const Args& a, int wv_) { LAUNDER_IDS;
    const int lane = tidx_ & 63, gw = bidx_ * 8 + (tidx_ >> 6), NGW = gridDim.x * 8;
    for (int m = gw; m < MTOT; m += NGW) rms_row_f32_inplace(a.out + (size_t)m * DM, a.in[26], lane);
}

__device__ __forceinline__ void phase_small(const Args& a, int wv_) { LAUNDER_IDS;
    unsigned char* ws = a.ws; const int tid = tidx_, lane = tid & 63, gw = bidx_ * 8 + (tid >> 6), NGW = gridDim.x * 8;
    const bf16_t* proj = (const bf16_t*)(ws + WS_PROJ);
    for (int task = gw; task < 2 * SEQ; task += NGW) {
        const int row = task >> 1, which = task & 1;
        const bf16_t* src = proj + (size_t)row * NINP + (which ? C_CKV : C_CQ) + lane * 8;
        const u32x4 w = *(const u32x4*)src; float v[8] = {bf2f(w.x & 0xffffu), bf2f(w.x >> 16), bf2f(w.y & 0xffffu), bf2f(w.y >> 16), bf2f(w.z & 0xffffu), bf2f(w.z >> 16), bf2f(w.w & 0xffffu), bf2f(w.w >> 16)};
        float s = 0.f;
#pragma unroll
        for (int j = 0; j < 8; ++j) s += v[j] * v[j];
        const float rstd = rsqrtf(wave_sum(s) * (1.f / 512.f) + RMS_EPS);
        const float* g = (which ? a.in[10] : a.in[8]) + lane * 8; const f32x4 g0 = *(const f32x4*)g, g1 = *(const f32x4*)(g + 4);
        u32x4 o; o.x = cvt_pk_bf16(v[0] * rstd * g0.x, v[1] * rstd * g0.y); o.y = cvt_pk_bf16(v[2] * rstd * g0.z, v[3] * rstd * g0.w);
        o.z = cvt_pk_bf16(v[4] * rstd * g1.x, v[5] * rstd * g1.y); o.w = cvt_pk_bf16(v[6] * rstd * g1.z, v[7] * rstd * g1.w);
        *(u32x4*)((bf16_t*)(ws + (which ? WS_CKVN : WS_CQN)) + (size_t)row * 512 + lane * 8) = o;
        if (which && lane < 32) {
            const unsigned pw = *(const unsigned*)(proj + (size_t)row * NINP + C_KPE + 2 * lane); const float x1 = bf2f(pw & 0xffffu), x2 = bf2f(pw >> 16);
            const float c = ((const float*)(ws + WS_COS))[row * 32 + lane], sn = ((const float*)(ws + WS_SIN))[row * 32 + lane];
            *(unsigned*)((bf16_t*)(ws + WS_KPE) + (size_t)row * 64 + 2 * lane) = cvt_pk_bf16(x1 * c - x2 * sn, x2 * c + x1 * sn);
        }
    }
    const int gt = bidx_ * 512 + tid, NT = gridDim.x * 512; bf16_t* xc = (bf16_t*)(ws + WS_XC);
    for (int i = gt; i < SEQ * (DM / 8); i += NT) {
        const int row = i >> 8, c0 = (i & 255) * 8; float accv[8];
        { const f32x4 b0 = *(const f32x4*)(a.in[14] + c0), b1 = *(const f32x4*)(a.in[14] + c0 + 4); accv[0] = b0.x; accv[1] = b0.y; accv[2] = b0.z; accv[3] = b0.w; accv[4] = b1.x; accv[5] = b1.y; accv[6] = b1.z; accv[7] = b1.w; }
#pragma unroll
        for (int k = 0; k < 4; ++k) { const int t = row + k - 2; if (t < 0 || t >= SEQ) continue;
            const u32x4 w = *(const u32x4*)(proj + (size_t)t * NINP + C_XREC + c0); const f32x4 w0 = *(const f32x4*)(a.in[13] + k * DM + c0), w1 = *(const f32x4*)(a.in[13] + k * DM + c0 + 4);
            accv[0] += bf2f(w.x & 0xffffu) * w0.x; accv[1] += bf2f(w.x >> 16) * w0.y; accv[2] += bf2f(w.y & 0xffffu) * w0.z; accv[3] += bf2f(w.y >> 16) * w0.w;
            accv[4] += bf2f(w.z & 0xffffu) * w1.x; accv[5] += bf2f(w.z >> 16) * w1.y; accv[6] += bf2f(w.w & 0xffffu) * w1.z; accv[7] += bf2f(w.w >> 16) * w1.w; }
        u32x4 o; o.x = cvt_pk_bf16(accv[0], accv[1]); o.y = cvt_pk_bf16(accv[2], accv[3]); o.z = cvt_pk_bf16(accv[4], accv[5]); o.w = cvt_pk_bf16(accv[6], accv[7]);
        *(u32x4*)(xc + (size_t)row * DM + c0) = o;
    }
}

__device__ __forceinline__ void phase_scan1(const Args& a, int wv_) { LAUNDER_IDS;
    unsigned char* ws = a.ws; const int tid = tidx_;
    for (int it = bidx_; it < 1024; it += gridDim.x) {
        const int half = it & 1, dir = (it >> 1) & 1, c = it >> 2, ch = half * 1024 + tid * 2;
        const bf16_t* A = (const bf16_t*)(ws + (dir ? WS_AB : WS_AF)) + ch; const bf16_t* U = (const bf16_t*)(ws + (dir ? WS_UB : WS_UF)) + ch;
        f32x2 P = {1.f, 1.f}, Hh = {0.f, 0.f};
#pragma unroll 8
        for (int i = 0; i < 32; ++i) { const int t = dir ? (c * 32 + 31 - i) : (c * 32 + i); const unsigned aw = *(const unsigned*)(A + (size_t)t * DM), uw = *(const unsigned*)(U + (size_t)t * DM);
            const f32x2 av = {1.0f - bf2f(aw & 0xffffu), 1.0f - bf2f(aw >> 16)}, uv = {bf2f(uw & 0xffffu), bf2f(uw >> 16)}; Hh = av * Hh + uv; P = P * av; }
        *(f32x2*)((float*)(ws + WS_AGGA) + (size_t)(dir * 256 + c) * DM + ch) = P; *(f32x2*)((float*)(ws + WS_AGGB) + (size_t)(dir * 256 + c) * DM + ch) = Hh;
    }
}
__device__ __forceinline__ void phase_scan15(const Args& a, LAS unsigned char* lds, int wv_) { LAUNDER_IDS;
    if (bidx_ >= 32) return;
    unsigned char* ws = a.ws; const int tid = tidx_, seg = tid >> 6, cpl = tid & 63, idx = bidx_ * 64 + cpl, dir = idx >> 10, ch = (idx & 1023) * 2;
    const float* GA = (const float*)(ws + WS_AGGA) + (size_t)dir * 256 * DM + ch; const float* GB = (const float*)(ws + WS_AGGB) + (size_t)dir * 256 * DM + ch; float* CR = (float*)(ws + WS_CARRY) + (size_t)dir * 256 * DM + ch;
    LAS f32x4* seg_agg = (LAS f32x4*)lds;
    f32x2 A = {1.f, 1.f}, B = {0.f, 0.f};
#pragma unroll 8
    for (int i = 0; i < 32; ++i) { const int c = dir ? 255 - (seg * 32 + i) : seg * 32 + i; const f32x2 av = *(const f32x2*)(GA + (size_t)c * DM), bv = *(const f32x2*)(GB + (size_t)c * DM); B = av * B + bv; A = A * av; }
    seg_agg[seg * 64 + cpl] = (f32x4){A.x, A.y, B.x, B.y};
    __syncthreads();
    f32x2 carry = {0.f, 0.f};
    for (int k = 0; k < seg; ++k) { const f32x4 g = seg_agg[k * 64 + cpl]; carry = (f32x2){g.x, g.y} * carry + (f32x2){g.z, g.w}; }
    __syncthreads();
#pragma unroll 8
    for (int i = 0; i < 32; ++i) { const int c = dir ? 255 - (seg * 32 + i) : seg * 32 + i; *(f32x2*)(CR + (size_t)c * DM) = carry; const f32x2 av = *(const f32x2*)(GA + (size_t)c * DM), bv = *(const f32x2*)(GB + (size_t)c * DM); carry = av * carry + bv; }
}
__device__ __forceinline__ void phase_scan2(const Args& a, int wv_) { LAUNDER_IDS;
    unsigned char* ws = a.ws; const int tid = tidx_;
    const bf16_t* proj = (const bf16_t*)(ws + WS_PROJ); bf16_t* yg = (bf16_t*)(ws + WS_YG);
    for (int it = bidx_; it < 512; it += gridDim.x) {
        const int half = it & 1, c = it >> 1, ch = half * 1024 + tid * 2;
        const bf16_t* AF = (const bf16_t*)(ws + WS_AF) + ch; const bf16_t* UF = (const bf16_t*)(ws + WS_UF) + ch; const bf16_t* AB = (const bf16_t*)(ws + WS_AB) + ch; const bf16_t* UB = (const bf16_t*)(ws + WS_UB) + ch;
        f32x2 hf[32]; f32x2 h = *(const f32x2*)((const float*)(ws + WS_CARRY) + (size_t)c * DM + ch);
#pragma unroll
        for (int i = 0; i < 32; ++i) { const int t = c * 32 + i; const unsigned aw = *(const unsigned*)(AF + (size_t)t * DM), uw = *(const unsigned*)(UF + (size_t)t * DM);
            const f32x2 av = {1.0f - bf2f(aw & 0xffffu), 1.0f - bf2f(aw >> 16)}, uv = {bf2f(uw & 0xffffu), bf2f(uw >> 16)}; h = av * h + uv; hf[i] = h; }
        h = *(const f32x2*)((const float*)(ws + WS_CARRY) + (size_t)(256 + c) * DM + ch);
#pragma unroll
        for (int i = 31; i >= 0; --i) { const int t = c * 32 + i; const unsigned aw = *(const unsigned*)(AB + (size_t)t * DM), uw = *(const unsigned*)(UB + (size_t)t * DM);
            const f32x2 av = {1.0f - bf2f(aw & 0xffffu), 1.0f - bf2f(aw >> 16)}, uv = {bf2f(uw & 0xffffu), bf2f(uw >> 16)}; h = av * h + uv;
            const unsigned gw = *(const unsigned*)(proj + (size_t)t * NINP + C_GREC + ch); const f32x2 hs = hf[i] + h;
            *(unsigned*)(yg + (size_t)t * DM + ch) = cvt_pk_bf16(gelu_tanh(bf2f(gw & 0xffffu)) * hs.x, gelu_tanh(bf2f(gw >> 16)) * hs.y); }
    }
}

__device__ __forceinline__ void phase_attention(const Args& a, char* lds, int wv_) { LAUNDER_IDS;
    unsigned char* ws = a.ws; const int G = gridDim.x, bx = bidx_; const int vcu = (G % 8 == 0) ? (bx % 8) * (G / 8) + bx / 8 : bx;
    const bf16_t* Q = (const bf16_t*)(ws + WS_Q); const bf16_t* KV = (const bf16_t*)(ws + WS_KV); const bf16_t* KPE = (const bf16_t*)(ws + WS_KPE); bf16_t* O = (bf16_t*)(ws + WS_ATTO);
    for (int u = vcu; u < 512; u += G) { const int h = u >> 5, qb = u & 31;
        att::attn_unit(Q + (size_t)qb * 256 * NQ + h * 192, KV + h * 256, KV + h * 256 + 128, KPE, O + (size_t)qb * 256 * DM + h * 128, SEQ, lds, wv_); }
}

__device__ __forceinline__ void phase_ffn_up(const Args& a, LAS unsigned char* lds, int which, int wv_) {
    pg8::Gemm g{(const bf16_t*)(a.ws + WS_H), (const bf16_t*)(a.ws + (which ? WS_W2GU : WS_W1GU))};
    pg8::EpiSwiglu E{(bf16_t*)(a.ws + WS_ACT), DFF};
    pg8::gemm_phase<pg8::EpiSwiglu, MTOT, 2 * DFF, DM, DM, 0, 0>(lds, g, E, wv_);
}
__device__ __forceinline__ void phase_ffn_down(const Args& a, LAS unsigned char* lds, int which, int wv_) {
    pg8::Gemm g{(const bf16_t*)(a.ws + WS_ACT), (const bf16_t*)(a.ws + (which ? WS_W2D : WS_W1D))};
    pg8::EpiResid E{which ? a.out : a.in[0], which ? a.out : a.in[1], which ? MTOT : SEQ, a.out, 0.5f, 0};
    pg8::gemm_phase<pg8::EpiResid, MTOT, DM, DFF, DFF, 0, 0>(lds, g, E, wv_);
}
__device__ __forceinline__ void phase_wout(const Args& a, LAS unsigned char* lds, int s, int wv_) {
    pg8::Gemm g{(const bf16_t*)(a.ws + WS_H), (const bf16_t*)(a.ws + WS_WOUT)};
    pg8::EpiResid E{a.out, a.out, MTOT, a.out, 1.0f, 0};
    pg8::gemm_phase<pg8::EpiResid, MTOT, DM, DM, DM, 0, 0>(lds, g, E, wv_);
}
__device__ __forceinline__ void phase_win(const Args& a, LAS unsigned char* lds, int s, int wv_) {
    pg8::Gemm g{(const bf16_t*)(a.ws + WS_H) + (size_t)s * SEQ * DM, (const bf16_t*)(a.ws + WS_WIN)}; pg8::EpiBf16 E{(bf16_t*)(a.ws + WS_PROJ), NINP};
    pg8::gemm_phase<pg8::EpiBf16, SEQ, NINP, DM, DM, 0, 0>(lds, g, E, wv_);
}
__device__ __forceinline__ void phase_kv(const Args& a, LAS unsigned char* lds, int wv_) {
    pg8::Gemm g{(const bf16_t*)(a.ws + WS_CKVN), (const bf16_t*)(a.ws + WS_WUKV)}; pg8::EpiBf16 E{(bf16_t*)(a.ws + WS_KV), NKV};
    pg8::gemm_phase<pg8::EpiBf16, SEQ, NKV, 512, 512, 0, 0>(lds, g, E, wv_);
}

__device__ __forceinline__ void run_phase(const Args& a, int ph, unsigned char* lds_g, int wv_) {
    LAS unsigned char* lds = (LAS unsigned char*)lds_g; unsigned char* ws = a.ws;
    if (ph == 0) { if (PHM(0)) phase_prologue(a, lds, wv_); return; }
    if (ph == 1 || ph == 41) { if (PHM(1)) phase_ffn_up(a, lds, ph == 41, wv_); return; }
    if (ph == 2 || ph == 42) { if (PHM(2)) phase_ffn_down(a, lds, ph == 42, wv_); return; }
    if (ph == 3) { if (PHM(3)) phase_norm(a, a.in[6], wv_); return; }
    if (ph == 40) { if (PHM(3)) phase_norm(a, a.in[22], wv_); return; }
    if (ph == 39) { if (PHM(16)) phase_wout(a, lds, 0, wv_); return; }
    if (ph == 43) { if (PHM(4)) phase_final_norm(a, wv_); return; }
    const int s = (ph - 4) / 7, sub = (ph - 4) % 7;
    switch (sub) {
    case 0: if (PHM(5)) phase_win(a, lds, s, wv_); break;
    case 1: if (PHM(6)) phase_small(a, wv_); break;
    case 2: {
        if (PHM(7)) { pg8::Gemm g{(const bf16_t*)(ws + WS_CQN), (const bf16_t*)(ws + WS_WUQ)}; pg8::EpiQ E{(bf16_t*)(ws + WS_Q), (const float*)(ws + WS_COS), (const float*)(ws + WS_SIN)};
          pg8::gemm_phase<pg8::EpiQ, SEQ, NQ, 512, 512, 0, 0>(lds, g, E, wv_); }
        if (PHM(15)) phase_kv(a, lds, wv_);
        if (PHM(8)) { pg8::Gemm g{(const bf16_t*)(ws + WS_XC), (const bf16_t*)(ws + WS_WG)};
          pg8::EpiGates E{(const bf16_t*)(ws + WS_XC), a.in[16], a.in[18], (const float*)(ws + WS_C8), (bf16_t*)(ws + WS_AF), (bf16_t*)(ws + WS_UF), (size_t)(WS_AB - WS_AF) / 2};
          pg8::gemm_phase<pg8::EpiGates, SEQ, 8192, 128, DM, 16, 128>(lds, g, E, wv_); }
        break; }
    case 3: if (PHM(9)) phase_attention(a, (char*)lds_g, wv_); if (PHM(10)) phase_scan1(a, wv_); break;
    case 4: {
        if (PHM(11)) phase_scan15(a, lds, wv_);
        if (PHM(12)) { pg8::Gemm g{(const bf16_t*)(ws + WS_ATTO), (const bf16_t*)(ws + WS_WOA)}; pg8::EpiT1 E{(const bf16_t*)(ws + WS_PROJ) + C_GA, NINP, (bf16_t*)(ws + WS_T1)};
        pg8::gemm_phase<pg8::EpiT1, SEQ, DM, DM, DM, 0, 0>(lds, g, E, wv_); } break; }
    case 5: if (PHM(13)) phase_scan2(a, wv_); break;
    case 6: {
        if (PHM(14)) { pg8::Gemm g{(const bf16_t*)(ws + WS_YG), (const bf16_t*)(ws + WS_WOR)}; pg8::EpiMerge E{(const bf16_t*)(ws + WS_PROJ) + C_GR, NINP, (const bf16_t*)(ws + WS_T1), (bf16_t*)(ws + WS_H) + (size_t)s * SEQ * DM};
        pg8::gemm_phase<pg8::EpiMerge, SEQ, DM, DM, DM, 0, 0>(lds, g, E, wv_); } break; }
    default: break;
    }
}

__global__ void __launch_bounds__(512, 2) mega(Args a) {
    extern __shared__ __attribute__((aligned(16))) unsigned char lds[];
    cg::grid_group grid = cg::this_grid();
    const int wv_ = __builtin_amdgcn_readfirstlane(threadIdx.x >> 6);
    volatile LAS unsigned* misc = (volatile LAS unsigned*)((LAS unsigned char*)lds + (LDS_BYTES - 64));
    if (threadIdx.x < 2) misc[threadIdx.x] = 0u;
    __syncthreads();
    XcdBarrier bar = xcd_barrier_post((unsigned*)(a.ws + WS_CTL), misc);
    for (int ph = a.ph_lo; ph < a.ph_hi; ++ph) {
#ifdef PROBE_REPEAT
        if (PROBE_REPEAT(ph)) { run_phase(a, ph, lds, wv_); xcd_barrier(bar); }
#endif
        run_phase(a, ph, lds, wv_);
        if (ph + 1 < a.ph_hi) { if (ph == a.ph_lo) grid.sync(); else xcd_barrier(bar); }
    }
}

extern "C" void kernel_launch(void* const* d_in, const int* in_sizes, int n_in, void* d_out, int out_size, void* d_ws, size_t ws_size, hipStream_t stream) {
    static int grid = 0;
    if (grid == 0) {
        if (n_in != 27 || out_size != MTOT * DM || ws_size < WS_END) { fprintf(stderr, "kernel_launch: unexpected shapes: n_in %d out %d ws %zu (need %zu)\n", n_in, out_size, ws_size, (size_t)WS_END); grid = -1; return; }
        int dev = 0, cus = 0, per_cu = 0;
        (void)hipGetDevice(&dev); (void)hipDeviceGetAttribute(&cus, hipDeviceAttributeMultiprocessorCount, dev);
        if (hipFuncSetAttribute((const void*)mega, hipFuncAttributeMaxDynamicSharedMemorySize, LDS_BYTES) != hipSuccess) { fprintf(stderr, "kernel_launch: hipFuncSetAttribute failed\n"); grid = -1; return; }
        (void)hipOccupancyMaxActiveBlocksPerMultiprocessor(&per_cu, (const void*)mega, 512, LDS_BYTES);
        if (per_cu < 1) { fprintf(stderr, "kernel_launch: occupancy query says %d blocks/CU\n", per_cu); per_cu = 1; }
        (void)hipGetLastError();
        grid = cus;
    }
    if (grid < 0) return;
    if (hipMemsetAsync((char*)d_ws + WS_CTL, 0, CTL_BYTES, stream) != hipSuccess) { fprintf(stderr, "kernel_launch: hipMemsetAsync failed\n"); return; }
    Args a{};
    for (int i = 0; i < 27; ++i) a.in[i] = (const float*)d_in[i];
    a.out = (float*)d_out; a.ws = (unsigned char*)d_ws;
#if MK_ONE_LAUNCH
    a.ph_lo = 0; a.ph_hi = NPH;
    { void* args[] = {&a}; hipError_t e = hipLaunchCooperativeKernel((const void*)mega, dim3(grid), dim3(512), args, LDS_BYTES, stream);
      if (e != hipSuccess) fprintf(stderr, "cooperative launch failed: %s (grid %d)\n", hipGetErrorString(e), grid); }
#else
    for (int ph = 0; ph < NPH; ++ph) {
        a.ph_lo = ph; a.ph_hi = ph + 1;
        void* args[] = {&a}; hipError_t e = hipLaunchCooperativeKernel((const void*)mega, dim3(grid), dim3(512), args, LDS_BYTES, stream);
        if (e != hipSuccess) { fprintf(stderr, "cooperative launch %d failed: %s (grid %d)\n", ph, hipGetErrorString(e), grid); break; }
    }
#endif
}
```

```cpp
#include <hip/hip_runtime.h>
#include <hip/hip_cooperative_groups.h>
#include <cstdio>
#include <cstdint>
namespace cg = cooperative_groups;

#ifndef MK_ONE_LAUNCH
#define MK_ONE_LAUNCH 1
#endif
#ifndef PH_MASK
#define PH_MASK 0xffffffffu
#endif
#define PHM(k) (((PH_MASK) >> (k)) & 1u)
#define LAUNDER_IDS int tidx_ = wv_ * 64 + (int)__builtin_amdgcn_mbcnt_hi(~0u, __builtin_amdgcn_mbcnt_lo(~0u, 0u)), bidx_ = blockIdx.x; asm volatile("" : "+v"(tidx_), "+s"(bidx_))

#define LAS __attribute__((address_space(3)))
typedef unsigned short bf16_t;
typedef short bf16x8 __attribute__((ext_vector_type(8)));
typedef short s16x4 __attribute__((ext_vector_type(4)));
typedef float f32x4 __attribute__((ext_vector_type(4)));
typedef float f32x2 __attribute__((ext_vector_type(2)));
typedef float f32x16 __attribute__((ext_vector_type(16)));
typedef unsigned u32x4 __attribute__((ext_vector_type(4)));
typedef unsigned u32x2 __attribute__((ext_vector_type(2)));

constexpr int DM = 2048, SEQ = 8192, NSEQ = 5, MTOT = NSEQ * SEQ, DFF = 5632;
constexpr int NIN = 9280, NINP = 9472;
constexpr int NQ = 3072, NKV = 4096;
constexpr int C_CQ = 0, C_CKV = 512, C_KPE = 1024, C_XREC = 1088, C_GREC = 3136, C_GA = 5184, C_GR = 7232;
constexpr float RMS_EPS = 1e-6f;
constexpr float QSCALE = 0.07216878364870322f * 1.4426950408889634f;

constexpr size_t MiB = 1u << 20;
constexpr size_t WS_COS = 0, WS_SIN = 1 * MiB, WS_C8 = 2 * MiB, WS_CTL = 3 * MiB, CTL_BYTES = 16384;
constexpr size_t WS_W1GU = 4 * MiB, WS_W1D = 48 * MiB, WS_W2GU = 70 * MiB, WS_W2D = 114 * MiB, WS_WIN = 136 * MiB, WS_WUQ = 173 * MiB,
                 WS_WUKV = 176 * MiB, WS_WOA = 180 * MiB, WS_WOR = 188 * MiB, WS_WOUT = 196 * MiB, WS_WG = 204 * MiB;
constexpr size_t WS_H = 206 * MiB, WS_ACT = 366 * MiB;
constexpr size_t WS_PROJ = 366 * MiB, WS_CQN = 514 * MiB, WS_CKVN = 522 * MiB, WS_KPE = 530 * MiB, WS_XC = 532 * MiB, WS_MERGED = 532 * MiB,
                 WS_Q = 564 * MiB, WS_KV = 612 * MiB, WS_T1 = 564 * MiB, WS_AF = 676 * MiB, WS_UF = 740 * MiB, WS_AB = 804 * MiB, WS_UB = 868 * MiB,
                 WS_ATTO = 932 * MiB, WS_YG = 964 * MiB, WS_AGGA = 996 * MiB, WS_AGGB = 1000 * MiB, WS_CARRY = 1004 * MiB, WS_END = 1008 * MiB;

constexpr int LDS_BYTES = 135168;
constexpr int NPH = 44;

__device__ __forceinline__ float bf2f(unsigned b) { return __uint_as_float(b << 16); }
__device__ __forceinline__ unsigned cvt_pk_bf16(float lo, float hi) { unsigned r; asm volatile("v_cvt_pk_bf16_f32 %0, %1, %2" : "=v"(r) : "v"(lo), "v"(hi)); return r; }
__device__ __forceinline__ float fsigmoid(float x) { return __builtin_amdgcn_rcpf(1.0f + __expf(-x)); }
__device__ __forceinline__ float wave_sum(float v) {
    v += __int_as_float(__builtin_amdgcn_ds_swizzle(__float_as_int(v), 0x041f));
    v += __int_as_float(__builtin_amdgcn_ds_swizzle(__float_as_int(v), 0x081f));
    v += __int_as_float(__builtin_amdgcn_ds_swizzle(__float_as_int(v), 0x101f));
    v += __int_as_float(__builtin_amdgcn_ds_swizzle(__float_as_int(v), 0x201f));
    v += __int_as_float(__builtin_amdgcn_ds_swizzle(__float_as_int(v), 0x401f));
    auto rr = __builtin_amdgcn_permlane32_swap(__float_as_uint(v), __float_as_uint(v), false, false);
    return __uint_as_float(rr[0]) + __uint_as_float(rr[1]);
}
__device__ __forceinline__ float gelu_tanh(float x) {
    const float z = 0.7978845608028654f * (x + 0.044715f * x * x * x);
    const float e = __expf(2.0f * z);
    const float t = 1.0f - 2.0f * __builtin_amdgcn_rcpf(1.0f + e);
    return 0.5f * x * (1.0f + t);
}

namespace pg8 {
constexpr int BM = 256, BK = 64, HALF = 128, HTB = HALF * BK * 2, STAGE_BYTES = 8 * HTB, NXCD = 8, WGM = 4;
__host__ __device__ __forceinline__ int lds_byte(int r, int c) { const int st = (r >> 4) * 2 + (c >> 5), rr = r & 15, cc = c & 31, ob = rr * 64 + cc * 2; return st * 1024 + (ob ^ (((ob >> 9) & 1) << 5)); }
__host__ __device__ __forceinline__ void stage_rc(int b, int& R, int& C) { const int st = b / 1024, sb = b % 1024, swz = sb ^ (((sb >> 9) & 1) << 5); R = (st >> 1) * 16 + swz / 64; C = (st & 1) * 32 + (swz % 64) / 2; }
__host__ __device__ __forceinline__ int perm32(int rho) { const int n = rho >> 4, i = rho & 15; return 8 * (i >> 2) + 4 * n + (i & 3); }

struct Unit { int pm, pn; };
struct Gemm { const bf16_t* A; const bf16_t* Bt; };

struct StaticOrder {
    int nM, nN, nwg, G, c;
    __device__ void init(int M, int N, int G_, int c_) { nM = M / BM; nN = N / BM; nwg = nM * nN; G = G_; c = c_; }
    __device__ bool next(int i, Unit& u) const {
        const long L = (long)i * G + c; if (L >= nwg) return false;
        int wgid = (int)L; { const int q = nwg / NXCD, r = nwg % NXCD, xcd = wgid % NXCD, off = wgid / NXCD; wgid = (xcd < r ? xcd * (q + 1) : r * (q + 1) + (xcd - r) * q) + off; }
        const int nig = WGM * nN, gid = wgid / nig, fm = gid * WGM, gsz = (nM - fm) < WGM ? (nM - fm) : WGM;
        u.pm = fm + ((wgid % nig) % gsz); u.pn = (wgid % nig) / gsz; return true;
    }
};

template <class Epi, int GM, int GN, int GK, int LDA, int AMOD, int ASTRIDE>
__device__ __forceinline__ void gemm_phase(LAS unsigned char* lds, const Gemm g, const Epi& E, int wv_) {
    int tid_ = wv_ * 64 + (int)__builtin_amdgcn_mbcnt_hi(~0u, __builtin_amdgcn_mbcnt_lo(~0u, 0u)), bid_ = blockIdx.x; asm volatile("" : "+v"(tid_), "+s"(bid_));
    const int tid = tid_, wid = __builtin_amdgcn_readfirstlane(tid >> 6), lane = tid & 63, wr = wid >> 2, wc = wid & 3, fr = lane & 15, fq = lane >> 4;
    constexpr int K = GK, lda = LDA; int nt = K / BK; asm volatile("" : "+s"(nt));
    StaticOrder S; S.init(GM, GN, (int)gridDim.x, bid_);
    unsigned voffA[2], voffB[2];
#pragma unroll
    for (int i = 0; i < 2; ++i) { int R, C; stage_rc(tid * 16 + i * 8192, R, C); const int Rb = Epi::PERM ? ((R & ~31) + perm32(R & 31)) : R;
        voffA[i] = (unsigned)(R * lda + C) * 2u; voffB[i] = (unsigned)(Rb * K + C) * 2u; }
    const size_t kstep = (size_t)(BK * 2);
    const size_t hstepA = (size_t)HALF * lda * 2, tstepA = 2 * hstepA;
    const size_t hstepB = (size_t)HALF * K * 2, tstepB = 2 * hstepB;
    const unsigned ldsw = (unsigned)wid * 1024u;
    const int aoff = lds_byte(wr * 64 + fr, fq * 8), boff = lds_byte(wc * 32 + fr, fq * 8);
#define PG8_SA(b, h) (((b) * 2 + (h)) * HTB)
#define PG8_SB(b, h) ((4 + (b) * 2 + (h)) * HTB)
#define PG8_STAGE(bufoff, gbase, voff) do { _Pragma("unroll") for (int _i = 0; _i < 2; ++_i) \
        __builtin_amdgcn_global_load_lds((const unsigned*)((const char*)(gbase) + (voff)[_i]), (LAS unsigned*)(lds + (bufoff) + ldsw + _i * 8192), 16, 0, 0); } while (0)
#define PG8_LDA(dst, b, h) do { _Pragma("unroll") for (int m = 0; m < 4; ++m) _Pragma("unroll") for (int k = 0; k < 2; ++k) dst[m][k] = *(const LAS bf16x8*)(lds + PG8_SA(b, h) + aoff + m * 2048 + k * 1024); } while (0)
#define PG8_LDB(dst, b, h) do { _Pragma("unroll") for (int n = 0; n < 2; ++n) _Pragma("unroll") for (int k = 0; k < 2; ++k) dst[n][k] = *(const LAS bf16x8*)(lds + PG8_SB(b, h) + boff + n * 2048 + k * 1024); } while (0)
#define PG8_MMA(ai, bj, At, Bt) do { __builtin_amdgcn_s_setprio(1); _Pragma("unroll") for (int m = 0; m < 4; ++m) _Pragma("unroll") for (int n = 0; n < 2; ++n) _Pragma("unroll") for (int k = 0; k < 2; ++k) \
        acc[ai][bj][m][n] = __builtin_amdgcn_mfma_f32_16x16x32_bf16(Bt[n][k], At[m][k], acc[ai][bj][m][n], 0, 0, 0); __builtin_amdgcn_s_setprio(0); } while (0)
#define PG8_WAIT_V(n) asm volatile("s_waitcnt vmcnt(" #n ")" ::: "memory")
#define PG8_WAIT_L(n) asm volatile("s_waitcnt lgkmcnt(" #n ")" ::: "memory")
#define PG8_BAR __builtin_amdgcn_s_barrier()
#define PG8_SCHED __builtin_amdgcn_sched_barrier(0)
#define PG8_AOFF(pn) (AMOD ? (size_t)((pn) % (AMOD ? AMOD : 1)) * (size_t)ASTRIDE * 2 : (size_t)0)
    Unit cur, nxt; int ui = 0;
    if (!S.next(0, cur)) return;
    f32x4 acc[2][2][4][2];
#pragma unroll
    for (int a = 0; a < 2; ++a)
#pragma unroll
        for (int b = 0; b < 2; ++b)
#pragma unroll
            for (int m = 0; m < 4; ++m)
#pragma unroll
                for (int n = 0; n < 2; ++n) acc[a][b][m][n] = (f32x4){0.f, 0.f, 0.f, 0.f};
    bf16x8 At[4][2], B0[2][2], B1[2][2];
    const char* cA = (const char*)g.A + (size_t)cur.pm * tstepA + PG8_AOFF(cur.pn); const char* cB = (const char*)g.Bt + (size_t)cur.pn * tstepB;
    PG8_STAGE(PG8_SB(0, 0), cB, voffB); PG8_STAGE(PG8_SB(0, 1), cB + hstepB, voffB); PG8_STAGE(PG8_SA(0, 0), cA, voffA); PG8_STAGE(PG8_SA(0, 1), cA + hstepA, voffA);
    if (wr == 1) PG8_BAR;
    PG8_WAIT_V(2); PG8_BAR;
    PG8_STAGE(PG8_SB(1, 0), cB + kstep, voffB); PG8_STAGE(PG8_SA(1, 0), cA + kstep, voffA); PG8_STAGE(PG8_SB(1, 1), cB + hstepB + kstep, voffB);
    PG8_WAIT_V(6); PG8_BAR;
    for (;;) {
        const bool has_next = S.next(ui + 1, nxt);
        const char* nA = has_next ? (const char*)g.A + (size_t)nxt.pm * tstepA + PG8_AOFF(nxt.pn) : cA; const char* nB = has_next ? (const char*)g.Bt + (size_t)nxt.pn * tstepB : cB;
        for (int t = 0; t < nt; t += 2) {
            const bool last = (t == nt - 2);
            const char* a1 = cA + (size_t)(t + 1) * kstep;
            const char* a2 = last ? nA : cA + (size_t)(t + 2) * kstep; const char* b2 = last ? nB : cB + (size_t)(t + 2) * kstep;
            const char* a3 = a2 + kstep; const char* b3 = b2 + kstep;
            PG8_LDB(B0, 0, 0); PG8_LDB(B1, 0, 1); PG8_SCHED; PG8_LDA(At, 0, 0); PG8_STAGE(PG8_SA(1, 1), a1 + hstepA, voffA);
            PG8_WAIT_V(8); PG8_WAIT_L(0); PG8_BAR; PG8_MMA(0, 0, At, B0); PG8_MMA(0, 1, At, B1); PG8_BAR; PG8_SCHED;
            PG8_LDA(At, 0, 1); PG8_STAGE(PG8_SB(0, 0), b2, voffB); PG8_STAGE(PG8_SB(0, 1), b2 + hstepB, voffB); PG8_STAGE(PG8_SA(0, 0), a2, voffA);
            PG8_WAIT_V(8); PG8_WAIT_L(0); PG8_BAR; PG8_MMA(1, 0, At, B0); PG8_MMA(1, 1, At, B1); PG8_BAR; PG8_SCHED;
            PG8_LDB(B0, 1, 0); PG8_LDB(B1, 1, 1); PG8_SCHED; PG8_LDA(At, 1, 0); PG8_STAGE(PG8_SA(0, 1), a2 + hstepA, voffA);
            PG8_WAIT_V(8); PG8_WAIT_L(0); PG8_BAR; PG8_MMA(0, 0, At, B0); PG8_MMA(0, 1, At, B1); PG8_BAR; PG8_SCHED;
            PG8_LDA(At, 1, 1); PG8_STAGE(PG8_SB(1, 0), b3, voffB); PG8_STAGE(PG8_SB(1, 1), b3 + hstepB, voffB); PG8_STAGE(PG8_SA(1, 0), a3, voffA);
            PG8_WAIT_V(8); PG8_WAIT_L(0); PG8_BAR; PG8_MMA(1, 0, At, B0); PG8_MMA(1, 1, At, B1); PG8_BAR; PG8_SCHED;
        }
        if (wr == 0) PG8_BAR;
        { int fr2 = fr, fq2 = fq; asm volatile("" : "+v"(fr2), "+v"(fq2)); E(acc, cur, wr, wc, fr2, fq2); }
        if (!has_next) break;
#pragma unroll
        for (int a = 0; a < 2; ++a)
#pragma unroll
            for (int b = 0; b < 2; ++b)
#pragma unroll
                for (int m = 0; m < 4; ++m)
#pragma unroll
                    for (int n = 0; n < 2; ++n) acc[a][b][m][n] = (f32x4){0.f, 0.f, 0.f, 0.f};
        cur = nxt; cA = nA; cB = nB; ++ui;
        if (wr == 1) PG8_BAR;
    }
    PG8_WAIT_V(0);
    PG8_BAR;
#undef PG8_SA
#undef PG8_SB
#undef PG8_STAGE
#undef PG8_LDA
#undef PG8_LDB
#undef PG8_MMA
#undef PG8_WAIT_V
#undef PG8_WAIT_L
#undef PG8_BAR
#undef PG8_SCHED
#undef PG8_AOFF
}

typedef f32x4 Acc[2][2][4][2];

struct EpiBf16 {
    static constexpr bool PERM = true;
    bf16_t* O; int ldc;
    __device__ __forceinline__ void operator()(const Acc& acc, const Unit& u, int wr, int wc, int fr, int fq) const {
        const int row0 = u.pm * BM + wr * 64 + fr, col0 = u.pn * BM + wc * 32 + 8 * fq;
#pragma unroll
        for (int ai = 0; ai < 2; ++ai)
#pragma unroll
            for (int m = 0; m < 4; ++m) { bf16_t* rowp = O + (size_t)(row0 + ai * HALF + m * 16) * ldc + col0;
#pragma unroll
                for (int bj = 0; bj < 2; ++bj) { const f32x4 v0 = acc[ai][bj][m][0], v1 = acc[ai][bj][m][1];
                    u32x4 w; w.x = cvt_pk_bf16(v0[0], v0[1]); w.y = cvt_pk_bf16(v0[2], v0[3]); w.z = cvt_pk_bf16(v1[0], v1[1]); w.w = cvt_pk_bf16(v1[2], v1[3]);
                    *(u32x4*)(rowp + bj * HALF) = w; } asm volatile("" ::: "memory"); }
    }
};
struct EpiSwiglu {
    static constexpr bool PERM = true;
    bf16_t* O; int ldc;
    __device__ __forceinline__ void operator()(const Acc& acc, const Unit& u, int wr, int wc, int fr, int fq) const {
        const int row0 = u.pm * BM + wr * 64 + fr, col0 = u.pn * HALF + wc * 32 + 8 * fq;
#pragma unroll
        for (int ai = 0; ai < 2; ++ai)
#pragma unroll
            for (int m = 0; m < 4; ++m) { bf16_t* rowp = O + (size_t)(row0 + ai * HALF + m * 16) * ldc + col0;
                float r[8];
#pragma unroll
                for (int n = 0; n < 2; ++n)
#pragma unroll
                    for (int j = 0; j < 4; ++j) { const float gv = acc[ai][0][m][n][j], uv = acc[ai][1][m][n][j]; r[n * 4 + j] = gv * fsigmoid(gv) * uv; }
                u32x4 w; w.x = cvt_pk_bf16(r[0], r[1]); w.y = cvt_pk_bf16(r[2], r[3]); w.z = cvt_pk_bf16(r[4], r[5]); w.w = cvt_pk_bf16(r[6], r[7]);
                *(u32x4*)rowp = w; asm volatile("" ::: "memory"); }
    }
};
struct EpiResid {
    static constexpr bool PERM = false;
    const float* res0; const float* res1; int split; float* out; float alpha; int row_base;
    __device__ __forceinline__ void operator()(const Acc& acc, const Unit& u, int wr, int wc, int fr, int fq) const {
        const int grow0 = row_base + u.pm * BM; const float* rb = grow0 < split ? res0 + (size_t)grow0 * DM : res1 + (size_t)(grow0 - split) * DM;
        float* ob = out + (size_t)grow0 * DM; const int col0 = u.pn * BM + wc * 32 + 4 * fq;
#pragma unroll
        for (int ai = 0; ai < 2; ++ai)
#pragma unroll
            for (int m = 0; m < 4; ++m) { const size_t off = (size_t)(ai * HALF + wr * 64 + m * 16 + fr) * DM + col0;
#pragma unroll
                for (int bj = 0; bj < 2; ++bj)
#pragma unroll
                    for (int n = 0; n < 2; ++n) { const f32x4 bs = *(const f32x4*)(rb + off + bj * HALF + n * 16); *(f32x4*)(ob + off + bj * HALF + n * 16) = bs + acc[ai][bj][m][n] * alpha; } asm volatile("" ::: "memory"); }
    }
};
struct EpiQ {
    static constexpr bool PERM = true;
    bf16_t* O; const float* cosT; const float* sinT;
    __device__ __forceinline__ void operator()(const Acc& acc, const Unit& u, int wr, int wc, int fr, int fq) const {
        const int row0 = u.pm * BM + wr * 64 + fr;
#pragma unroll
        for (int bj = 0; bj < 2; ++bj) { const int col0 = u.pn * BM + bj * HALF + wc * 32 + 8 * fq; const int d = col0 % 192; const bool rope = d >= 128; const int jp0 = (d - 128) >> 1;
#pragma unroll
            for (int ai = 0; ai < 2; ++ai)
#pragma unroll
                for (int m = 0; m < 4; ++m) { const int row = row0 + ai * HALF + m * 16; f32x4 v0 = acc[ai][bj][m][0], v1 = acc[ai][bj][m][1];
                    if (rope) { const f32x4 c = *(const f32x4*)(cosT + (size_t)row * 32 + jp0), s = *(const f32x4*)(sinT + (size_t)row * 32 + jp0);
                        const f32x4 a0 = v0, a1 = v1;
                        v0[0] = a0[0] * c[0] - a0[1] * s[0]; v0[1] = a0[1] * c[0] + a0[0] * s[0]; v0[2] = a0[2] * c[1] - a0[3] * s[1]; v0[3] = a0[3] * c[1] + a0[2] * s[1];
                        v1[0] = a1[0] * c[2] - a1[1] * s[2]; v1[1] = a1[1] * c[2] + a1[0] * s[2]; v1[2] = a1[2] * c[3] - a1[3] * s[3]; v1[3] = a1[3] * c[3] + a1[2] * s[3]; }
                    v0 = v0 * QSCALE; v1 = v1 * QSCALE;
                    u32x4 w; w.x = cvt_pk_bf16(v0[0], v0[1]); w.y = cvt_pk_bf16(v0[2], v0[3]); w.z = cvt_pk_bf16(v1[0], v1[1]); w.w = cvt_pk_bf16(v1[2], v1[3]);
                    *(u32x4*)(O + (size_t)row * NQ + col0) = w; asm volatile("" ::: "memory"); } }
    }
};
struct EpiGates {
    static constexpr bool PERM = true;
    const bf16_t* xc; const float* b_a; const float* b_i; const float* c8; bf16_t* Aout; bf16_t* Uout; size_t dir_stride;
    __device__ __forceinline__ void operator()(const Acc& acc, const Unit& u, int wr, int wc, int fr, int fq) const {
        const int dir = u.pn >> 4, blk = u.pn & 15; const int row0 = u.pm * BM + wr * 64 + fr; const int ch0 = blk * HALF + wc * 32 + 8 * fq;
        bf16_t* Ao = Aout + (size_t)dir * dir_stride; bf16_t* Uo = Uout + (size_t)dir * dir_stride;
        f32x4 ba[2], bi[2], cc[2];
#pragma unroll
        for (int n = 0; n < 2; ++n) { ba[n] = *(const f32x4*)(b_a + dir * DM + ch0 + 4 * n); bi[n] = *(const f32x4*)(b_i + dir * DM + ch0 + 4 * n); cc[n] = *(const f32x4*)(c8 + dir * DM + ch0 + 4 * n); }
#pragma unroll
        for (int ai = 0; ai < 2; ++ai)
#pragma unroll
            for (int m = 0; m < 4; ++m) { const int row = row0 + ai * HALF + m * 16; const size_t off = (size_t)row * DM + ch0;
                const u32x4 xw = *(const u32x4*)(xc + off);
                const float xv[8] = {bf2f(xw.x & 0xffffu), bf2f(xw.x >> 16), bf2f(xw.y & 0xffffu), bf2f(xw.y >> 16), bf2f(xw.z & 0xffffu), bf2f(xw.z >> 16), bf2f(xw.w & 0xffffu), bf2f(xw.w >> 16)};
                float om[8], uv[8];
#pragma unroll
                for (int n = 0; n < 2; ++n)
#pragma unroll
                    for (int j = 0; j < 4; ++j) { const float r = fsigmoid(acc[ai][0][m][n][j] + ba[n][j]), ig = fsigmoid(acc[ai][1][m][n][j] + bi[n][j]);
                        const float y = r * cc[n][j];
                        float o1 = y * (1.0f - y * (0.5f - y * (0.16666667f - y * (0.041666668f - y * 0.008333334f))));
                        if (__builtin_expect(__any(y >= 0.125f), 0)) { const float ome = 1.0f - __expf(-y); o1 = y < 0.125f ? o1 : ome; }
                        om[n * 4 + j] = o1; uv[n * 4 + j] = sqrtf(o1 * (2.0f - o1)) * (ig * xv[n * 4 + j]); }
                u32x4 wa, wu; wa.x = cvt_pk_bf16(om[0], om[1]); wa.y = cvt_pk_bf16(om[2], om[3]); wa.z = cvt_pk_bf16(om[4], om[5]); wa.w = cvt_pk_bf16(om[6], om[7]);
                wu.x = cvt_pk_bf16(uv[0], uv[1]); wu.y = cvt_pk_bf16(uv[2], uv[3]); wu.z = cvt_pk_bf16(uv[4], uv[5]); wu.w = cvt_pk_bf16(uv[6], uv[7]);
                *(u32x4*)(Ao + off) = wa; *(u32x4*)(Uo + off) = wu; asm volatile("" ::: "memory"); }
    }
};
struct EpiT1 {
    static constexpr bool PERM = true;
    const bf16_t* gate; int ldg; bf16_t* O;
    __device__ __forceinline__ void operator()(const Acc& acc, const Unit& u, int wr, int wc, int fr, int fq) const {
        const int row0 = u.pm * BM + wr * 64 + fr;
#pragma unroll
        for (int ai = 0; ai < 2; ++ai)
#pragma unroll
            for (int m = 0; m < 4; ++m) { const int row = row0 + ai * HALF + m * 16;
#pragma unroll
                for (int bj = 0; bj < 2; ++bj) { const int col0 = u.pn * BM + bj * HALF + wc * 32 + 8 * fq;
                    const u32x4 gw = *(const u32x4*)(gate + (size_t)row * ldg + col0); f32x4 v0 = acc[ai][bj][m][0], v1 = acc[ai][bj][m][1];
                    v0[0] *= fsigmoid(bf2f(gw.x & 0xffffu)); v0[1] *= fsigmoid(bf2f(gw.x >> 16)); v0[2] *= fsigmoid(bf2f(gw.y & 0xffffu)); v0[3] *= fsigmoid(bf2f(gw.y >> 16));
                    v1[0] *= fsigmoid(bf2f(gw.z & 0xffffu)); v1[1] *= fsigmoid(bf2f(gw.z >> 16)); v1[2] *= fsigmoid(bf2f(gw.w & 0xffffu)); v1[3] *= fsigmoid(bf2f(gw.w >> 16));
                    u32x4 w; w.x = cvt_pk_bf16(v0[0], v0[1]); w.y = cvt_pk_bf16(v0[2], v0[3]); w.z = cvt_pk_bf16(v1[0], v1[1]); w.w = cvt_pk_bf16(v1[2], v1[3]);
                    *(u32x4*)(O + (size_t)row * DM + col0) = w; } asm volatile("" ::: "memory"); }
    }
};
struct EpiMerge {
    static constexpr bool PERM = true;
    const bf16_t* gate; int ldg; const bf16_t* T1; bf16_t* O;
    __device__ __forceinline__ void operator()(const Acc& acc, const Unit& u, int wr, int wc, int fr, int fq) const {
        const int row0 = u.pm * BM + wr * 64 + fr;
#pragma unroll
        for (int ai = 0; ai < 2; ++ai)
#pragma unroll
            for (int m = 0; m < 4; ++m) { const int row = row0 + ai * HALF + m * 16;
#pragma unroll
                for (int bj = 0; bj < 2; ++bj) { const int col0 = u.pn * BM + bj * HALF + wc * 32 + 8 * fq;
                    const u32x4 gw = *(const u32x4*)(gate + (size_t)row * ldg + col0); const u32x4 tw = *(const u32x4*)(T1 + (size_t)row * DM + col0);
                    f32x4 v0 = acc[ai][bj][m][0], v1 = acc[ai][bj][m][1];
                    const f32x4 t0 = {bf2f(tw.x & 0xffffu), bf2f(tw.x >> 16), bf2f(tw.y & 0xffffu), bf2f(tw.y >> 16)}, t1 = {bf2f(tw.z & 0xffffu), bf2f(tw.z >> 16), bf2f(tw.w & 0xffffu), bf2f(tw.w >> 16)};
                    v0[0] = t0[0] + v0[0] * fsigmoid(bf2f(gw.x & 0xffffu)); v0[1] = t0[1] + v0[1] * fsigmoid(bf2f(gw.x >> 16)); v0[2] = t0[2] + v0[2] * fsigmoid(bf2f(gw.y & 0xffffu)); v0[3] = t0[3] + v0[3] * fsigmoid(bf2f(gw.y >> 16));
                    v1[0] = t1[0] + v1[0] * fsigmoid(bf2f(gw.z & 0xffffu)); v1[1] = t1[1] + v1[1] * fsigmoid(bf2f(gw.z >> 16)); v1[2] = t1[2] + v1[2] * fsigmoid(bf2f(gw.w & 0xffffu)); v1[3] = t1[3] + v1[3] * fsigmoid(bf2f(gw.w >> 16));
                    u32x4 w; w.x = cvt_pk_bf16(v0[0], v0[1]); w.y = cvt_pk_bf16(v0[2], v0[3]); w.z = cvt_pk_bf16(v1[0], v1[1]); w.w = cvt_pk_bf16(v1[2], v1[3]);
                    *(u32x4*)(O + (size_t)row * DM + col0) = w; } asm volatile("" ::: "memory"); }
    }
};
}

namespace att {
constexpr int NW = 8, QBLK = 32, KVBLK = 64;
constexpr int LDQ = NQ, LDKV = NKV, LDO = DM;
constexpr int SLOT_K = 24576, SLOT_V = 16384, KR_OFF = 16384;
constexpr int OFF_K = 0, OFF_V = 3 * SLOT_K, OFF_WS = OFF_V + 3 * SLOT_V;
constexpr float THRL = 11.0f;
#define KNSWZ(row, colB) ((row) * 256 + ((colB) ^ (((row) & 15) << 4)))
#define KRSWZ(row, colB) ((row) * 128 + ((colB) ^ ((((row) >> 1) & 7) << 4)))
#define SBAR() __builtin_amdgcn_sched_barrier(0)
__device__ __forceinline__ int crow(int r, int hi) { return (r & 3) + 8 * (r >> 2) + 4 * hi; }

__device__ __forceinline__ void partialSM(f32x16& p0, f32x16& p1, float& m_reg, float& mn, float& alpha) {
    float pmax = p0[0];
#pragma unroll
    for (int r = 1; r < 16; ++r) pmax = fmaxf(pmax, p0[r]);
#pragma unroll
    for (int r = 0; r < 16; ++r) pmax = fmaxf(pmax, p1[r]);
    { auto rr = __builtin_amdgcn_permlane32_swap(__float_as_uint(pmax), __float_as_uint(pmax), false, false);
      pmax = fmaxf(__uint_as_float(rr[0]), __uint_as_float(rr[1])); }
    if (__builtin_expect(__all(pmax - m_reg <= THRL), 1)) { mn = m_reg; alpha = 1.f; }
    else { mn = fmaxf(m_reg, pmax); alpha = __builtin_amdgcn_exp2f(m_reg - mn); m_reg = mn; }
#pragma unroll
    for (int r = 0; r < 16; ++r) p0[r] = p0[r] - mn;
#pragma unroll
    for (int r = 0; r < 16; ++r) p1[r] = p1[r] - mn;
#pragma unroll
    for (int r = 0; r < 16; ++r) p0[r] = __builtin_amdgcn_exp2f(p0[r]);
}
__device__ __forceinline__ void finishSM(f32x16& p0, f32x16& p1, float alpha, float& l_reg, bf16x8& pa0, bf16x8& pa1, bf16x8& pa2, bf16x8& pa3) {
#pragma unroll
    for (int r = 0; r < 16; ++r) p1[r] = __builtin_amdgcn_exp2f(p1[r]);
    float ps = 0;
#pragma unroll
    for (int r = 0; r < 16; ++r) ps += p0[r];
#pragma unroll
    for (int r = 0; r < 16; ++r) ps += p1[r];
    { auto rr = __builtin_amdgcn_permlane32_swap(__float_as_uint(ps), __float_as_uint(ps), false, false);
      ps = __uint_as_float(rr[0]) + __uint_as_float(rr[1]); }
    l_reg = l_reg * alpha + ps;
#define PK4(P, BASE, OUT) do { unsigned a0 = cvt_pk_bf16(P[BASE + 0], P[BASE + 1]), a1 = cvt_pk_bf16(P[BASE + 2], P[BASE + 3]);   \
    unsigned b0 = cvt_pk_bf16(P[BASE + 4], P[BASE + 5]), b1 = cvt_pk_bf16(P[BASE + 6], P[BASE + 7]);                              \
    auto r0 = __builtin_amdgcn_permlane32_swap(a0, b0, false, false); auto r1 = __builtin_amdgcn_permlane32_swap(a1, b1, false, false); \
    u32x4 w = {r0[0], r1[0], r0[1], r1[1]}; OUT = *reinterpret_cast<bf16x8*>(&w); } while (0)
    PK4(p0, 0, pa0); PK4(p0, 8, pa1); PK4(p1, 0, pa2); PK4(p1, 8, pa3);
#undef PK4
}
__device__ __forceinline__ void qkt(f32x16& p0, f32x16& p1, const char* Kn, const bf16x8* qr, int r32, int hi) {
    const char* Kr = Kn + KR_OFF;
    p0 = f32x16{}; p1 = f32x16{};
    __builtin_amdgcn_s_setprio(1);
#pragma unroll
    for (int d0 = 0; d0 < 8; ++d0) { const int cb = (d0 * 16 + hi * 8) * 2;
        const bf16x8 b0 = *reinterpret_cast<const bf16x8*>(Kn + KNSWZ(r32, cb));
        const bf16x8 b1 = *reinterpret_cast<const bf16x8*>(Kn + KNSWZ(32 + r32, cb));
        p0 = __builtin_amdgcn_mfma_f32_32x32x16_bf16(b0, qr[d0], p0, 0, 0, 0);
        p1 = __builtin_amdgcn_mfma_f32_32x32x16_bf16(b1, qr[d0], p1, 0, 0, 0); }
#pragma unroll
    for (int d0 = 0; d0 < 4; ++d0) { const int cb = (d0 * 16 + hi * 8) * 2;
        const bf16x8 b0 = *reinterpret_cast<const bf16x8*>(Kr + KRSWZ(r32, cb));
        const bf16x8 b1 = *reinterpret_cast<const bf16x8*>(Kr + KRSWZ(32 + r32, cb));
        p0 = __builtin_amdgcn_mfma_f32_32x32x16_bf16(b0, qr[8 + d0], p0, 0, 0, 0);
        p1 = __builtin_amdgcn_mfma_f32_32x32x16_bf16(b1, qr[8 + d0], p1, 0, 0, 0); }
}
__device__ __forceinline__ int v_st(int k, int c) { const int kk = (k & ~0xC) | ((k & 4) << 1) | ((k & 8) >> 1); return ((kk >> 3) * 4 + (c >> 5)) * 512 + ((kk & 7) * 32 + (c & 31)) * 2; }
__device__ __forceinline__ int v_rd_base(int lane) { return ((lane & 3) << 3) | (((lane >> 2) & 3) << 6) | (((lane >> 4) & 1) << 5) | (((lane >> 5) & 1) << 8); }
constexpr int v_rd_off(int d0, int ks, int half) { return d0 * 512 + ks * 4096 + half * 2048; }
template <int OFF> __device__ __forceinline__ s16x4 tr_read(int vb) {
    s16x4 r; asm volatile("ds_read_b64_tr_b16 %0, %1 offset:%2" : "=&v"(r) : "v"(vb), "i"(OFF) : "memory"); return r;
}
template <int D0> __device__ __forceinline__ void pv_one(f32x16& od, int vb, bf16x8 pa0, bf16x8 pa1, bf16x8 pa2, bf16x8 pa3) {
    const s16x4 l0 = tr_read<v_rd_off(D0, 0, 0)>(vb), h0 = tr_read<v_rd_off(D0, 0, 1)>(vb), l1 = tr_read<v_rd_off(D0, 1, 0)>(vb), h1 = tr_read<v_rd_off(D0, 1, 1)>(vb);
    const s16x4 l2 = tr_read<v_rd_off(D0, 2, 0)>(vb), h2 = tr_read<v_rd_off(D0, 2, 1)>(vb), l3 = tr_read<v_rd_off(D0, 3, 0)>(vb), h3 = tr_read<v_rd_off(D0, 3, 1)>(vb);
    asm volatile("s_waitcnt lgkmcnt(0)" ::: "memory"); SBAR();
#define PK(L, H) (bf16x8){L[0], L[1], L[2], L[3], H[0], H[1], H[2], H[3]}
    od = __builtin_amdgcn_mfma_f32_32x32x16_bf16(pa0, PK(l0, h0), od, 0, 0, 0);
    od = __builtin_amdgcn_mfma_f32_32x32x16_bf16(pa1, PK(l1, h1), od, 0, 0, 0);
    od = __builtin_amdgcn_mfma_f32_32x32x16_bf16(pa2, PK(l2, h2), od, 0, 0, 0);
    od = __builtin_amdgcn_mfma_f32_32x32x16_bf16(pa3, PK(l3, h3), od, 0, 0, 0);
#undef PK
}
__device__ __forceinline__ void pv_d0(f32x16* o, int vb, bf16x8 pa0, bf16x8 pa1, bf16x8 pa2, bf16x8 pa3) {
    pv_one<0>(o[0], vb, pa0, pa1, pa2, pa3); pv_one<1>(o[1], vb, pa0, pa1, pa2, pa3); pv_one<2>(o[2], vb, pa0, pa1, pa2, pa3); pv_one<3>(o[3], vb, pa0, pa1, pa2, pa3);
}

__device__ __forceinline__ void attn_unit(const bf16_t* __restrict__ Qb, const bf16_t* __restrict__ Kn, const bf16_t* __restrict__ Vh, const bf16_t* __restrict__ Kr,
                                          bf16_t* __restrict__ Ob, int seq, char* lds, int wv_) { LAUNDER_IDS;
    const int tid = tidx_, wid = __builtin_amdgcn_readfirstlane(tid >> 6), lane = tid & 63, r32 = lane & 31, hi = lane >> 5;
    LAS unsigned char* lds3 = (LAS unsigned char*)lds;
    float* ws = (float*)(lds + OFF_WS) + wid * 64; float* li_l = ws; float* al_l = ws + 32;
    float m_reg = -1e30f, l_reg = 0; f32x16 o[4] = {}; bf16x8 qr[12];
    const bf16_t* Qw = Qb + (long)(wid * QBLK + r32) * LDQ + hi * 8;
#pragma unroll
    for (int d0 = 0; d0 < 12; ++d0) qr[d0] = *reinterpret_cast<const bf16x8*>(Qw + d0 * 16);
    unsigned gkn[2], gv[2], gkr;
#pragma unroll
    for (int i = 0; i < 2; ++i) { const int c = wid * 2 + i; const int row = c * 4 + (lane >> 4), slot = lane & 15; gkn[i] = (unsigned)(row * (LDKV * 2) + ((slot ^ (row & 15)) << 4));
        const int st = c * 2 + (lane >> 5), kk = (st >> 2) * 8 + ((lane & 31) >> 2), k = (kk & ~0xC) | ((kk & 4) << 1) | ((kk & 8) >> 1), col = (st & 3) * 32 + (lane & 3) * 8; gv[i] = (unsigned)(k * (LDKV * 2) + col * 2); }
    { const int row = wid * 8 + (lane >> 3), slot = lane & 7; gkr = (unsigned)(row * 128 + ((slot ^ ((row >> 1) & 7)) << 4)); }
    const int vb0 = (int)(uintptr_t)(lds + OFF_V) + v_rd_base(lane);
#define DMA(t, slot) do { const char* kt_ = (const char*)Kn + (size_t)(t) * (KVBLK * LDKV * 2); const char* vt_ = (const char*)Vh + (size_t)(t) * (KVBLK * LDKV * 2); const char* rt_ = (const char*)Kr + (size_t)(t) * (KVBLK * 128); \
    _Pragma("unroll") for (int i_ = 0; i_ < 2; ++i_) { \
      __builtin_amdgcn_global_load_lds((const unsigned*)(kt_ + gkn[i_]), (LAS unsigned*)(lds3 + OFF_K + (slot) * SLOT_K + (wid * 2 + i_) * 1024), 16, 0, 0); \
      __builtin_amdgcn_global_load_lds((const unsigned*)(vt_ + gv[i_]), (LAS unsigned*)(lds3 + OFF_V + (slot) * SLOT_V + (wid * 2 + i_) * 1024), 16, 0, 0); } \
    __builtin_amdgcn_global_load_lds((const unsigned*)(rt_ + gkr), (LAS unsigned*)(lds3 + OFF_K + (slot) * SLOT_K + KR_OFF + wid * 1024), 16, 0, 0); } while (0)
#define WAIT_BAR() asm volatile("s_waitcnt vmcnt(0) lgkmcnt(0)\n\ts_barrier" ::: "memory")
#define RESC(a) do { if (__any((a) < 1.f)) { if (hi == 0) al_l[r32] = (a); asm volatile("s_waitcnt lgkmcnt(0)" ::: "memory"); \
    _Pragma("unroll") for (int d = 0; d < 4; ++d) _Pragma("unroll") for (int r = 0; r < 16; ++r) o[d][r] *= al_l[crow(r, hi)]; } } while (0)
    f32x16 pA0, pA1, pB0, pB1; float mnA, mnB, alA, alB; bf16x8 pa0, pa1, pa2, pa3; const int NT = seq / KVBLK;
    DMA(0, 0); DMA(1, 1); WAIT_BAR();
    qkt(pA0, pA1, lds + OFF_K, qr, r32, hi); __builtin_amdgcn_s_setprio(0); partialSM(pA0, pA1, m_reg, mnA, alA);
    int s_prev = 0, s_cur = 1, s_next = 2;
#define ROT() do { const int t_ = s_prev; s_prev = s_cur; s_cur = s_next; s_next = t_; } while (0)
    for (int j = 1; j + 1 < NT; j += 2) {
        DMA(j + 1, s_next); SBAR();
        qkt(pB0, pB1, lds + OFF_K + s_cur * SLOT_K, qr, r32, hi);
        finishSM(pA0, pA1, alA, l_reg, pa0, pa1, pa2, pa3); __builtin_amdgcn_s_setprio(0); SBAR();
        pv_d0(o, vb0 + s_prev * SLOT_V, pa0, pa1, pa2, pa3); partialSM(pB0, pB1, m_reg, mnB, alB);
        RESC(alB); WAIT_BAR(); ROT();
        DMA(j + 2, s_next); SBAR();
        qkt(pA0, pA1, lds + OFF_K + s_cur * SLOT_K, qr, r32, hi);
        finishSM(pB0, pB1, alB, l_reg, pa0, pa1, pa2, pa3); __builtin_amdgcn_s_setprio(0); SBAR();
        pv_d0(o, vb0 + s_prev * SLOT_V, pa0, pa1, pa2, pa3); partialSM(pA0, pA1, m_reg, mnA, alA);
        RESC(alA); WAIT_BAR(); ROT();
    }
    SBAR(); qkt(pB0, pB1, lds + OFF_K + s_cur * SLOT_K, qr, r32, hi);
    finishSM(pA0, pA1, alA, l_reg, pa0, pa1, pa2, pa3); __builtin_amdgcn_s_setprio(0); SBAR();
    pv_d0(o, vb0 + s_prev * SLOT_V, pa0, pa1, pa2, pa3); partialSM(pB0, pB1, m_reg, mnB, alB);
    RESC(alB);
    finishSM(pB0, pB1, alB, l_reg, pa0, pa1, pa2, pa3); __builtin_amdgcn_s_setprio(0); SBAR();
    pv_d0(o, vb0 + s_cur * SLOT_V, pa0, pa1, pa2, pa3);
    if (hi == 0) li_l[r32] = l_reg; asm volatile("s_waitcnt lgkmcnt(0)" ::: "memory");
    float rli[16];
#pragma unroll
    for (int r = 0; r < 16; ++r) rli[r] = __builtin_amdgcn_rcpf(li_l[crow(r, hi)]);
    bf16_t* Ow = Ob + (long)(wid * QBLK) * LDO;
#pragma unroll
    for (int r = 0; r < 16; ++r) { const int orow = crow(r, hi);
#pragma unroll
        for (int d0 = 0; d0 < 4; ++d0) Ow[(long)orow * LDO + d0 * 32 + r32] = (bf16_t)(cvt_pk_bf16(o[d0][r] * rli[r], 0.f) & 0xffffu); }
    WAIT_BAR();
#undef DMA
#undef WAIT_BAR
#undef RESC
#undef ROT
}
}


#define XB_TMO      128
#define XB_XCNT(j)  (256  + 64 * (j))
#define XB_XSUB(j)  (1280 + 64 * (j))
#define XB_XGEN(j)  (2304 + 64 * (j))
#define XB_TOP      3328
#define XB_TOPGEN   3392
#define XCD_BAR_WORDS 3456
#define XB_SPIN_CAP (1u << 22)
__device__ __forceinline__ unsigned xb_ld(unsigned* p)              { return __hip_atomic_load(p, __ATOMIC_RELAXED, __HIP_MEMORY_SCOPE_AGENT); }
__device__ __forceinline__ unsigned xb_add(unsigned* p, unsigned v) { return __hip_atomic_fetch_add(p, v, __ATOMIC_RELAXED, __HIP_MEMORY_SCOPE_AGENT); }
__device__ __forceinline__ unsigned xb_xcc_id() { return (unsigned)__builtin_amdgcn_s_getreg((3 << 11) | 20) & 0xFu; }
#define XB_SPIN(cond, bar) do { unsigned _sp = 0; while (cond) { __builtin_amdgcn_s_sleep(1); \
    if ((++_sp & 255u) == 0u) { if (xb_ld(&(bar)[XB_TMO])) break; if (_sp > XB_SPIN_CAP) { atomicAdd(&(bar)[XB_TMO], 1u); break; } } } } while (0)
struct XcdBarrier { unsigned* bar; unsigned x; volatile LAS unsigned* st; };
__device__ __forceinline__ XcdBarrier xcd_barrier_post(unsigned* bar, volatile LAS unsigned* st) {
    XcdBarrier b; b.bar = bar; b.x = xb_xcc_id(); b.st = st;
    if (threadIdx.x == 0) (void)xb_add(&bar[XB_XCNT(b.x)], 1u);
    return b;
}
__device__ __forceinline__ void xcd_barrier_complete(unsigned* bar, unsigned x, unsigned& nloc, unsigned& nx) {
    const unsigned G = gridDim.x * gridDim.y * gridDim.z;
    unsigned sum, cnt, mine, sp = 0u;
    for (;;) {
        sum = 0u; cnt = 0u; mine = 0u;
#pragma unroll
        for (unsigned j = 0; j < 16; ++j) { const unsigned c = xb_ld(&bar[XB_XCNT(j)]); sum += c; cnt += (c > 0u) ? 1u : 0u; mine = (j == x) ? c : mine; }
        if (sum == G) break;
        __builtin_amdgcn_s_sleep(1);
        if ((++sp & 255u) == 0u) { if (xb_ld(&bar[XB_TMO])) break; if (sp > XB_SPIN_CAP) { atomicAdd(&bar[XB_TMO], 1u); break; } }
    }
    nloc = mine > 0u ? mine : 1u; nx = cnt > 0u ? cnt : 1u;
}
__device__ __forceinline__ void xcd_barrier(const XcdBarrier& b) {
    asm volatile("s_waitcnt vmcnt(0)" ::: "memory");
    __syncthreads();
    if (threadIdx.x == 0) {
        unsigned* bar = b.bar;
        __builtin_amdgcn_s_waitcnt(0);
        unsigned nloc = b.st[0], nx = b.st[1];
        if (nloc == 0u) { xcd_barrier_complete(bar, b.x, nloc, nx); b.st[0] = nloc; b.st[1] = nx; }
        const unsigned old = xb_add(&bar[XB_XSUB(b.x)], 1u);
        const unsigned gen = old / nloc;
        if (old + 1u == (gen + 1u) * nloc) {
            __builtin_amdgcn_fence(__ATOMIC_RELEASE, "agent");
            asm volatile("s_waitcnt vmcnt(0)" ::: "memory");
            const unsigned og = xb_add(&bar[XB_TOP], 1u);
            const unsigned tg = og / nx;
            if (og + 1u == (tg + 1u) * nx) xb_add(&bar[XB_TOPGEN], 1u);
            else XB_SPIN(xb_ld(&bar[XB_TOPGEN]) == tg, bar);
            __builtin_amdgcn_fence(__ATOMIC_ACQUIRE, "agent");
            xb_add(&bar[XB_XGEN(b.x)], 1u);
            asm volatile("s_waitcnt vmcnt(0)" ::: "memory");
        } else {
            XB_SPIN(xb_ld(&bar[XB_XGEN(b.x)]) == gen, bar);
            __builtin_amdgcn_fence(__ATOMIC_ACQUIRE, "agent");
            asm volatile("s_waitcnt vmcnt(0)" ::: "memory");
        }
    }
    __syncthreads();
}

struct Args { const float* in[27]; float* out; unsigned char* ws; int ph_lo, ph_hi; };

__device__ __forceinline__ int map_row(int mode, int row_off, int n) {
    if (mode == 0) return row_off + n;
    if (mode == 1) return (n >> 7) * 256 + row_off + (n & 127);
    if (mode == 2) { if (n >= C_KPE && n < C_KPE + 64) { const int j = n - C_KPE; return C_KPE + (j < 32 ? 2 * j : 2 * (j - 32) + 1); } return n; }
    { const int h = n / 192, d = n % 192; if (d < 128) return n; const int j = d - 128; return h * 192 + 128 + (j < 32 ? 2 * j : 2 * (j - 32) + 1); }
}
__device__ __forceinline__ void transpose_item(const float* W, int K, int N, bf16_t* WT, int mode, int row_off, LAS float* scr, int item, int lane) {
    const int nblk = N / 32, kb = item / nblk, nb = item % nblk, k0 = 64 * kb, n0 = 32 * nb;
    float wv[32];
#pragma unroll
    for (int i = 0; i < 32; ++i) { const int kk = 2 * i + (lane >> 5); wv[i] = W[(size_t)(k0 + kk) * N + n0 + (lane & 31)]; }
#pragma unroll
    for (int i = 0; i < 32; ++i) { const int kk = 2 * i + (lane >> 5); scr[kk * 33 + (lane & 31)] = wv[i]; }
    asm volatile("s_waitcnt lgkmcnt(0)" ::: "memory");
    const int c = lane & 7;
#pragma unroll
    for (int j = 0; j < 4; ++j) { const int n = (lane >> 3) + 8 * j; const LAS float* s = scr + (8 * c) * 33 + n;
        u32x4 o; o.x = cvt_pk_bf16(s[0 * 33], s[1 * 33]); o.y = cvt_pk_bf16(s[2 * 33], s[3 * 33]); o.z = cvt_pk_bf16(s[4 * 33], s[5 * 33]); o.w = cvt_pk_bf16(s[6 * 33], s[7 * 33]);
        *(u32x4*)(WT + (size_t)map_row(mode, row_off, n0 + n) * K + k0 + 8 * c) = o; }
    asm volatile("s_waitcnt lgkmcnt(0)" ::: "memory");
}

__device__ __forceinline__ void rms_row_bf16(const float* xrow, const float* g, bf16_t* orow, int lane) {
    const f32x4* xr = (const f32x4*)xrow + lane; const f32x4* gr = (const f32x4*)g + lane;
    f32x4 v[8]; float s = 0.f;
#pragma unroll
    for (int j = 0; j < 8; ++j) { v[j] = xr[64 * j]; s += (v[j].x * v[j].x + v[j].y * v[j].y) + (v[j].z * v[j].z + v[j].w * v[j].w); }
    const float rstd = rsqrtf(wave_sum(s) * (1.f / DM) + RMS_EPS);
    u32x2* o8 = (u32x2*)orow + lane;
#pragma unroll
    for (int j = 0; j < 8; ++j) { const f32x4 gg = gr[64 * j]; u32x2 w; w.x = cvt_pk_bf16(v[j].x * rstd * gg.x, v[j].y * rstd * gg.y); w.y = cvt_pk_bf16(v[j].z * rstd * gg.z, v[j].w * rstd * gg.w); o8[64 * j] = w; }
}
__device__ __forceinline__ void rms_row_f32_inplace(float* xrow, const float* g, int lane) {
    f32x4* xr = (f32x4*)xrow + lane; const f32x4* gr = (const f32x4*)g + lane;
    f32x4 v[8]; float s = 0.f;
#pragma unroll
    for (int j = 0; j < 8; ++j) { v[j] = xr[64 * j]; s += (v[j].x * v[j].x + v[j].y * v[j].y) + (v[j].z * v[j].z + v[j].w * v[j].w); }
    const float rstd = rsqrtf(wave_sum(s) * (1.f / DM) + RMS_EPS);
#pragma unroll
    for (int j = 0; j < 8; ++j) { const f32x4 gg = gr[64 * j]; xr[64 * j] = v[j] * rstd * gg; }
}

__device__ __forceinline__ void phase_prologue(const Args& a, LAS unsigned char* lds, int wv_) { LAUNDER_IDS;
    const int tid = tidx_, lane = tid & 63, wave = tid >> 6;
    unsigned char* ws = a.ws;
    LAS float* scr = (LAS float*)(lds + wave * 16384);
    const int gw = bidx_ * 8 + wave, NGW = gridDim.x * 8;
    constexpr int I_GU = (DM / 64) * (DFF / 32), I_D = (DFF / 64) * (DM / 32), I_IN = (DM / 64) * (NIN / 32), I_UQ = (512 / 64) * (NQ / 32), I_UKV = (512 / 64) * (NKV / 32),
                  I_SQ = (DM / 64) * (DM / 32), I_G = 64 * 8;
    constexpr int NITEMS = 4 * I_GU + 2 * I_D + I_IN + I_UQ + I_UKV + 3 * I_SQ + I_G;
    for (int it = gw; it < NITEMS; it += NGW) {
        int r = it;
        if (r < I_GU) { transpose_item(a.in[3], DM, DFF, (bf16_t*)(ws + WS_W1GU), 1, 0, scr, r, lane); continue; } r -= I_GU;
        if (r < I_GU) { transpose_item(a.in[4], DM, DFF, (bf16_t*)(ws + WS_W1GU), 1, 128, scr, r, lane); continue; } r -= I_GU;
        if (r < I_GU) { transpose_item(a.in[23], DM, DFF, (bf16_t*)(ws + WS_W2GU), 1, 0, scr, r, lane); continue; } r -= I_GU;
        if (r < I_GU) { transpose_item(a.in[24], DM, DFF, (bf16_t*)(ws + WS_W2GU), 1, 128, scr, r, lane); continue; } r -= I_GU;
        if (r < I_D) { transpose_item(a.in[5], DFF, DM, (bf16_t*)(ws + WS_W1D), 0, 0, scr, r, lane); continue; } r -= I_D;
        if (r < I_D) { transpose_item(a.in[25], DFF, DM, (bf16_t*)(ws + WS_W2D), 0, 0, scr, r, lane); continue; } r -= I_D;
        if (r < I_IN) { transpose_item(a.in[7], DM, NIN, (bf16_t*)(ws + WS_WIN), 2, 0, scr, r, lane); continue; } r -= I_IN;
        if (r < I_UQ) { transpose_item(a.in[9], 512, NQ, (bf16_t*)(ws + WS_WUQ), 3, 0, scr, r, lane); continue; } r -= I_UQ;
        if (r < I_UKV) { transpose_item(a.in[11], 512, NKV, (bf16_t*)(ws + WS_WUKV), 0, 0, scr, r, lane); continue; } r -= I_UKV;
        if (r < I_SQ) { transpose_item(a.in[12], DM, DM, (bf16_t*)(ws + WS_WOA), 0, 0, scr, r, lane); continue; } r -= I_SQ;
        if (r < I_SQ) { transpose_item(a.in[20], DM, DM, (bf16_t*)(ws + WS_WOR), 0, 0, scr, r, lane); continue; } r -= I_SQ;
        if (r < I_SQ) { transpose_item(a.in[21], DM, DM, (bf16_t*)(ws + WS_WOUT), 0, 0, scr, r, lane); continue; } r -= I_SQ;
        { const int mat = r >> 3, sub = r & 7, type = mat & 1, db = mat >> 1;
          transpose_item((type ? a.in[17] : a.in[15]) + (size_t)db * 128 * 128, 128, 128, (bf16_t*)(ws + WS_WG), 0, mat * 128, scr, sub, lane); }
    }
    { const int gt = bidx_ * 512 + tid, NT = gridDim.x * 512; u32x4* p = (u32x4*)((bf16_t*)(ws + WS_WIN) + (size_t)NIN * DM);
      for (int i = gt; i < (NINP - NIN) * DM / 8; i += NT) p[i] = (u32x4){0u, 0u, 0u, 0u}; }
    { const int gt = bidx_ * 512 + tid, NT = gridDim.x * 512; float* cosT = (float*)(ws + WS_COS); float* sinT = (float*)(ws + WS_SIN); float* c8 = (float*)(ws + WS_C8);
      for (int i = gt; i < SEQ * 32; i += NT) { const int pos = i >> 5, j = i & 31; const float inv = powf(10000.0f, -(float)(2 * j) / 64.0f); const float ang = (float)pos * inv; cosT[i] = cosf(ang); sinT[i] = sinf(ang); }
      for (int i = gt; i < 2 * DM; i += NT) { const float l = a.in[19][i]; const float sp = (-l > 20.f) ? -l : log1pf(expf(-l)); c8[i] = 8.0f * sp; } }
    for (int m = gw; m < MTOT; m += NGW) { const float* xr = m < SEQ ? a.in[0] + (size_t)m * DM : a.in[1] + (size_t)(m - SEQ) * DM; rms_row_bf16(xr, a.in[2], (bf16_t*)(ws + WS_H) + (size_t)m * DM, lane); }
}

__device__ __forceinline__ void phase_norm(const Args& a, const float* g, int wv_) { LAUNDER_IDS;
    const int lane = tidx_ & 63, gw = bidx_ * 8 + (tidx_ >> 6), NGW = gridDim.x * 8;
    for (int m = gw; m < MTOT; m += NGW) rms_row_bf16(a.out + (size_t)m * DM, g, (bf16_t*)(a.ws + WS_H) + (size_t)m * DM, lane);
}
__device__ __forceinline__ void phase_final_norm(const Args& a, int wv_) { LAUNDER_IDS;
    const int lane = tidx_ & 63, gw = bidx_ * 8 + (tidx_ >> 6), NGW = gridDim.x * 8;
    for (int m = gw; m < MTOT; m += NGW) rms_row_f32_inplace(a.out + (size_t)m * DM, a.in[26], lane);
}

__device__ __forceinline__ void phase_small(const Args& a, int wv_) { LAUNDER_IDS;
    unsigned char* ws = a.ws; const int tid = tidx_, lane = tid & 63, gw = bidx_ * 8 + (tid >> 6), NGW = gridDim.x * 8;
    const bf16_t* proj = (const bf16_t*)(ws + WS_PROJ);
    for (int task = gw; task < 2 * SEQ; task += NGW) {
        const int row = task >> 1, which = task & 1;
        const bf16_t* src = proj + (size_t)row * NINP + (which ? C_CKV : C_CQ) + lane * 8;
        const u32x4 w = *(const u32x4*)src; float v[8] = {bf2f(w.x & 0xffffu), bf2f(w.x >> 16), bf2f(w.y & 0xffffu), bf2f(w.y >> 16), bf2f(w.z & 0xffffu), bf2f(w.z >> 16), bf2f(w.w & 0xffffu), bf2f(w.w >> 16)};
        float s = 0.f;
#pragma unroll
        for (int j = 0; j < 8; ++j) s += v[j] * v[j];
        const float rstd = rsqrtf(wave_sum(s) * (1.f / 512.f) + RMS_EPS);
        const float* g = (which ? a.in[10] : a.in[8]) + lane * 8; const f32x4 g0 = *(const f32x4*)g, g1 = *(const f32x4*)(g + 4);
        u32x4 o; o.x = cvt_pk_bf16(v[0] * rstd * g0.x, v[1] * rstd * g0.y); o.y = cvt_pk_bf16(v[2] * rstd * g0.z, v[3] * rstd * g0.w);
        o.z = cvt_pk_bf16(v[4] * rstd * g1.x, v[5] * rstd * g1.y); o.w = cvt_pk_bf16(v[6] * rstd * g1.z, v[7] * rstd * g1.w);
        *(u32x4*)((bf16_t*)(ws + (which ? WS_CKVN : WS_CQN)) + (size_t)row * 512 + lane * 8) = o;
        if (which && lane < 32) {
            const unsigned pw = *(const unsigned*)(proj + (size_t)row * NINP + C_KPE + 2 * lane); const float x1 = bf2f(pw & 0xffffu), x2 = bf2f(pw >> 16);
            const float c = ((const float*)(ws + WS_COS))[row * 32 + lane], sn = ((const float*)(ws + WS_SIN))[row * 32 + lane];
            *(unsigned*)((bf16_t*)(ws + WS_KPE) + (size_t)row * 64 + 2 * lane) = cvt_pk_bf16(x1 * c - x2 * sn, x2 * c + x1 * sn);
        }
    }
    const int gt = bidx_ * 512 + tid, NT = gridDim.x * 512; bf16_t* xc = (bf16_t*)(ws + WS_XC);
    for (int i = gt; i < SEQ * (DM / 8); i += NT) {
        const int row = i >> 8, c0 = (i & 255) * 8; float accv[8];
        { const f32x4 b0 = *(const f32x4*)(a.in[14] + c0), b1 = *(const f32x4*)(a.in[14] + c0 + 4); accv[0] = b0.x; accv[1] = b0.y; accv[2] = b0.z; accv[3] = b0.w; accv[4] = b1.x; accv[5] = b1.y; accv[6] = b1.z; accv[7] = b1.w; }
#pragma unroll
        for (int k = 0; k < 4; ++k) { const int t = row + k - 2; if (t < 0 || t >= SEQ) continue;
            const u32x4 w = *(const u32x4*)(proj + (size_t)t * NINP + C_XREC + c0); const f32x4 w0 = *(const f32x4*)(a.in[13] + k * DM + c0), w1 = *(const f32x4*)(a.in[13] + k * DM + c0 + 4);
            accv[0] += bf2f(w.x & 0xffffu) * w0.x; accv[1] += bf2f(w.x >> 16) * w0.y; accv[2] += bf2f(w.y & 0xffffu) * w0.z; accv[3] += bf2f(w.y >> 16) * w0.w;
            accv[4] += bf2f(w.z & 0xffffu) * w1.x; accv[5] += bf2f(w.z >> 16) * w1.y; accv[6] += bf2f(w.w & 0xffffu) * w1.z; accv[7] += bf2f(w.w >> 16) * w1.w; }
        u32x4 o; o.x = cvt_pk_bf16(accv[0], accv[1]); o.y = cvt_pk_bf16(accv[2], accv[3]); o.z = cvt_pk_bf16(accv[4], accv[5]); o.w = cvt_pk_bf16(accv[6], accv[7]);
        *(u32x4*)(xc + (size_t)row * DM + c0) = o;
    }
}

__device__ __forceinline__ void phase_scan1(const Args& a, int wv_) { LAUNDER_IDS;
    unsigned char* ws = a.ws; const int tid = tidx_;
    for (int it = bidx_; it < 1024; it += gridDim.x) {
        const int half = it & 1, dir = (it >> 1) & 1, c = it >> 2, ch = half * 1024 + tid * 2;
        const bf16_t* A = (const bf16_t*)(ws + (dir ? WS_AB : WS_AF)) + ch; const bf16_t* U = (const bf16_t*)(ws + (dir ? WS_UB : WS_UF)) + ch;
        f32x2 P = {1.f, 1.f}, Hh = {0.f, 0.f};
        unsigned awv[32], uwv[32];
#pragma unroll
        for (int i = 0; i < 32; ++i) { const int t = dir ? (c * 32 + 31 - i) : (c * 32 + i); awv[i] = *(const unsigned*)(A + (size_t)t * DM); uwv[i] = *(const unsigned*)(U + (size_t)t * DM); }
#pragma unroll
        for (int i = 0; i < 32; ++i) { const unsigned aw = awv[i], uw = uwv[i];
            const f32x2 av = {1.0f - bf2f(aw & 0xffffu), 1.0f - bf2f(aw >> 16)}, uv = {bf2f(uw & 0xffffu), bf2f(uw >> 16)}; Hh = av * Hh + uv; P = P * av; }
        *(f32x2*)((float*)(ws + WS_AGGA) + (size_t)(dir * 256 + c) * DM + ch) = P; *(f32x2*)((float*)(ws + WS_AGGB) + (size_t)(dir * 256 + c) * DM + ch) = Hh;
    }
}
__device__ __forceinline__ void phase_scan15(const Args& a, LAS unsigned char* lds, int wv_) { LAUNDER_IDS;
    if (bidx_ >= 32) return;
    unsigned char* ws = a.ws; const int tid = tidx_, seg = tid >> 6, cpl = tid & 63, idx = bidx_ * 64 + cpl, dir = idx >> 10, ch = (idx & 1023) * 2;
    const float* GA = (const float*)(ws + WS_AGGA) + (size_t)dir * 256 * DM + ch; const float* GB = (const float*)(ws + WS_AGGB) + (size_t)dir * 256 * DM + ch; float* CR = (float*)(ws + WS_CARRY) + (size_t)dir * 256 * DM + ch;
    LAS f32x4* seg_agg = (LAS f32x4*)lds;
    f32x2 A = {1.f, 1.f}, B = {0.f, 0.f};
#pragma unroll 8
    for (int i = 0; i < 32; ++i) { const int c = dir ? 255 - (seg * 32 + i) : seg * 32 + i; const f32x2 av = *(const f32x2*)(GA + (size_t)c * DM), bv = *(const f32x2*)(GB + (size_t)c * DM); B = av * B + bv; A = A * av; }
    seg_agg[seg * 64 + cpl] = (f32x4){A.x, A.y, B.x, B.y};
    __syncthreads();
    f32x2 carry = {0.f, 0.f};
    for (int k = 0; k < seg; ++k) { const f32x4 g = seg_agg[k * 64 + cpl]; carry = (f32x2){g.x, g.y} * carry + (f32x2){g.z, g.w}; }
    __syncthreads();
#pragma unroll 8
    for (int i = 0; i < 32; ++i) { const int c = dir ? 255 - (seg * 32 + i) : seg * 32 + i; *(f32x2*)(CR + (size_t)c * DM) = carry; const f32x2 av = *(const f32x2*)(GA + (size_t)c * DM), bv = *(const f32x2*)(GB + (size_t)c * DM); carry = av * carry + bv; }
}
__device__ __forceinline__ void phase_scan2(const Args& a, int wv_) { LAUNDER_IDS;
    unsigned char* ws = a.ws; const int tid = tidx_;
    const bf16_t* proj = (const bf16_t*)(ws + WS_PROJ); bf16_t* yg = (bf16_t*)(ws + WS_YG);
    for (int it = bidx_; it < 512; it += gridDim.x) {
        const int half = it & 1, c = it >> 1, ch = half * 1024 + tid * 2;
        const bf16_t* AF = (const bf16_t*)(ws + WS_AF) + ch; const bf16_t* UF = (const bf16_t*)(ws + WS_UF) + ch; const bf16_t* AB = (const bf16_t*)(ws + WS_AB) + ch; const bf16_t* UB = (const bf16_t*)(ws + WS_UB) + ch;
        f32x2 hf[32]; f32x2 h = *(const f32x2*)((const float*)(ws + WS_CARRY) + (size_t)c * DM + ch);
        { unsigned awv[32], uwv[32];
#pragma unroll
          for (int i = 0; i < 32; ++i) { const int t = c * 32 + i; awv[i] = *(const unsigned*)(AF + (size_t)t * DM); uwv[i] = *(const unsigned*)(UF + (size_t)t * DM); }
#pragma unroll
          for (int i = 0; i < 32; ++i) { const unsigned aw = awv[i], uw = uwv[i];
            const f32x2 av = {1.0f - bf2f(aw & 0xffffu), 1.0f - bf2f(aw >> 16)}, uv = {bf2f(uw & 0xffffu), bf2f(uw >> 16)}; h = av * h + uv; hf[i] = h; } }
        h = *(const f32x2*)((const float*)(ws + WS_CARRY) + (size_t)(256 + c) * DM + ch);
        { unsigned awv[32], uwv[32], gwv[32];
#pragma unroll
          for (int i = 0; i < 32; ++i) { const int t = c * 32 + i; awv[i] = *(const unsigned*)(AB + (size_t)t * DM); uwv[i] = *(const unsigned*)(UB + (size_t)t * DM); gwv[i] = *(const unsigned*)(proj + (size_t)t * NINP + C_GREC + ch); }
#pragma unroll
          for (int i = 31; i >= 0; --i) { const int t = c * 32 + i; const unsigned aw = awv[i], uw = uwv[i], gw = gwv[i];
            const f32x2 av = {1.0f - bf2f(aw & 0xffffu), 1.0f - bf2f(aw >> 16)}, uv = {bf2f(uw & 0xffffu), bf2f(uw >> 16)}; h = av * h + uv;
            const f32x2 hs = hf[i] + h;
            *(unsigned*)(yg + (size_t)t * DM + ch) = cvt_pk_bf16(gelu_tanh(bf2f(gw & 0xffffu)) * hs.x, gelu_tanh(bf2f(gw >> 16)) * hs.y); } }
    }
}

__device__ __forceinline__ void phase_attention(const Args& a, char* lds, int wv_) { LAUNDER_IDS;
    unsigned char* ws = a.ws; const int G = gridDim.x, bx = bidx_; const int vcu = (G % 8 == 0) ? (bx % 8) * (G / 8) + bx / 8 : bx;
    const bf16_t* Q = (const bf16_t*)(ws + WS_Q); const bf16_t* KV = (const bf16_t*)(ws + WS_KV); const bf16_t* KPE = (const bf16_t*)(ws + WS_KPE); bf16_t* O = (bf16_t*)(ws + WS_ATTO);
    for (int u = vcu; u < 512; u += G) { const int h = u >> 5, qb = u & 31;
        att::attn_unit(Q + (size_t)qb * 256 * NQ + h * 192, KV + h * 256, KV + h * 256 + 128, KPE, O + (size_t)qb * 256 * DM + h * 128, SEQ, lds, wv_); }
}

__device__ __forceinline__ void phase_ffn_up(const Args& a, LAS unsigned char* lds, int which, int wv_) {
    pg8::Gemm g{(const bf16_t*)(a.ws + WS_H), (const bf16_t*)(a.ws + (which ? WS_W2GU : WS_W1GU))};
    pg8::EpiSwiglu E{(bf16_t*)(a.ws + WS_ACT), DFF};
    pg8::gemm_phase<pg8::EpiSwiglu, MTOT, 2 * DFF, DM, DM, 0, 0>(lds, g, E, wv_);
}
__device__ __forceinline__ void phase_ffn_down(const Args& a, LAS unsigned char* lds, int which, int wv_) {
    pg8::Gemm g{(const bf16_t*)(a.ws + WS_ACT), (const bf16_t*)(a.ws + (which ? WS_W2D : WS_W1D))};
    pg8::EpiResid E{which ? a.out : a.in[0], which ? a.out : a.in[1], which ? MTOT : SEQ, a.out, 0.5f, 0};
    pg8::gemm_phase<pg8::EpiResid, MTOT, DM, DFF, DFF, 0, 0>(lds, g, E, wv_);
}
__device__ __forceinline__ void phase_wout(const Args& a, LAS unsigned char* lds, int s, int wv_) {
    pg8::Gemm g{(const bf16_t*)(a.ws + WS_H), (const bf16_t*)(a.ws + WS_WOUT)};
    pg8::EpiResid E{a.out, a.out, MTOT, a.out, 1.0f, 0};
    pg8::gemm_phase<pg8::EpiResid, MTOT, DM, DM, DM, 0, 0>(lds, g, E, wv_);
}
__device__ __forceinline__ void phase_win(const Args& a, LAS unsigned char* lds, int s, int wv_) {
    pg8::Gemm g{(const bf16_t*)(a.ws + WS_H) + (size_t)s * SEQ * DM, (const bf16_t*)(a.ws + WS_WIN)}; pg8::EpiBf16 E{(bf16_t*)(a.ws + WS_PROJ), NINP};
    pg8::gemm_phase<pg8::EpiBf16, SEQ, NINP, DM, DM, 0, 0>(lds, g, E, wv_);
}
__device__ __forceinline__ void phase_kv(const Args& a, LAS unsigned char* lds, int wv_) {
    pg8::Gemm g{(const bf16_t*)(a.ws + WS_CKVN), (const bf16_t*)(a.ws + WS_WUKV)}; pg8::EpiBf16 E{(bf16_t*)(a.ws + WS_KV), NKV};
    pg8::gemm_phase<pg8::EpiBf16, SEQ, NKV, 512, 512, 0, 0>(lds, g, E, wv_);
}

__device__ __forceinline__ void run_phase(const Args& a, int ph, unsigned char* lds_g, int wv_) {
    LAS unsigned char* lds = (LAS unsigned char*)lds_g; unsigned char* ws = a.ws;
    if (ph == 0) { if (PHM(0)) phase_prologue(a, lds, wv_); return; }
    if (ph == 1 || ph == 41) { if (PHM(1)) phase_ffn_up(a, lds, ph == 41, wv_); return; }
    if (ph == 2 || ph == 42) { if (PHM(2)) phase_ffn_down(a, lds, ph == 42, wv_); return; }
    if (ph == 3) { if (PHM(3)) phase_norm(a, a.in[6], wv_); return; }
    if (ph == 40) { if (PHM(3)) phase_norm(a, a.in[22], wv_); return; }
    if (ph == 39) { if (PHM(16)) phase_wout(a, lds, 0, wv_); return; }
    if (ph == 43) { if (PHM(4)) phase_final_norm(a, wv_); return; }
    const int s = (ph - 4) / 7, sub = (ph - 4) % 7;
    switch (sub) {
    case 0: if (PHM(5)) phase_win(a, lds, s, wv_); break;
    case 1: if (PHM(6)) phase_small(a, wv_); break;
    case 2: {
        if (PHM(7)) { pg8::Gemm g{(const bf16_t*)(ws + WS_CQN), (const bf16_t*)(ws + WS_WUQ)}; pg8::EpiQ E{(bf16_t*)(ws + WS_Q), (const float*)(ws + WS_COS), (const float*)(ws + WS_SIN)};
          pg8::gemm_phase<pg8::EpiQ, SEQ, NQ, 512, 512, 0, 0>(lds, g, E, wv_); }
        if (PHM(15)) phase_kv(a, lds, wv_);
        if (PHM(8)) { pg8::Gemm g{(const bf16_t*)(ws + WS_XC), (const bf16_t*)(ws + WS_WG)};
          pg8::EpiGates E{(const bf16_t*)(ws + WS_XC), a.in[16], a.in[18], (const float*)(ws + WS_C8), (bf16_t*)(ws + WS_AF), (bf16_t*)(ws + WS_UF), (size_t)(WS_AB - WS_AF) / 2};
          pg8::gemm_phase<pg8::EpiGates, SEQ, 8192, 128, DM, 16, 128>(lds, g, E, wv_); }
        break; }
    case 3: if (PHM(9)) phase_attention(a, (char*)lds_g, wv_); if (PHM(10)) phase_scan1(a, wv_); break;
    case 4: {
        if (PHM(11)) phase_scan15(a, lds, wv_);
        if (PHM(12)) { pg8::Gemm g{(const bf16_t*)(ws + WS_ATTO), (const bf16_t*)(ws + WS_WOA)}; pg8::EpiT1 E{(const bf16_t*)(ws + WS_PROJ) + C_GA, NINP, (bf16_t*)(ws + WS_T1)};
        pg8::gemm_phase<pg8::EpiT1, SEQ, DM, DM, DM, 0, 0>(lds, g, E, wv_); } break; }
    case 5: if (PHM(13)) phase_scan2(a, wv_); break;
    case 6: {
        if (PHM(14)) { pg8::Gemm g{(const bf16_t*)(ws + WS_YG), (const bf16_t*)(ws + WS_WOR)}; pg8::EpiMerge E{(const bf16_t*)(ws + WS_PROJ) + C_GR, NINP, (const bf16_t*)(ws + WS_T1), (bf16_t*)(ws + WS_H) + (size_t)s * SEQ * DM};
        pg8::gemm_phase<pg8::EpiMerge, SEQ, DM, DM, DM, 0, 0>(lds, g, E, wv_); } break; }
    default: break;
    }
}

__global__ void __launch_bounds__(512, 2) mega(Args a) {
    extern __shared__ __attribute__((aligned(16))) unsigned char lds[];
    cg::grid_group grid = cg::this_grid();
    const int wv_ = __builtin_amdgcn_readfirstlane(threadIdx.x >> 6);
    volatile LAS unsigned* misc = (volatile LAS unsigned*)((LAS unsigned char*)lds + (LDS_BYTES - 64));
    if (threadIdx.x < 2) misc[threadIdx.x] = 0u;
    __syncthreads();
    XcdBarrier bar = xcd_barrier_post((unsigned*)(a.ws + WS_CTL), misc);
    for (int ph = a.ph_lo; ph < a.ph_hi; ++ph) {
#ifdef PROBE_REPEAT
        if (PROBE_REPEAT(ph)) { run_phase(a, ph, lds, wv_); xcd_barrier(bar); }
#endif
        run_phase(a, ph, lds, wv_);
        if (ph + 1 < a.ph_hi) { if (ph == a.ph_lo) grid.sync(); else xcd_barrier(bar); }
    }
}

extern "C" void kernel_launch(void* const* d_in, const int* in_sizes, int n_in, void* d_out, int out_size, void* d_ws, size_t ws_size, hipStream_t stream) {
    static int grid = 0;
    if (grid == 0) {
        if (n_in != 27 || out_size != MTOT * DM || ws_size < WS_END) { fprintf(stderr, "kernel_launch: unexpected shapes: n_in %d out %d ws %zu (need %zu)\n", n_in, out_size, ws_size, (size_t)WS_END); grid = -1; return; }
        int dev = 0, cus = 0, per_cu = 0;
        (void)hipGetDevice(&dev); (void)hipDeviceGetAttribute(&cus, hipDeviceAttributeMultiprocessorCount, dev);
        if (hipFuncSetAttribute((const void*)mega, hipFuncAttributeMaxDynamicSharedMemorySize, LDS_BYTES) != hipSuccess) { fprintf(stderr, "kernel_launch: hipFuncSetAttribute failed\n"); grid = -1; return; }
        (void)hipOccupancyMaxActiveBlocksPerMultiprocessor(&per_cu, (const void*)mega, 512, LDS_BYTES);
        if (per_cu < 1) { fprintf(stderr, "kernel_launch: occupancy query says %d blocks/CU\n", per_cu); per_cu = 1; }
        (void)hipGetLastError();
        grid = cus;
    }
    if (grid < 0) return;
    if (hipMemsetAsync((char*)d_ws + WS_CTL, 0, CTL_BYTES, stream) != hipSuccess) { fprintf(stderr, "kernel_launch: hipMemsetAsync failed\n"); return; }
    Args a{};
    for (int i = 0; i < 27; ++i) a.in[i] = (const float*)d_in[i];
    a.out = (float*)d_out; a.ws = (unsigned char*)d_ws;
#if MK_ONE_LAUNCH
    a.ph_lo = 0; a.ph_hi = NPH;
    { void* args[] = {&a}; hipError_t e = hipLaunchCooperativeKernel((const void*)mega, dim3(grid), dim3(512), args, LDS_BYTES, stream);
      if (e != hipSuccess) fprintf(stderr, "cooperative launch failed: %s (grid %d)\n", hipGetErrorString(e), grid); }
#else
    for (int ph = 0; ph < NPH; ++ph) {
        a.ph_lo = ph; a.ph_hi = ph + 1;
        void* args[] = {&a}; hipError_t e = hipLaunchCooperativeKernel((const void*)mega, dim3(grid), dim3(512), args, LDS_BYTES, stream);
        if (e != hipSuccess) { fprintf(stderr, "cooperative launch %d failed: %s (grid %d)\n", ph, hipGetErrorString(e), grid); break; }
    }
#endif
}
```

```cpp
#include <hip/hip_runtime.h>
#include <hip/hip_cooperative_groups.h>
#include <cstdio>
#include <cstdint>
namespace cg = cooperative_groups;

#ifndef MK_ONE_LAUNCH
#define MK_ONE_LAUNCH 1
#endif
#ifndef PH_MASK
#define PH_MASK 0xffffffffu
#endif
#define PHM(k) (((PH_MASK) >> (k)) & 1u)
#define LAUNDER_IDS int tidx_ = wv_ * 64 + (int)__builtin_amdgcn_mbcnt_hi(~0u, __builtin_amdgcn_mbcnt_lo(~0u, 0u)), bidx_ = blockIdx.x; asm volatile("" : "+v"(tidx_), "+s"(bidx_))

#define LAS __attribute__((address_space(3)))
typedef unsigned short bf16_t;
typedef short bf16x8 __attribute__((ext_vector_type(8)));
typedef short s16x4 __attribute__((ext_vector_type(4)));
typedef float f32x4 __attribute__((ext_vector_type(4)));
typedef float f32x2 __attribute__((ext_vector_type(2)));
typedef float f32x16 __attribute__((ext_vector_type(16)));
typedef unsigned u32x4 __attribute__((ext_vector_type(4)));
typedef unsigned u32x2 __attribute__((ext_vector_type(2)));

constexpr int DM = 2048, SEQ = 8192, NSEQ = 5, MTOT = NSEQ * SEQ, DFF = 5632;
constexpr int NIN = 9280, NINP = 9472;
constexpr int NQ = 3072, NKV = 4096;
constexpr int C_CQ = 0, C_CKV = 512, C_KPE = 1024, C_XREC = 1088, C_GREC = 3136, C_GA = 5184, C_GR = 7232;
constexpr float RMS_EPS = 1e-6f;
constexpr float QSCALE = 0.07216878364870322f * 1.4426950408889634f;

constexpr size_t MiB = 1u << 20;
constexpr size_t WS_COS = 0, WS_SIN = 1 * MiB, WS_C8 = 2 * MiB, WS_CTL = 3 * MiB, CTL_BYTES = 16384;
constexpr size_t WS_W1GU = 4 * MiB, WS_W1D = 48 * MiB, WS_W2GU = 70 * MiB, WS_W2D = 114 * MiB, WS_WIN = 136 * MiB, WS_WUQ = 173 * MiB,
                 WS_WUKV = 176 * MiB, WS_WOA = 180 * MiB, WS_WOR = 188 * MiB, WS_WOUT = 196 * MiB, WS_WG = 204 * MiB;
constexpr size_t WS_H = 206 * MiB, WS_ACT = 366 * MiB;
constexpr size_t WS_PROJ = 366 * MiB, WS_CQN = 514 * MiB, WS_CKVN = 522 * MiB, WS_KPE = 530 * MiB, WS_XC = 532 * MiB, WS_MERGED = 532 * MiB,
                 WS_Q = 564 * MiB, WS_KV = 612 * MiB, WS_T1 = 564 * MiB, WS_AF = 676 * MiB, WS_UF = 740 * MiB, WS_AB = 804 * MiB, WS_UB = 868 * MiB,
                 WS_ATTO = 932 * MiB, WS_YG = 964 * MiB, WS_AGGA = 996 * MiB, WS_AGGB = 1000 * MiB, WS_CARRY = 1004 * MiB, WS_END = 1008 * MiB;

constexpr int LDS_BYTES = 135168;
constexpr int NPH = 44;

__device__ __forceinline__ float bf2f(unsigned b) { return __uint_as_float(b << 16); }
__device__ __forceinline__ unsigned cvt_pk_bf16(float lo, float hi) { unsigned r; asm volatile("v_cvt_pk_bf16_f32 %0, %1, %2" : "=v"(r) : "v"(lo), "v"(hi)); return r; }
__device__ __forceinline__ float fsigmoid(float x) { return __builtin_amdgcn_rcpf(1.0f + __expf(-x)); }
__device__ __forceinline__ float wave_sum(float v) {
    v += __int_as_float(__builtin_amdgcn_ds_swizzle(__float_as_int(v), 0x041f));
    v += __int_as_float(__builtin_amdgcn_ds_swizzle(__float_as_int(v), 0x081f));
    v += __int_as_float(__builtin_amdgcn_ds_swizzle(__float_as_int(v), 0x101f));
    v += __int_as_float(__builtin_amdgcn_ds_swizzle(__float_as_int(v), 0x201f));
    v += __int_as_float(__builtin_amdgcn_ds_swizzle(__float_as_int(v), 0x401f));
    auto rr = __builtin_amdgcn_permlane32_swap(__float_as_uint(v), __float_as_uint(v), false, false);
    return __uint_as_float(rr[0]) + __uint_as_float(rr[1]);
}
__device__ __forceinline__ float gelu_tanh(float x) {
    const float z = 0.7978845608028654f * (x + 0.044715f * x * x * x);
    const float e = __expf(2.0f * z);
    const float t = 1.0f - 2.0f * __builtin_amdgcn_rcpf(1.0f + e);
    return 0.5f * x * (1.0f + t);
}

namespace pg8 {
constexpr int BM = 256, BK = 64, HALF = 128, HTB = HALF * BK * 2, STAGE_BYTES = 8 * HTB, NXCD = 8, WGM = 4;
__host__ __device__ __forceinline__ int lds_byte(int r, int c) { const int st = (r >> 4) * 2 + (c >> 5), rr = r & 15, cc = c & 31, ob = rr * 64 + cc * 2; return st * 1024 + (ob ^ (((ob >> 9) & 1) << 5)); }
__host__ __device__ __forceinline__ void stage_rc(int b, int& R, int& C) { const int st = b / 1024, sb = b % 1024, swz = sb ^ (((sb >> 9) & 1) << 5); R = (st >> 1) * 16 + swz / 64; C = (st & 1) * 32 + (swz % 64) / 2; }
__host__ __device__ __forceinline__ int perm32(int rho) { const int n = rho >> 4, i = rho & 15; return 8 * (i >> 2) + 4 * n + (i & 3); }

struct Unit { int pm, pn; };
struct Gemm { const bf16_t* A; const bf16_t* Bt; };

struct StaticOrder {
    int nM, nN, nwg, G, c;
    __device__ void init(int M, int N, int G_, int c_) { nM = M / BM; nN = N / BM; nwg = nM * nN; G = G_; c = c_; }
    __device__ bool next(int i, Unit& u) const {
        const long L = (long)i * G + c; if (L >= nwg) return false;
        int wgid = (int)L; { const int q = nwg / NXCD, r = nwg % NXCD, xcd = wgid % NXCD, off = wgid / NXCD; wgid = (xcd < r ? xcd * (q + 1) : r * (q + 1) + (xcd - r) * q) + off; }
        const int nig = WGM * nN, gid = wgid / nig, fm = gid * WGM, gsz = (nM - fm) < WGM ? (nM - fm) : WGM;
        u.pm = fm + ((wgid % nig) % gsz); u.pn = (wgid % nig) / gsz; return true;
    }
};

template <class Epi, int GM, int GN, int GK, int LDA, int AMOD, int ASTRIDE>
__device__ __forceinline__ void gemm_phase(LAS unsigned char* lds, const Gemm g, const Epi& E, int wv_) {
    int tid_ = wv_ * 64 + (int)__builtin_amdgcn_mbcnt_hi(~0u, __builtin_amdgcn_mbcnt_lo(~0u, 0u)), bid_ = blockIdx.x; asm volatile("" : "+v"(tid_), "+s"(bid_));
    const int tid = tid_, wid = __builtin_amdgcn_readfirstlane(tid >> 6), lane = tid & 63, wr = wid >> 2, wc = wid & 3, fr = lane & 15, fq = lane >> 4;
    constexpr int K = GK, lda = LDA; int nt = K / BK; asm volatile("" : "+s"(nt));
    StaticOrder S; S.init(GM, GN, (int)gridDim.x, bid_);
    unsigned voffA[2], voffB[2];
#pragma unroll
    for (int i = 0; i < 2; ++i) { int R, C; stage_rc(tid * 16 + i * 8192, R, C); const int Rb = Epi::PERM ? ((R & ~31) + perm32(R & 31)) : R;
        voffA[i] = (unsigned)(R * lda + C) * 2u; voffB[i] = (unsigned)(Rb * K + C) * 2u; }
    const size_t kstep = (size_t)(BK * 2);
    const size_t hstepA = (size_t)HALF * lda * 2, tstepA = 2 * hstepA;
    const size_t hstepB = (size_t)HALF * K * 2, tstepB = 2 * hstepB;
    const unsigned ldsw = (unsigned)wid * 1024u;
    const int aoff = lds_byte(wr * 64 + fr, fq * 8), boff = lds_byte(wc * 32 + fr, fq * 8);
#define PG8_SA(b, h) (((b) * 2 + (h)) * HTB)
#define PG8_SB(b, h) ((4 + (b) * 2 + (h)) * HTB)
#define PG8_STAGE(bufoff, gbase, voff) do { _Pragma("unroll") for (int _i = 0; _i < 2; ++_i) \
        __builtin_amdgcn_global_load_lds((const unsigned*)((const char*)(gbase) + (voff)[_i]), (LAS unsigned*)(lds + (bufoff) + ldsw + _i * 8192), 16, 0, 0); } while (0)
#define PG8_LDA(dst, b, h) do { _Pragma("unroll") for (int m = 0; m < 4; ++m) _Pragma("unroll") for (int k = 0; k < 2; ++k) dst[m][k] = *(const LAS bf16x8*)(lds + PG8_SA(b, h) + aoff + m * 2048 + k * 1024); } while (0)
#define PG8_LDB(dst, b, h) do { _Pragma("unroll") for (int n = 0; n < 2; ++n) _Pragma("unroll") for (int k = 0; k < 2; ++k) dst[n][k] = *(const LAS bf16x8*)(lds + PG8_SB(b, h) + boff + n * 2048 + k * 1024); } while (0)
#define PG8_MMA(ai, bj, At, Bt) do { __builtin_amdgcn_s_setprio(1); _Pragma("unroll") for (int m = 0; m < 4; ++m) _Pragma("unroll") for (int n = 0; n < 2; ++n) _Pragma("unroll") for (int k = 0; k < 2; ++k) \
        acc[ai][bj][m][n] = __builtin_amdgcn_mfma_f32_16x16x32_bf16(Bt[n][k], At[m][k], acc[ai][bj][m][n], 0, 0, 0); __builtin_amdgcn_s_setprio(0); } while (0)
#define PG8_WAIT_V(n) asm volatile("s_waitcnt vmcnt(" #n ")" ::: "memory")
#define PG8_WAIT_L(n) asm volatile("s_waitcnt lgkmcnt(" #n ")" ::: "memory")
#define PG8_BAR __builtin_amdgcn_s_barrier()
#define PG8_SCHED __builtin_amdgcn_sched_barrier(0)
#define PG8_AOFF(pn) (AMOD ? (size_t)((pn) % (AMOD ? AMOD : 1)) * (size_t)ASTRIDE * 2 : (size_t)0)
    Unit cur, nxt; int ui = 0;
    if (!S.next(0, cur)) return;
    f32x4 acc[2][2][4][2];
#pragma unroll
    for (int a = 0; a < 2; ++a)
#pragma unroll
        for (int b = 0; b < 2; ++b)
#pragma unroll
            for (int m = 0; m < 4; ++m)
#pragma unroll
                for (int n = 0; n < 2; ++n) acc[a][b][m][n] = (f32x4){0.f, 0.f, 0.f, 0.f};
    bf16x8 At[4][2], B0[2][2], B1[2][2];
    const char* cA = (const char*)g.A + (size_t)cur.pm * tstepA + PG8_AOFF(cur.pn); const char* cB = (const char*)g.Bt + (size_t)cur.pn * tstepB;
    PG8_STAGE(PG8_SB(0, 0), cB, voffB); PG8_STAGE(PG8_SB(0, 1), cB + hstepB, voffB); PG8_STAGE(PG8_SA(0, 0), cA, voffA); PG8_STAGE(PG8_SA(0, 1), cA + hstepA, voffA);
    if (wr == 1) PG8_BAR;
    PG8_WAIT_V(2); PG8_BAR;
    PG8_STAGE(PG8_SB(1, 0), cB + kstep, voffB); PG8_STAGE(PG8_SA(1, 0), cA + kstep, voffA); PG8_STAGE(PG8_SB(1, 1), cB + hstepB + kstep, voffB);
    PG8_WAIT_V(6); PG8_BAR;
    for (;;) {
        const bool has_next = S.next(ui + 1, nxt);
        const char* nA = has_next ? (const char*)g.A + (size_t)nxt.pm * tstepA + PG8_AOFF(nxt.pn) : cA; const char* nB = has_next ? (const char*)g.Bt + (size_t)nxt.pn * tstepB : cB;
        for (int t = 0; t < nt; t += 2) {
            const bool last = (t == nt - 2);
            const char* a1 = cA + (size_t)(t + 1) * kstep;
            const char* a2 = last ? nA : cA + (size_t)(t + 2) * kstep; const char* b2 = last ? nB : cB + (size_t)(t + 2) * kstep;
            const char* a3 = a2 + kstep; const char* b3 = b2 + kstep;
            PG8_LDB(B0, 0, 0); PG8_LDB(B1, 0, 1); PG8_SCHED; PG8_LDA(At, 0, 0); PG8_STAGE(PG8_SA(1, 1), a1 + hstepA, voffA);
            PG8_WAIT_V(8); PG8_WAIT_L(0); PG8_BAR; PG8_MMA(0, 0, At, B0); PG8_MMA(0, 1, At, B1); PG8_BAR; PG8_SCHED;
            PG8_LDA(At, 0, 1); PG8_STAGE(PG8_SB(0, 0), b2, voffB); PG8_STAGE(PG8_SB(0, 1), b2 + hstepB, voffB); PG8_STAGE(PG8_SA(0, 0), a2, voffA);
            PG8_WAIT_V(8); PG8_WAIT_L(0); PG8_BAR; PG8_MMA(1, 0, At, B0); PG8_MMA(1, 1, At, B1); PG8_BAR; PG8_SCHED;
            PG8_LDB(B0, 1, 0); PG8_LDB(B1, 1, 1); PG8_SCHED; PG8_LDA(At, 1, 0); PG8_STAGE(PG8_SA(0, 1), a2 + hstepA, voffA);
            PG8_WAIT_V(8); PG8_WAIT_L(0); PG8_BAR; PG8_MMA(0, 0, At, B0); PG8_MMA(0, 1, At, B1); PG8_BAR; PG8_SCHED;
            PG8_LDA(At, 1, 1); PG8_STAGE(PG8_SB(1, 0), b3, voffB); PG8_STAGE(PG8_SB(1, 1), b3 + hstepB, voffB); PG8_STAGE(PG8_SA(1, 0), a3, voffA);
            PG8_WAIT_V(8); PG8_WAIT_L(0); PG8_BAR; PG8_MMA(1, 0, At, B0); PG8_MMA(1, 1, At, B1); PG8_BAR; PG8_SCHED;
        }
        if (wr == 0) PG8_BAR;
        { int fr2 = fr, fq2 = fq; asm volatile("" : "+v"(fr2), "+v"(fq2)); E(acc, cur, wr, wc, fr2, fq2); }
        if (!has_next) break;
#pragma unroll
        for (int a = 0; a < 2; ++a)
#pragma unroll
            for (int b = 0; b < 2; ++b)
#pragma unroll
                for (int m = 0; m < 4; ++m)
#pragma unroll
                    for (int n = 0; n < 2; ++n) acc[a][b][m][n] = (f32x4){0.f, 0.f, 0.f, 0.f};
        cur = nxt; cA = nA; cB = nB; ++ui;
        if (wr == 1) PG8_BAR;
    }
    PG8_WAIT_V(0);
    PG8_BAR;
#undef PG8_SA
#undef PG8_SB
#undef PG8_STAGE
#undef PG8_LDA
#undef PG8_LDB
#undef PG8_MMA
#undef PG8_WAIT_V
#undef PG8_WAIT_L
#undef PG8_BAR
#undef PG8_SCHED
#undef PG8_AOFF
}

typedef f32x4 Acc[2][2][4][2];

struct EpiBf16 {
    static constexpr bool PERM = true;
    bf16_t* O; int ldc;
    __device__ __forceinline__ void operator()(const Acc& acc, const Unit& u, int wr, int wc, int fr, int fq) const {
        const int row0 = u.pm * BM + wr * 64 + fr, col0 = u.pn * BM + wc * 32 + 8 * fq;
#pragma unroll
        for (int ai = 0; ai < 2; ++ai)
#pragma unroll
            for (int m = 0; m < 4; ++m) { bf16_t* rowp = O + (size_t)(row0 + ai * HALF + m * 16) * ldc + col0;
#pragma unroll
                for (int bj = 0; bj < 2; ++bj) { const f32x4 v0 = acc[ai][bj][m][0], v1 = acc[ai][bj][m][1];
                    u32x4 w; w.x = cvt_pk_bf16(v0[0], v0[1]); w.y = cvt_pk_bf16(v0[2], v0[3]); w.z = cvt_pk_bf16(v1[0], v1[1]); w.w = cvt_pk_bf16(v1[2], v1[3]);
                    *(u32x4*)(rowp + bj * HALF) = w; } asm volatile("" ::: "memory"); }
    }
};
struct EpiSwiglu {
    static constexpr bool PERM = true;
    bf16_t* O; int ldc;
    __device__ __forceinline__ void operator()(const Acc& acc, const Unit& u, int wr, int wc, int fr, int fq) const {
        const int row0 = u.pm * BM + wr * 64 + fr, col0 = u.pn * HALF + wc * 32 + 8 * fq;
#pragma unroll
        for (int ai = 0; ai < 2; ++ai)
#pragma unroll
            for (int m = 0; m < 4; ++m) { bf16_t* rowp = O + (size_t)(row0 + ai * HALF + m * 16) * ldc + col0;
                float r[8];
#pragma unroll
                for (int n = 0; n < 2; ++n)
#pragma unroll
                    for (int j = 0; j < 4; ++j) { const float gv = acc[ai][0][m][n][j], uv = acc[ai][1][m][n][j]; r[n * 4 + j] = gv * fsigmoid(gv) * uv; }
                u32x4 w; w.x = cvt_pk_bf16(r[0], r[1]); w.y = cvt_pk_bf16(r[2], r[3]); w.z = cvt_pk_bf16(r[4], r[5]); w.w = cvt_pk_bf16(r[6], r[7]);
                *(u32x4*)rowp = w; asm volatile("" ::: "memory"); }
    }
};
struct EpiResid {
    static constexpr bool PERM = false;
    const float* res0; const float* res1; int split; float* out; float alpha; int row_base;
    __device__ __forceinline__ void operator()(const Acc& acc, const Unit& u, int wr, int wc, int fr, int fq) const {
        const int grow0 = row_base + u.pm * BM; const float* rb = grow0 < split ? res0 + (size_t)grow0 * DM : res1 + (size_t)(grow0 - split) * DM;
        float* ob = out + (size_t)grow0 * DM; const int col0 = u.pn * BM + wc * 32 + 4 * fq;
#pragma unroll
        for (int ai = 0; ai < 2; ++ai)
#pragma unroll
            for (int m = 0; m < 4; ++m) { const size_t off = (size_t)(ai * HALF + wr * 64 + m * 16 + fr) * DM + col0;
#pragma unroll
                for (int bj = 0; bj < 2; ++bj)
#pragma unroll
                    for (int n = 0; n < 2; ++n) { const f32x4 bs = *(const f32x4*)(rb + off + bj * HALF + n * 16); *(f32x4*)(ob + off + bj * HALF + n * 16) = bs + acc[ai][bj][m][n] * alpha; } asm volatile("" ::: "memory"); }
    }
};
struct EpiQ {
    static constexpr bool PERM = true;
    bf16_t* O; const float* cosT; const float* sinT;
    __device__ __forceinline__ void operator()(const Acc& acc, const Unit& u, int wr, int wc, int fr, int fq) const {
        const int row0 = u.pm * BM + wr * 64 + fr;
#pragma unroll
        for (int bj = 0; bj < 2; ++bj) { const int col0 = u.pn * BM + bj * HALF + wc * 32 + 8 * fq; const int d = col0 % 192; const bool rope = d >= 128; const int jp0 = (d - 128) >> 1;
#pragma unroll
            for (int ai = 0; ai < 2; ++ai)
#pragma unroll
                for (int m = 0; m < 4; ++m) { const int row = row0 + ai * HALF + m * 16; f32x4 v0 = acc[ai][bj][m][0], v1 = acc[ai][bj][m][1];
                    if (rope) { const f32x4 c = *(const f32x4*)(cosT + (size_t)row * 32 + jp0), s = *(const f32x4*)(sinT + (size_t)row * 32 + jp0);
                        const f32x4 a0 = v0, a1 = v1;
                        v0[0] = a0[0] * c[0] - a0[1] * s[0]; v0[1] = a0[1] * c[0] + a0[0] * s[0]; v0[2] = a0[2] * c[1] - a0[3] * s[1]; v0[3] = a0[3] * c[1] + a0[2] * s[1];
                        v1[0] = a1[0] * c[2] - a1[1] * s[2]; v1[1] = a1[1] * c[2] + a1[0] * s[2]; v1[2] = a1[2] * c[3] - a1[3] * s[3]; v1[3] = a1[3] * c[3] + a1[2] * s[3]; }
                    v0 = v0 * QSCALE; v1 = v1 * QSCALE;
                    u32x4 w; w.x = cvt_pk_bf16(v0[0], v0[1]); w.y = cvt_pk_bf16(v0[2], v0[3]); w.z = cvt_pk_bf16(v1[0], v1[1]); w.w = cvt_pk_bf16(v1[2], v1[3]);
                    *(u32x4*)(O + (size_t)row * NQ + col0) = w; asm volatile("" ::: "memory"); } }
    }
};
struct EpiGates {
    static constexpr bool PERM = true;
    const bf16_t* xc; const float* b_a; const float* b_i; const float* c8; bf16_t* Aout; bf16_t* Uout; size_t dir_stride;
    __device__ __forceinline__ void operator()(const Acc& acc, const Unit& u, int wr, int wc, int fr, int fq) const {
        const int dir = u.pn >> 4, blk = u.pn & 15; const int row0 = u.pm * BM + wr * 64 + fr; const int ch0 = blk * HALF + wc * 32 + 8 * fq;
        bf16_t* Ao = Aout + (size_t)dir * dir_stride; bf16_t* Uo = Uout + (size_t)dir * dir_stride;
        f32x4 ba[2], bi[2], cc[2];
#pragma unroll
        for (int n = 0; n < 2; ++n) { ba[n] = *(const f32x4*)(b_a + dir * DM + ch0 + 4 * n); bi[n] = *(const f32x4*)(b_i + dir * DM + ch0 + 4 * n); cc[n] = *(const f32x4*)(c8 + dir * DM + ch0 + 4 * n); }
#pragma unroll
        for (int ai = 0; ai < 2; ++ai)
#pragma unroll
            for (int m = 0; m < 4; ++m) { const int row = row0 + ai * HALF + m * 16; const size_t off = (size_t)row * DM + ch0;
                const u32x4 xw = *(const u32x4*)(xc + off);
                const float xv[8] = {bf2f(xw.x & 0xffffu), bf2f(xw.x >> 16), bf2f(xw.y & 0xffffu), bf2f(xw.y >> 16), bf2f(xw.z & 0xffffu), bf2f(xw.z >> 16), bf2f(xw.w & 0xffffu), bf2f(xw.w >> 16)};
                float om[8], uv[8];
#pragma unroll
                for (int n = 0; n < 2; ++n)
#pragma unroll
                    for (int j = 0; j < 4; ++j) { const float r = fsigmoid(acc[ai][0][m][n][j] + ba[n][j]), ig = fsigmoid(acc[ai][1][m][n][j] + bi[n][j]);
                        const float y = r * cc[n][j];
                        float o1 = y * (1.0f - y * (0.5f - y * (0.16666667f - y * (0.041666668f - y * 0.008333334f))));
                        if (__builtin_expect(__any(y >= 0.125f), 0)) { const float ome = 1.0f - __expf(-y); o1 = y < 0.125f ? o1 : ome; }
                        om[n * 4 + j] = o1; uv[n * 4 + j] = sqrtf(o1 * (2.0f - o1)) * (ig * xv[n * 4 + j]); }
                u32x4 wa, wu; wa.x = cvt_pk_bf16(om[0], om[1]); wa.y = cvt_pk_bf16(om[2], om[3]); wa.z = cvt_pk_bf16(om[4], om[5]); wa.w = cvt_pk_bf16(om[6], om[7]);
                wu.x = cvt_pk_bf16(uv[0], uv[1]); wu.y = cvt_pk_bf16(uv[2], uv[3]); wu.z = cvt_pk_bf16(uv[4], uv[5]); wu.w = cvt_pk_bf16(uv[6], uv[7]);
                *(u32x4*)(Ao + off) = wa; *(u32x4*)(Uo + off) = wu; asm volatile("" ::: "memory"); }
    }
};
struct EpiT1 {
    static constexpr bool PERM = true;
    const bf16_t* gate; int ldg; bf16_t* O;
    __device__ __forceinline__ void operator()(const Acc& acc, const Unit& u, int wr, int wc, int fr, int fq) const {
        const int row0 = u.pm * BM + wr * 64 + fr;
#pragma unroll
        for (int ai = 0; ai < 2; ++ai)
#pragma unroll
            for (int m = 0; m < 4; ++m) { const int row = row0 + ai * HALF + m * 16;
#pragma unroll
                for (int bj = 0; bj < 2; ++bj) { const int col0 = u.pn * BM + bj * HALF + wc * 32 + 8 * fq;
                    const u32x4 gw = *(const u32x4*)(gate + (size_t)row * ldg + col0); f32x4 v0 = acc[ai][bj][m][0], v1 = acc[ai][bj][m][1];
                    v0[0] *= fsigmoid(bf2f(gw.x & 0xffffu)); v0[1] *= fsigmoid(bf2f(gw.x >> 16)); v0[2] *= fsigmoid(bf2f(gw.y & 0xffffu)); v0[3] *= fsigmoid(bf2f(gw.y >> 16));
                    v1[0] *= fsigmoid(bf2f(gw.z & 0xffffu)); v1[1] *= fsigmoid(bf2f(gw.z >> 16)); v1[2] *= fsigmoid(bf2f(gw.w & 0xffffu)); v1[3] *= fsigmoid(bf2f(gw.w >> 16));
                    u32x4 w; w.x = cvt_pk_bf16(v0[0], v0[1]); w.y = cvt_pk_bf16(v0[2], v0[3]); w.z = cvt_pk_bf16(v1[0], v1[1]); w.w = cvt_pk_bf16(v1[2], v1[3]);
                    *(u32x4*)(O + (size_t)row * DM + col0) = w; } asm volatile("" ::: "memory"); }
    }
};
struct EpiMerge {
    static constexpr bool PERM = true;
    const bf16_t* gate; int ldg; const bf16_t* T1; bf16_t* O;
    __device__ __forceinline__ void operator()(const Acc& acc, const Unit& u, int wr, int wc, int fr, int fq) const {
        const int row0 = u.pm * BM + wr * 64 + fr;
#pragma unroll
        for (int ai = 0; ai < 2; ++ai)
#pragma unroll
            for (int m = 0; m < 4; ++m) { const int row = row0 + ai * HALF + m * 16;
#pragma unroll
                for (int bj = 0; bj < 2; ++bj) { const int col0 = u.pn * BM + bj * HALF + wc * 32 + 8 * fq;
                    const u32x4 gw = *(const u32x4*)(gate + (size_t)row * ldg + col0); const u32x4 tw = *(const u32x4*)(T1 + (size_t)row * DM + col0);
                    f32x4 v0 = acc[ai][bj][m][0], v1 = acc[ai][bj][m][1];
                    const f32x4 t0 = {bf2f(tw.x & 0xffffu), bf2f(tw.x >> 16), bf2f(tw.y & 0xffffu), bf2f(tw.y >> 16)}, t1 = {bf2f(tw.z & 0xffffu), bf2f(tw.z >> 16), bf2f(tw.w & 0xffffu), bf2f(tw.w >> 16)};
                    v0[0] = t0[0] + v0[0] * fsigmoid(bf2f(gw.x & 0xffffu)); v0[1] = t0[1] + v0[1] * fsigmoid(bf2f(gw.x >> 16)); v0[2] = t0[2] + v0[2] * fsigmoid(bf2f(gw.y & 0xffffu)); v0[3] = t0[3] + v0[3] * fsigmoid(bf2f(gw.y >> 16));
                    v1[0] = t1[0] + v1[0] * fsigmoid(bf2f(gw.z & 0xffffu)); v1[1] = t1[1] + v1[1] * fsigmoid(bf2f(gw.z >> 16)); v1[2] = t1[2] + v1[2] * fsigmoid(bf2f(gw.w & 0xffffu)); v1[3] = t1[3] + v1[3] * fsigmoid(bf2f(gw.w >> 16));
                    u32x4 w; w.x = cvt_pk_bf16(v0[0], v0[1]); w.y = cvt_pk_bf16(v0[2], v0[3]); w.z = cvt_pk_bf16(v1[0], v1[1]); w.w = cvt_pk_bf16(v1[2], v1[3]);
                    *(u32x4*)(O + (size_t)row * DM + col0) = w; } asm volatile("" ::: "memory"); }
    }
};
}

namespace att {
constexpr int NW = 8, QBLK = 32, KVBLK = 64;
constexpr int LDQ = NQ, LDKV = NKV, LDO = DM;
constexpr int SLOT_K = 24576, SLOT_V = 16384, KR_OFF = 16384;
constexpr int OFF_K = 0, OFF_V = 3 * SLOT_K, OFF_WS = OFF_V + 3 * SLOT_V;
constexpr float THRL = 11.0f;
#define KNSWZ(row, colB) ((row) * 256 + ((colB) ^ (((row) & 15) << 4)))
#define KRSWZ(row, colB) ((row) * 128 + ((colB) ^ ((((row) >> 1) & 7) << 4)))
#define SBAR() __builtin_amdgcn_sched_barrier(0)
__device__ __forceinline__ int crow(int r, int hi) { return (r & 3) + 8 * (r >> 2) + 4 * hi; }

__device__ __forceinline__ void partialSM(f32x16& p0, f32x16& p1, float& m_reg, float& mn, float& alpha) {
    float pmax = p0[0];
#pragma unroll
    for (int r = 1; r < 16; ++r) pmax = fmaxf(pmax, p0[r]);
#pragma unroll
    for (int r = 0; r < 16; ++r) pmax = fmaxf(pmax, p1[r]);
    { auto rr = __builtin_amdgcn_permlane32_swap(__float_as_uint(pmax), __float_as_uint(pmax), false, false);
      pmax = fmaxf(__uint_as_float(rr[0]), __uint_as_float(rr[1])); }
    if (__builtin_expect(__all(pmax - m_reg <= THRL), 1)) { mn = m_reg; alpha = 1.f; }
    else { mn = fmaxf(m_reg, pmax); alpha = __builtin_amdgcn_exp2f(m_reg - mn); m_reg = mn; }
#pragma unroll
    for (int r = 0; r < 16; ++r) p0[r] = p0[r] - mn;
#pragma unroll
    for (int r = 0; r < 16; ++r) p1[r] = p1[r] - mn;
#pragma unroll
    for (int r = 0; r < 16; ++r) p0[r] = __builtin_amdgcn_exp2f(p0[r]);
}
__device__ __forceinline__ void finishSM(f32x16& p0, f32x16& p1, float alpha, float& l_reg, bf16x8& pa0, bf16x8& pa1, bf16x8& pa2, bf16x8& pa3) {
#pragma unroll
    for (int r = 0; r < 16; ++r) p1[r] = __builtin_amdgcn_exp2f(p1[r]);
    float ps = 0;
#pragma unroll
    for (int r = 0; r < 16; ++r) ps += p0[r];
#pragma unroll
    for (int r = 0; r < 16; ++r) ps += p1[r];
    { auto rr = __builtin_amdgcn_permlane32_swap(__float_as_uint(ps), __float_as_uint(ps), false, false);
      ps = __uint_as_float(rr[0]) + __uint_as_float(rr[1]); }
    l_reg = l_reg * alpha + ps;
#define PK4(P, BASE, OUT) do { unsigned a0 = cvt_pk_bf16(P[BASE + 0], P[BASE + 1]), a1 = cvt_pk_bf16(P[BASE + 2], P[BASE + 3]);   \
    unsigned b0 = cvt_pk_bf16(P[BASE + 4], P[BASE + 5]), b1 = cvt_pk_bf16(P[BASE + 6], P[BASE + 7]);                              \
    auto r0 = __builtin_amdgcn_permlane32_swap(a0, b0, false, false); auto r1 = __builtin_amdgcn_permlane32_swap(a1, b1, false, false); \
    u32x4 w = {r0[0], r1[0], r0[1], r1[1]}; OUT = *reinterpret_cast<bf16x8*>(&w); } while (0)
    PK4(p0, 0, pa0); PK4(p0, 8, pa1); PK4(p1, 0, pa2); PK4(p1, 8, pa3);
#undef PK4
}
__device__ __forceinline__ void qkt(f32x16& p0, f32x16& p1, const char* Kn, const bf16x8* qr, int r32, int hi) {
    const char* Kr = Kn + KR_OFF;
    p0 = f32x16{}; p1 = f32x16{};
    __builtin_amdgcn_s_setprio(1);
#pragma unroll
    for (int d0 = 0; d0 < 8; ++d0) { const int cb = (d0 * 16 + hi * 8) * 2;
        const bf16x8 b0 = *reinterpret_cast<const bf16x8*>(Kn + KNSWZ(r32, cb));
        const bf16x8 b1 = *reinterpret_cast<const bf16x8*>(Kn + KNSWZ(32 + r32, cb));
        p0 = __builtin_amdgcn_mfma_f32_32x32x16_bf16(b0, qr[d0], p0, 0, 0, 0);
        p1 = __builtin_amdgcn_mfma_f32_32x32x16_bf16(b1, qr[d0], p1, 0, 0, 0); }
#pragma unroll
    for (int d0 = 0; d0 < 4; ++d0) { const int cb = (d0 * 16 + hi * 8) * 2;
        const bf16x8 b0 = *reinterpret_cast<const bf16x8*>(Kr + KRSWZ(r32, cb));
        const bf16x8 b1 = *reinterpret_cast<const bf16x8*>(Kr + KRSWZ(32 + r32, cb));
        p0 = __builtin_amdgcn_mfma_f32_32x32x16_bf16(b0, qr[8 + d0], p0, 0, 0, 0);
        p1 = __builtin_amdgcn_mfma_f32_32x32x16_bf16(b1, qr[8 + d0], p1, 0, 0, 0); }
}
__device__ __forceinline__ int v_st(int k, int c) { const int kk = (k & ~0xC) | ((k & 4) << 1) | ((k & 8) >> 1); return ((kk >> 3) * 4 + (c >> 5)) * 512 + ((kk & 7) * 32 + (c & 31)) * 2; }
__device__ __forceinline__ int v_rd_base(int lane) { return ((lane & 3) << 3) | (((lane >> 2) & 3) << 6) | (((lane >> 4) & 1) << 5) | (((lane >> 5) & 1) << 8); }
constexpr int v_rd_off(int d0, int ks, int half) { return d0 * 512 + ks * 4096 + half * 2048; }
template <int OFF> __device__ __forceinline__ s16x4 tr_read(int vb) {
    s16x4 r; asm volatile("ds_read_b64_tr_b16 %0, %1 offset:%2" : "=&v"(r) : "v"(vb), "i"(OFF) : "memory"); return r;
}
template <int D0> __device__ __forceinline__ void pv_one(f32x16& od, int vb, bf16x8 pa0, bf16x8 pa1, bf16x8 pa2, bf16x8 pa3) {
    const s16x4 l0 = tr_read<v_rd_off(D0, 0, 0)>(vb), h0 = tr_read<v_rd_off(D0, 0, 1)>(vb), l1 = tr_read<v_rd_off(D0, 1, 0)>(vb), h1 = tr_read<v_rd_off(D0, 1, 1)>(vb);
    const s16x4 l2 = tr_read<v_rd_off(D0, 2, 0)>(vb), h2 = tr_read<v_rd_off(D0, 2, 1)>(vb), l3 = tr_read<v_rd_off(D0, 3, 0)>(vb), h3 = tr_read<v_rd_off(D0, 3, 1)>(vb);
    asm volatile("s_waitcnt lgkmcnt(0)" ::: "memory"); SBAR();
#define PK(L, H) (bf16x8){L[0], L[1], L[2], L[3], H[0], H[1], H[2], H[3]}
    od = __builtin_amdgcn_mfma_f32_32x32x16_bf16(pa0, PK(l0, h0), od, 0, 0, 0);
    od = __builtin_amdgcn_mfma_f32_32x32x16_bf16(pa1, PK(l1, h1), od, 0, 0, 0);
    od = __builtin_amdgcn_mfma_f32_32x32x16_bf16(pa2, PK(l2, h2), od, 0, 0, 0);
    od = __builtin_amdgcn_mfma_f32_32x32x16_bf16(pa3, PK(l3, h3), od, 0, 0, 0);
#undef PK
}
__device__ __forceinline__ void pv_d0(f32x16* o, int vb, bf16x8 pa0, bf16x8 pa1, bf16x8 pa2, bf16x8 pa3) {
    pv_one<0>(o[0], vb, pa0, pa1, pa2, pa3); pv_one<1>(o[1], vb, pa0, pa1, pa2, pa3); pv_one<2>(o[2], vb, pa0, pa1, pa2, pa3); pv_one<3>(o[3], vb, pa0, pa1, pa2, pa3);
}

__device__ __forceinline__ void attn_unit(const bf16_t* __restrict__ Qb, const bf16_t* __restrict__ Kn, const bf16_t* __restrict__ Vh, const bf16_t* __restrict__ Kr,
                                          bf16_t* __restrict__ Ob, int seq, char* lds, int wv_) { LAUNDER_IDS;
    const int tid = tidx_, wid = __builtin_amdgcn_readfirstlane(tid >> 6), lane = tid & 63, r32 = lane & 31, hi = lane >> 5;
    LAS unsigned char* lds3 = (LAS unsigned char*)lds;
    float* ws = (float*)(lds + OFF_WS) + wid * 64; float* li_l = ws; float* al_l = ws + 32;
    float m_reg = -1e30f, l_reg = 0; f32x16 o[4] = {}; bf16x8 qr[12];
    const bf16_t* Qw = Qb + (long)(wid * QBLK + r32) * LDQ + hi * 8;
#pragma unroll
    for (int d0 = 0; d0 < 12; ++d0) qr[d0] = *reinterpret_cast<const bf16x8*>(Qw + d0 * 16);
    unsigned gkn[2], gv[2], gkr;
#pragma unroll
    for (int i = 0; i < 2; ++i) { const int c = wid * 2 + i; const int row = c * 4 + (lane >> 4), slot = lane & 15; gkn[i] = (unsigned)(row * (LDKV * 2) + ((slot ^ (row & 15)) << 4));
        const int st = c * 2 + (lane >> 5), kk = (st >> 2) * 8 + ((lane & 31) >> 2), k = (kk & ~0xC) | ((kk & 4) << 1) | ((kk & 8) >> 1), col = (st & 3) * 32 + (lane & 3) * 8; gv[i] = (unsigned)(k * (LDKV * 2) + col * 2); }
    { const int row = wid * 8 + (lane >> 3), slot = lane & 7; gkr = (unsigned)(row * 128 + ((slot ^ ((row >> 1) & 7)) << 4)); }
    const int vb0 = (int)(uintptr_t)(lds + OFF_V) + v_rd_base(lane);
#define DMA(t, slot) do { const char* kt_ = (const char*)Kn + (size_t)(t) * (KVBLK * LDKV * 2); const char* vt_ = (const char*)Vh + (size_t)(t) * (KVBLK * LDKV * 2); const char* rt_ = (const char*)Kr + (size_t)(t) * (KVBLK * 128); \
    _Pragma("unroll") for (int i_ = 0; i_ < 2; ++i_) { \
      __builtin_amdgcn_global_load_lds((const unsigned*)(kt_ + gkn[i_]), (LAS unsigned*)(lds3 + OFF_K + (slot) * SLOT_K + (wid * 2 + i_) * 1024), 16, 0, 0); \
      __builtin_amdgcn_global_load_lds((const unsigned*)(vt_ + gv[i_]), (LAS unsigned*)(lds3 + OFF_V + (slot) * SLOT_V + (wid * 2 + i_) * 1024), 16, 0, 0); } \
    __builtin_amdgcn_global_load_lds((const unsigned*)(rt_ + gkr), (LAS unsigned*)(lds3 + OFF_K + (slot) * SLOT_K + KR_OFF + wid * 1024), 16, 0, 0); } while (0)
#define WAIT_BAR() asm volatile("s_waitcnt vmcnt(0) lgkmcnt(0)\n\ts_barrier" ::: "memory")
#define RESC(a) do { if (__any((a) < 1.f)) { if (hi == 0) al_l[r32] = (a); asm volatile("s_waitcnt lgkmcnt(0)" ::: "memory"); \
    _Pragma("unroll") for (int d = 0; d < 4; ++d) _Pragma("unroll") for (int r = 0; r < 16; ++r) o[d][r] *= al_l[crow(r, hi)]; } } while (0)
    f32x16 pA0, pA1, pB0, pB1; float mnA, mnB, alA, alB; bf16x8 pa0, pa1, pa2, pa3; const int NT = seq / KVBLK;
    DMA(0, 0); DMA(1, 1); WAIT_BAR();
    qkt(pA0, pA1, lds + OFF_K, qr, r32, hi); __builtin_amdgcn_s_setprio(0); partialSM(pA0, pA1, m_reg, mnA, alA);
    int s_prev = 0, s_cur = 1, s_next = 2;
#define ROT() do { const int t_ = s_prev; s_prev = s_cur; s_cur = s_next; s_next = t_; } while (0)
    for (int j = 1; j + 1 < NT; j += 2) {
        DMA(j + 1, s_next); SBAR();
        qkt(pB0, pB1, lds + OFF_K + s_cur * SLOT_K, qr, r32, hi);
        finishSM(pA0, pA1, alA, l_reg, pa0, pa1, pa2, pa3); __builtin_amdgcn_s_setprio(0); SBAR();
        pv_d0(o, vb0 + s_prev * SLOT_V, pa0, pa1, pa2, pa3); partialSM(pB0, pB1, m_reg, mnB, alB);
        RESC(alB); WAIT_BAR(); ROT();
        DMA(j + 2, s_next); SBAR();
        qkt(pA0, pA1, lds + OFF_K + s_cur * SLOT_K, qr, r32, hi);
        finishSM(pB0, pB1, alB, l_reg, pa0, pa1, pa2, pa3); __builtin_amdgcn_s_setprio(0); SBAR();
        pv_d0(o, vb0 + s_prev * SLOT_V, pa0, pa1, pa2, pa3); partialSM(pA0, pA1, m_reg, mnA, alA);
        RESC(alA); WAIT_BAR(); ROT();
    }
    SBAR(); qkt(pB0, pB1, lds + OFF_K + s_cur * SLOT_K, qr, r32, hi);
    finishSM(pA0, pA1, alA, l_reg, pa0, pa1, pa2, pa3); __builtin_amdgcn_s_setprio(0); SBAR();
    pv_d0(o, vb0 + s_prev * SLOT_V, pa0, pa1, pa2, pa3); partialSM(pB0, pB1, m_reg, mnB, alB);
    RESC(alB);
    finishSM(pB0, pB1, alB, l_reg, pa0, pa1, pa2, pa3); __builtin_amdgcn_s_setprio(0); SBAR();
    pv_d0(o, vb0 + s_cur * SLOT_V, pa0, pa1, pa2, pa3);
    if (hi == 0) li_l[r32] = l_reg; asm volatile("s_waitcnt lgkmcnt(0)" ::: "memory");
    float rli[16];
#pragma unroll
    for (int r = 0; r < 16; ++r) rli[r] = __builtin_amdgcn_rcpf(li_l[crow(r, hi)]);
    bf16_t* Ow = Ob + (long)(wid * QBLK) * LDO;
#pragma unroll
    for (int r = 0; r < 16; ++r) { const int orow = crow(r, hi);
#pragma unroll
        for (int d0 = 0; d0 < 4; ++d0) Ow[(long)orow * LDO + d0 * 32 + r32] = (bf16_t)(cvt_pk_bf16(o[d0][r] * rli[r], 0.f) & 0xffffu); }
    WAIT_BAR();
#undef DMA
#undef WAIT_BAR
#undef RESC
#undef ROT
}
}


#define XB_TMO      128
#define XB_XCNT(j)  (256  + 64 * (j))
#define XB_XSUB(j)  (1280 + 64 * (j))
#define XB_XGEN(j)  (2304 + 64 * (j))
#define XB_TOP      3328
#define XB_TOPGEN   3392
#define XCD_BAR_WORDS 3456
#define XB_SPIN_CAP (1u << 22)
__device__ __forceinline__ unsigned xb_ld(unsigned* p)              { return __hip_atomic_load(p, __ATOMIC_RELAXED, __HIP_MEMORY_SCOPE_AGENT); }
__device__ __forceinline__ unsigned xb_add(unsigned* p, unsigned v) { return __hip_atomic_fetch_add(p, v, __ATOMIC_RELAXED, __HIP_MEMORY_SCOPE_AGENT); }
__device__ __forceinline__ unsigned xb_xcc_id() { return (unsigned)__builtin_amdgcn_s_getreg((3 << 11) | 20) & 0xFu; }
#define XB_SPIN(cond, bar) do { unsigned _sp = 0; while (cond) { __builtin_amdgcn_s_sleep(1); \
    if ((++_sp & 255u) == 0u) { if (xb_ld(&(bar)[XB_TMO])) break; if (_sp > XB_SPIN_CAP) { atomicAdd(&(bar)[XB_TMO], 1u); break; } } } } while (0)
struct XcdBarrier { unsigned* bar; unsigned x; volatile LAS unsigned* st; };
__device__ __forceinline__ XcdBarrier xcd_barrier_post(unsigned* bar, volatile LAS unsigned* st) {
    XcdBarrier b; b.bar = bar; b.x = xb_xcc_id(); b.st = st;
    if (threadIdx.x == 0) (void)xb_add(&bar[XB_XCNT(b.x)], 1u);
    return b;
}
__device__ __forceinline__ void xcd_barrier_complete(unsigned* bar, unsigned x, unsigned& nloc, unsigned& nx) {
    const unsigned G = gridDim.x * gridDim.y * gridDim.z;
    unsigned sum, cnt, mine, sp = 0u;
    for (;;) {
        sum = 0u; cnt = 0u; mine = 0u;
#pragma unroll
        for (unsigned j = 0; j < 16; ++j) { const unsigned c = xb_ld(&bar[XB_XCNT(j)]); sum += c; cnt += (c > 0u) ? 1u : 0u; mine = (j == x) ? c : mine; }
        if (sum == G) break;
        __builtin_amdgcn_s_sleep(1);
        if ((++sp & 255u) == 0u) { if (xb_ld(&bar[XB_TMO])) break; if (sp > XB_SPIN_CAP) { atomicAdd(&bar[XB_TMO], 1u); break; } }
    }
    nloc = mine > 0u ? mine : 1u; nx = cnt > 0u ? cnt : 1u;
}
__device__ __forceinline__ void xcd_barrier(const XcdBarrier& b) {
    asm volatile("s_waitcnt vmcnt(0)" ::: "memory");
    __syncthreads();
    if (threadIdx.x == 0) {
        unsigned* bar = b.bar;
        __builtin_amdgcn_s_waitcnt(0);
        unsigned nloc = b.st[0], nx = b.st[1];
        if (nloc == 0u) { xcd_barrier_complete(bar, b.x, nloc, nx); b.st[0] = nloc; b.st[1] = nx; }
        const unsigned old = xb_add(&bar[XB_XSUB(b.x)], 1u);
        const unsigned gen = old / nloc;
        if (old + 1u == (gen + 1u) * nloc) {
            __builtin_amdgcn_fence(__ATOMIC_RELEASE, "agent");
            asm volatile("s_waitcnt vmcnt(0)" ::: "memory");
            const unsigned og = xb_add(&bar[XB_TOP], 1u);
            const unsigned tg = og / nx;
            if (og + 1u == (tg + 1u) * nx) xb_add(&bar[XB_TOPGEN], 1u);
            else XB_SPIN(xb_ld(&bar[XB_TOPGEN]) == tg, bar);
            __builtin_amdgcn_fence(__ATOMIC_ACQUIRE, "agent");
            xb_add(&bar[XB_XGEN(b.x)], 1u);
            asm volatile("s_waitcnt vmcnt(0)" ::: "memory");
        } else {
            XB_SPIN(xb_ld(&bar[XB_XGEN(b.x)]) == gen, bar);
            __builtin_amdgcn_fence(__ATOMIC_ACQUIRE, "agent");
            asm volatile("s_waitcnt vmcnt(0)" ::: "memory");
        }
    }
    __syncthreads();
}

struct Args { const float* in[27]; float* out; unsigned char* ws; int ph_lo, ph_hi; };

__device__ __forceinline__ int map_row(int mode, int row_off, int n) {
    if (mode == 0) return row_off + n;
    if (mode == 1) return (n >> 7) * 256 + row_off + (n & 127);
    if (mode == 2) { if (n >= C_KPE && n < C_KPE + 64) { const int j = n - C_KPE; return C_KPE + (j < 32 ? 2 * j : 2 * (j - 32) + 1); } return n; }
    { const int h = n / 192, d = n % 192; if (d < 128) return n; const int j = d - 128; return h * 192 + 128 + (j < 32 ? 2 * j : 2 * (j - 32) + 1); }
}
__device__ __forceinline__ void transpose_item(const float* W, int K, int N, bf16_t* WT, int mode, int row_off, LAS float* scr, int item, int lane) {
    const int nblk = N / 32, kb = item / nblk, nb = item % nblk, k0 = 64 * kb, n0 = 32 * nb;
    float wv[32];
#pragma unroll
    for (int i = 0; i < 32; ++i) { const int kk = 2 * i + (lane >> 5); wv[i] = W[(size_t)(k0 + kk) * N + n0 + (lane & 31)]; }
#pragma unroll
    for (int i = 0; i < 32; ++i) { const int kk = 2 * i + (lane >> 5); scr[kk * 33 + (lane & 31)] = wv[i]; }
    asm volatile("s_waitcnt lgkmcnt(0)" ::: "memory");
    const int c = lane & 7;
#pragma unroll
    for (int j = 0; j < 4; ++j) { const int n = (lane >> 3) + 8 * j; const LAS float* s = scr + (8 * c) * 33 + n;
        u32x4 o; o.x = cvt_pk_bf16(s[0 * 33], s[1 * 33]); o.y = cvt_pk_bf16(s[2 * 33], s[3 * 33]); o.z = cvt_pk_bf16(s[4 * 33], s[5 * 33]); o.w = cvt_pk_bf16(s[6 * 33], s[7 * 33]);
        *(u32x4*)(WT + (size_t)map_row(mode, row_off, n0 + n) * K + k0 + 8 * c) = o; }
    asm volatile("s_waitcnt lgkmcnt(0)" ::: "memory");
}

__device__ __forceinline__ void rms_row2_bf16(const float* xrow0, const float* xrow1, const float* g, bf16_t* orow0, bf16_t* orow1, int lane) {
    const f32x4* xr0 = (const f32x4*)xrow0 + lane; const f32x4* xr1 = (const f32x4*)xrow1 + lane; const f32x4* gr = (const f32x4*)g + lane;
    f32x4 v0[8], v1[8]; float s0 = 0.f, s1 = 0.f;
#pragma unroll
    for (int j = 0; j < 8; ++j) { v0[j] = xr0[64 * j]; v1[j] = xr1[64 * j]; }
#pragma unroll
    for (int j = 0; j < 8; ++j) { s0 += (v0[j].x * v0[j].x + v0[j].y * v0[j].y) + (v0[j].z * v0[j].z + v0[j].w * v0[j].w); s1 += (v1[j].x * v1[j].x + v1[j].y * v1[j].y) + (v1[j].z * v1[j].z + v1[j].w * v1[j].w); }
    const float r0 = rsqrtf(wave_sum(s0) * (1.f / DM) + RMS_EPS), r1 = rsqrtf(wave_sum(s1) * (1.f / DM) + RMS_EPS);
    u32x2* o0 = (u32x2*)orow0 + lane; u32x2* o1 = (u32x2*)orow1 + lane;
#pragma unroll
    for (int j = 0; j < 8; ++j) { const f32x4 gg = gr[64 * j]; u32x2 w;
        w.x = cvt_pk_bf16(v0[j].x * r0 * gg.x, v0[j].y * r0 * gg.y); w.y = cvt_pk_bf16(v0[j].z * r0 * gg.z, v0[j].w * r0 * gg.w); o0[64 * j] = w;
        w.x = cvt_pk_bf16(v1[j].x * r1 * gg.x, v1[j].y * r1 * gg.y); w.y = cvt_pk_bf16(v1[j].z * r1 * gg.z, v1[j].w * r1 * gg.w); o1[64 * j] = w; }
}
__device__ __forceinline__ void rms_row2_f32_inplace(float* xrow0, float* xrow1, const float* g, int lane) {
    f32x4* xr0 = (f32x4*)xrow0 + lane; f32x4* xr1 = (f32x4*)xrow1 + lane; const f32x4* gr = (const f32x4*)g + lane;
    f32x4 v0[8], v1[8]; float s0 = 0.f, s1 = 0.f;
#pragma unroll
    for (int j = 0; j < 8; ++j) { v0[j] = xr0[64 * j]; v1[j] = xr1[64 * j]; }
#pragma unroll
    for (int j = 0; j < 8; ++j) { s0 += (v0[j].x * v0[j].x + v0[j].y * v0[j].y) + (v0[j].z * v0[j].z + v0[j].w * v0[j].w); s1 += (v1[j].x * v1[j].x + v1[j].y * v1[j].y) + (v1[j].z * v1[j].z + v1[j].w * v1[j].w); }
    const float r0 = rsqrtf(wave_sum(s0) * (1.f / DM) + RMS_EPS), r1 = rsqrtf(wave_sum(s1) * (1.f / DM) + RMS_EPS);
#pragma unroll
    for (int j = 0; j < 8; ++j) { const f32x4 gg = gr[64 * j]; xr0[64 * j] = v0[j] * r0 * gg; xr1[64 * j] = v1[j] * r1 * gg; }
}

__device__ __forceinline__ void phase_prologue(const Args& a, LAS unsigned char* lds, int wv_) { LAUNDER_IDS;
    const int tid = tidx_, lane = tid & 63, wave = tid >> 6;
    unsigned char* ws = a.ws;
    LAS float* scr = (LAS float*)(lds + wave * 16384);
    const int gw = bidx_ * 8 + wave, NGW = gridDim.x * 8;
    constexpr int I_GU = (DM / 64) * (DFF / 32), I_D = (DFF / 64) * (DM / 32), I_IN = (DM / 64) * (NIN / 32), I_UQ = (512 / 64) * (NQ / 32), I_UKV = (512 / 64) * (NKV / 32),
                  I_SQ = (DM / 64) * (DM / 32), I_G = 64 * 8;
    constexpr int NITEMS = 4 * I_GU + 2 * I_D + I_IN + I_UQ + I_UKV + 3 * I_SQ + I_G;
    for (int it = gw; it < NITEMS; it += NGW) {
        int r = it;
        if (r < I_GU) { transpose_item(a.in[3], DM, DFF, (bf16_t*)(ws + WS_W1GU), 1, 0, scr, r, lane); continue; } r -= I_GU;
        if (r < I_GU) { transpose_item(a.in[4], DM, DFF, (bf16_t*)(ws + WS_W1GU), 1, 128, scr, r, lane); continue; } r -= I_GU;
        if (r < I_GU) { transpose_item(a.in[23], DM, DFF, (bf16_t*)(ws + WS_W2GU), 1, 0, scr, r, lane); continue; } r -= I_GU;
        if (r < I_GU) { transpose_item(a.in[24], DM, DFF, (bf16_t*)(ws + WS_W2GU), 1, 128, scr, r, lane); continue; } r -= I_GU;
        if (r < I_D) { transpose_item(a.in[5], DFF, DM, (bf16_t*)(ws + WS_W1D), 0, 0, scr, r, lane); continue; } r -= I_D;
        if (r < I_D) { transpose_item(a.in[25], DFF, DM, (bf16_t*)(ws + WS_W2D), 0, 0, scr, r, lane); continue; } r -= I_D;
        if (r < I_IN) { transpose_item(a.in[7], DM, NIN, (bf16_t*)(ws + WS_WIN), 2, 0, scr, r, lane); continue; } r -= I_IN;
        if (r < I_UQ) { transpose_item(a.in[9], 512, NQ, (bf16_t*)(ws + WS_WUQ), 3, 0, scr, r, lane); continue; } r -= I_UQ;
        if (r < I_UKV) { transpose_item(a.in[11], 512, NKV, (bf16_t*)(ws + WS_WUKV), 0, 0, scr, r, lane); continue; } r -= I_UKV;
        if (r < I_SQ) { transpose_item(a.in[12], DM, DM, (bf16_t*)(ws + WS_WOA), 0, 0, scr, r, lane); continue; } r -= I_SQ;
        if (r < I_SQ) { transpose_item(a.in[20], DM, DM, (bf16_t*)(ws + WS_WOR), 0, 0, scr, r, lane); continue; } r -= I_SQ;
        if (r < I_SQ) { transpose_item(a.in[21], DM, DM, (bf16_t*)(ws + WS_WOUT), 0, 0, scr, r, lane); continue; } r -= I_SQ;
        { const int mat = r >> 3, sub = r & 7, type = mat & 1, db = mat >> 1;
          transpose_item((type ? a.in[17] : a.in[15]) + (size_t)db * 128 * 128, 128, 128, (bf16_t*)(ws + WS_WG), 0, mat * 128, scr, sub, lane); }
    }
    { const int gt = bidx_ * 512 + tid, NT = gridDim.x * 512; u32x4* p = (u32x4*)((bf16_t*)(ws + WS_WIN) + (size_t)NIN * DM);
      for (int i = gt; i < (NINP - NIN) * DM / 8; i += NT) p[i] = (u32x4){0u, 0u, 0u, 0u}; }
    { const int gt = bidx_ * 512 + tid, NT = gridDim.x * 512; float* cosT = (float*)(ws + WS_COS); float* sinT = (float*)(ws + WS_SIN); float* c8 = (float*)(ws + WS_C8);
      for (int i = gt; i < SEQ * 32; i += NT) { const int pos = i >> 5, j = i & 31; const float inv = powf(10000.0f, -(float)(2 * j) / 64.0f); const float ang = (float)pos * inv; cosT[i] = cosf(ang); sinT[i] = sinf(ang); }
      for (int i = gt; i < 2 * DM; i += NT) { const float l = a.in[19][i]; const float sp = (-l > 20.f) ? -l : log1pf(expf(-l)); c8[i] = 8.0f * sp; } }
    for (int m = 2 * gw; m < MTOT; m += 2 * NGW) { const float* xr = m < SEQ ? a.in[0] + (size_t)m * DM : a.in[1] + (size_t)(m - SEQ) * DM;
        rms_row2_bf16(xr, xr + DM, a.in[2], (bf16_t*)(ws + WS_H) + (size_t)m * DM, (bf16_t*)(ws + WS_H) + (size_t)(m + 1) * DM, lane); }
}

__device__ __forceinline__ void phase_norm(const Args& a, const float* g, int wv_) { LAUNDER_IDS;
    const int lane = tidx_ & 63, gw = bidx_ * 8 + (tidx_ >> 6), NGW = gridDim.x * 8;
    for (int m = 2 * gw; m < MTOT; m += 2 * NGW) rms_row2_bf16(a.out + (size_t)m * DM, a.out + (size_t)(m + 1) * DM, g, (bf16_t*)(a.ws + WS_H) + (size_t)m * DM, (bf16_t*)(a.ws + WS_H) + (size_t)(m + 1) * DM, lane);
}
__device__ __forceinline__ void phase_final_norm(const Args& a, int wv_) { LAUNDER_IDS;
    const int lane = tidx_ & 63, gw = bidx_ * 8 + (tidx_ >> 6), NGW = gridDim.x * 8;
    for (int m = 2 * gw; m < MTOT; m += 2 * NGW) rms_row2_f32_inplace(a.out + (size_t)m * DM, a.out + (size_t)(m + 1) * DM, a.in[26], lane);
}

__device__ __forceinline__ void phase_small(const Args& a, int wv_) { LAUNDER_IDS;
    unsigned char* ws = a.ws; const int tid = tidx_, lane = tid & 63, gw = bidx_ * 8 + (tid >> 6), NGW = gridDim.x * 8;
    const bf16_t* proj = (const bf16_t*)(ws + WS_PROJ);
    for (int row = gw; row < SEQ; row += NGW) {
        const u32x4 wq = *(const u32x4*)(proj + (size_t)row * NINP + C_CQ + lane * 8), wk = *(const u32x4*)(proj + (size_t)row * NINP + C_CKV + lane * 8);
        const unsigned pw = *(const unsigned*)(proj + (size_t)row * NINP + C_KPE + 2 * (lane & 31));
        const f32x4 gq0 = *(const f32x4*)(a.in[8] + lane * 8), gq1 = *(const f32x4*)(a.in[8] + lane * 8 + 4), gk0 = *(const f32x4*)(a.in[10] + lane * 8), gk1 = *(const f32x4*)(a.in[10] + lane * 8 + 4);
        const float c = ((const float*)(ws + WS_COS))[row * 32 + (lane & 31)], sn = ((const float*)(ws + WS_SIN))[row * 32 + (lane & 31)];
        float vq[8] = {bf2f(wq.x & 0xffffu), bf2f(wq.x >> 16), bf2f(wq.y & 0xffffu), bf2f(wq.y >> 16), bf2f(wq.z & 0xffffu), bf2f(wq.z >> 16), bf2f(wq.w & 0xffffu), bf2f(wq.w >> 16)};
        float vk[8] = {bf2f(wk.x & 0xffffu), bf2f(wk.x >> 16), bf2f(wk.y & 0xffffu), bf2f(wk.y >> 16), bf2f(wk.z & 0xffffu), bf2f(wk.z >> 16), bf2f(wk.w & 0xffffu), bf2f(wk.w >> 16)};
        float sq = 0.f, sk = 0.f;
#pragma unroll
        for (int j = 0; j < 8; ++j) { sq += vq[j] * vq[j]; sk += vk[j] * vk[j]; }
        const float rq = rsqrtf(wave_sum(sq) * (1.f / 512.f) + RMS_EPS), rk = rsqrtf(wave_sum(sk) * (1.f / 512.f) + RMS_EPS);
        u32x4 oq, ok;
        oq.x = cvt_pk_bf16(vq[0] * rq * gq0.x, vq[1] * rq * gq0.y); oq.y = cvt_pk_bf16(vq[2] * rq * gq0.z, vq[3] * rq * gq0.w); oq.z = cvt_pk_bf16(vq[4] * rq * gq1.x, vq[5] * rq * gq1.y); oq.w = cvt_pk_bf16(vq[6] * rq * gq1.z, vq[7] * rq * gq1.w);
        ok.x = cvt_pk_bf16(vk[0] * rk * gk0.x, vk[1] * rk * gk0.y); ok.y = cvt_pk_bf16(vk[2] * rk * gk0.z, vk[3] * rk * gk0.w); ok.z = cvt_pk_bf16(vk[4] * rk * gk1.x, vk[5] * rk * gk1.y); ok.w = cvt_pk_bf16(vk[6] * rk * gk1.z, vk[7] * rk * gk1.w);
        *(u32x4*)((bf16_t*)(ws + WS_CQN) + (size_t)row * 512 + lane * 8) = oq; *(u32x4*)((bf16_t*)(ws + WS_CKVN) + (size_t)row * 512 + lane * 8) = ok;
        if (lane < 32) { const float x1 = bf2f(pw & 0xffffu), x2 = bf2f(pw >> 16); *(unsigned*)((bf16_t*)(ws + WS_KPE) + (size_t)row * 64 + 2 * lane) = cvt_pk_bf16(x1 * c - x2 * sn, x2 * c + x1 * sn); }
    }
    const int gt = bidx_ * 512 + tid, NT = gridDim.x * 512; bf16_t* xc = (bf16_t*)(ws + WS_XC);
    for (int i = gt; i < (SEQ / 4) * (DM / 8); i += NT) {
        const int r0 = (i >> 8) * 4, c0 = (i & 255) * 8;
        u32x4 xr[7];
#pragma unroll
        for (int k = 0; k < 7; ++k) { const int t = r0 + k - 2; xr[k] = (t >= 0 && t < SEQ) ? *(const u32x4*)(proj + (size_t)t * NINP + C_XREC + c0) : (u32x4){0u, 0u, 0u, 0u}; }
        f32x4 wlo[4], whi[4];
#pragma unroll
        for (int k = 0; k < 4; ++k) { wlo[k] = *(const f32x4*)(a.in[13] + k * DM + c0); whi[k] = *(const f32x4*)(a.in[13] + k * DM + c0 + 4); }
        const f32x4 b0 = *(const f32x4*)(a.in[14] + c0), b1 = *(const f32x4*)(a.in[14] + c0 + 4);
#pragma unroll
        for (int r = 0; r < 4; ++r) { f32x4 lo = b0, hi = b1;
#pragma unroll
            for (int k = 0; k < 4; ++k) { const u32x4 w = xr[r + k];
                lo += (f32x4){bf2f(w.x & 0xffffu), bf2f(w.x >> 16), bf2f(w.y & 0xffffu), bf2f(w.y >> 16)} * wlo[k]; hi += (f32x4){bf2f(w.z & 0xffffu), bf2f(w.z >> 16), bf2f(w.w & 0xffffu), bf2f(w.w >> 16)} * whi[k]; }
            u32x4 o; o.x = cvt_pk_bf16(lo[0], lo[1]); o.y = cvt_pk_bf16(lo[2], lo[3]); o.z = cvt_pk_bf16(hi[0], hi[1]); o.w = cvt_pk_bf16(hi[2], hi[3]);
            *(u32x4*)(xc + (size_t)(r0 + r) * DM + c0) = o; }
    }
}

__device__ __forceinline__ void phase_scan1(const Args& a, int wv_) { LAUNDER_IDS;
    unsigned char* ws = a.ws; const int tid = tidx_;
    for (int it = bidx_; it < 1024; it += gridDim.x) {
        const int half = it & 1, dir = (it >> 1) & 1, c = it >> 2, ch = half * 1024 + tid * 2;
        const bf16_t* A = (const bf16_t*)(ws + (dir ? WS_AB : WS_AF)) + ch; const bf16_t* U = (const bf16_t*)(ws + (dir ? WS_UB : WS_UF)) + ch;
        f32x2 P = {1.f, 1.f}, Hh = {0.f, 0.f};
        unsigned awv[32], uwv[32];
#pragma unroll
        for (int i = 0; i < 32; ++i) { const int t = dir ? (c * 32 + 31 - i) : (c * 32 + i); awv[i] = *(const unsigned*)(A + (size_t)t * DM); uwv[i] = *(const unsigned*)(U + (size_t)t * DM); }
#pragma unroll
        for (int i = 0; i < 32; ++i) { const unsigned aw = awv[i], uw = uwv[i];
            const f32x2 av = {1.0f - bf2f(aw & 0xffffu), 1.0f - bf2f(aw >> 16)}, uv = {bf2f(uw & 0xffffu), bf2f(uw >> 16)}; Hh = av * Hh + uv; P = P * av; }
        *(f32x2*)((float*)(ws + WS_AGGA) + (size_t)(dir * 256 + c) * DM + ch) = P; *(f32x2*)((float*)(ws + WS_AGGB) + (size_t)(dir * 256 + c) * DM + ch) = Hh;
    }
}
__device__ __forceinline__ void phase_scan15(const Args& a, LAS unsigned char* lds, int wv_) { LAUNDER_IDS;
    if (bidx_ >= 32) return;
    unsigned char* ws = a.ws; const int tid = tidx_, seg = tid >> 6, cpl = tid & 63, idx = bidx_ * 64 + cpl, dir = idx >> 10, ch = (idx & 1023) * 2;
    const float* GA = (const float*)(ws + WS_AGGA) + (size_t)dir * 256 * DM + ch; const float* GB = (const float*)(ws + WS_AGGB) + (size_t)dir * 256 * DM + ch; float* CR = (float*)(ws + WS_CARRY) + (size_t)dir * 256 * DM + ch;
    LAS f32x4* seg_agg = (LAS f32x4*)lds;
    f32x2 A = {1.f, 1.f}, B = {0.f, 0.f};
#pragma unroll 8
    for (int i = 0; i < 32; ++i) { const int c = dir ? 255 - (seg * 32 + i) : seg * 32 + i; const f32x2 av = *(const f32x2*)(GA + (size_t)c * DM), bv = *(const f32x2*)(GB + (size_t)c * DM); B = av * B + bv; A = A * av; }
    seg_agg[seg * 64 + cpl] = (f32x4){A.x, A.y, B.x, B.y};
    __syncthreads();
    f32x2 carry = {0.f, 0.f};
    for (int k = 0; k < seg; ++k) { const f32x4 g = seg_agg[k * 64 + cpl]; carry = (f32x2){g.x, g.y} * carry + (f32x2){g.z, g.w}; }
    __syncthreads();
#pragma unroll 8
    for (int i = 0; i < 32; ++i) { const int c = dir ? 255 - (seg * 32 + i) : seg * 32 + i; *(f32x2*)(CR + (size_t)c * DM) = carry; const f32x2 av = *(const f32x2*)(GA + (size_t)c * DM), bv = *(const f32x2*)(GB + (size_t)c * DM); carry = av * carry + bv; }
}
__device__ __forceinline__ void phase_scan2(const Args& a, int wv_) { LAUNDER_IDS;
    unsigned char* ws = a.ws; const int tid = tidx_;
    const bf16_t* proj = (const bf16_t*)(ws + WS_PROJ); bf16_t* yg = (bf16_t*)(ws + WS_YG);
    for (int it = bidx_; it < 512; it += gridDim.x) {
        const int half = it & 1, c = it >> 1, ch = half * 1024 + tid * 2;
        const bf16_t* AF = (const bf16_t*)(ws + WS_AF) + ch; const bf16_t* UF = (const bf16_t*)(ws + WS_UF) + ch; const bf16_t* AB = (const bf16_t*)(ws + WS_AB) + ch; const bf16_t* UB = (const bf16_t*)(ws + WS_UB) + ch;
        f32x2 hf[32]; f32x2 h = *(const f32x2*)((const float*)(ws + WS_CARRY) + (size_t)c * DM + ch);
        { unsigned awv[32], uwv[32];
#pragma unroll
          for (int i = 0; i < 32; ++i) { const int t = c * 32 + i; awv[i] = *(const unsigned*)(AF + (size_t)t * DM); uwv[i] = *(const unsigned*)(UF + (size_t)t * DM); }
#pragma unroll
          for (int i = 0; i < 32; ++i) { const unsigned aw = awv[i], uw = uwv[i];
            const f32x2 av = {1.0f - bf2f(aw & 0xffffu), 1.0f - bf2f(aw >> 16)}, uv = {bf2f(uw & 0xffffu), bf2f(uw >> 16)}; h = av * h + uv; hf[i] = h; } }
        h = *(const f32x2*)((const float*)(ws + WS_CARRY) + (size_t)(256 + c) * DM + ch);
        { unsigned awv[32], uwv[32], gwv[32];
#pragma unroll
          for (int i = 0; i < 32; ++i) { const int t = c * 32 + i; awv[i] = *(const unsigned*)(AB + (size_t)t * DM); uwv[i] = *(const unsigned*)(UB + (size_t)t * DM); gwv[i] = *(const unsigned*)(proj + (size_t)t * NINP + C_GREC + ch); }
#pragma unroll
          for (int i = 31; i >= 0; --i) { const int t = c * 32 + i; const unsigned aw = awv[i], uw = uwv[i], gw = gwv[i];
            const f32x2 av = {1.0f - bf2f(aw & 0xffffu), 1.0f - bf2f(aw >> 16)}, uv = {bf2f(uw & 0xffffu), bf2f(uw >> 16)}; h = av * h + uv;
            const f32x2 hs = hf[i] + h;
            *(unsigned*)(yg + (size_t)t * DM + ch) = cvt_pk_bf16(gelu_tanh(bf2f(gw & 0xffffu)) * hs.x, gelu_tanh(bf2f(gw >> 16)) * hs.y); } }
    }
}

__device__ __forceinline__ void phase_attention(const Args& a, char* lds, int wv_) { LAUNDER_IDS;
    unsigned char* ws = a.ws; const int G = gridDim.x, bx = bidx_; const int vcu = (G % 8 == 0) ? (bx % 8) * (G / 8) + bx / 8 : bx;
    const bf16_t* Q = (const bf16_t*)(ws + WS_Q); const bf16_t* KV = (const bf16_t*)(ws + WS_KV); const bf16_t* KPE = (const bf16_t*)(ws + WS_KPE); bf16_t* O = (bf16_t*)(ws + WS_ATTO);
    for (int u = vcu; u < 512; u += G) { const int h = u >> 5, qb = u & 31;
        att::attn_unit(Q + (size_t)qb * 256 * NQ + h * 192, KV + h * 256, KV + h * 256 + 128, KPE, O + (size_t)qb * 256 * DM + h * 128, SEQ, lds, wv_); }
}

__device__ __forceinline__ void phase_ffn_up(const Args& a, LAS unsigned char* lds, int which, int wv_) {
    pg8::Gemm g{(const bf16_t*)(a.ws + WS_H), (const bf16_t*)(a.ws + (which ? WS_W2GU : WS_W1GU))};
    pg8::EpiSwiglu E{(bf16_t*)(a.ws + WS_ACT), DFF};
    pg8::gemm_phase<pg8::EpiSwiglu, MTOT, 2 * DFF, DM, DM, 0, 0>(lds, g, E, wv_);
}
__device__ __forceinline__ void phase_ffn_down(const Args& a, LAS unsigned char* lds, int which, int wv_) {
    pg8::Gemm g{(const bf16_t*)(a.ws + WS_ACT), (const bf16_t*)(a.ws + (which ? WS_W2D : WS_W1D))};
    pg8::EpiResid E{which ? a.out : a.in[0], which ? a.out : a.in[1], which ? MTOT : SEQ, a.out, 0.5f, 0};
    pg8::gemm_phase<pg8::EpiResid, MTOT, DM, DFF, DFF, 0, 0>(lds, g, E, wv_);
}
__device__ __forceinline__ void phase_wout(const Args& a, LAS unsigned char* lds, int s, int wv_) {
    pg8::Gemm g{(const bf16_t*)(a.ws + WS_H), (const bf16_t*)(a.ws + WS_WOUT)};
    pg8::EpiResid E{a.out, a.out, MTOT, a.out, 1.0f, 0};
    pg8::gemm_phase<pg8::EpiResid, MTOT, DM, DM, DM, 0, 0>(lds, g, E, wv_);
}
__device__ __forceinline__ void phase_win(const Args& a, LAS unsigned char* lds, int s, int wv_) {
    pg8::Gemm g{(const bf16_t*)(a.ws + WS_H) + (size_t)s * SEQ * DM, (const bf16_t*)(a.ws + WS_WIN)}; pg8::EpiBf16 E{(bf16_t*)(a.ws + WS_PROJ), NINP};
    pg8::gemm_phase<pg8::EpiBf16, SEQ, NINP, DM, DM, 0, 0>(lds, g, E, wv_);
}
__device__ __forceinline__ void phase_kv(const Args& a, LAS unsigned char* lds, int wv_) {
    pg8::Gemm g{(const bf16_t*)(a.ws + WS_CKVN), (const bf16_t*)(a.ws + WS_WUKV)}; pg8::EpiBf16 E{(bf16_t*)(a.ws + WS_KV), NKV};
    pg8::gemm_phase<pg8::EpiBf16, SEQ, NKV, 512, 512, 0, 0>(lds, g, E, wv_);
}

__device__ __forceinline__ void run_phase(const Args& a, int ph, unsigned char* lds_g, int wv_) {
    LAS unsigned char* lds = (LAS unsigned char*)lds_g; unsigned char* ws = a.ws;
    if (ph == 0) { if (PHM(0)) phase_prologue(a, lds, wv_); return; }
    if (ph == 1 || ph == 41) { if (PHM(1)) phase_ffn_up(a, lds, ph == 41, wv_); return; }
    if (ph == 2 || ph == 42) { if (PHM(2)) phase_ffn_down(a, lds, ph == 42, wv_); return; }
    if (ph == 3) { if (PHM(3)) phase_norm(a, a.in[6], wv_); return; }
    if (ph == 40) { if (PHM(3)) phase_norm(a, a.in[22], wv_); return; }
    if (ph == 39) { if (PHM(16)) phase_wout(a, lds, 0, wv_); return; }
    if (ph == 43) { if (PHM(4)) phase_final_norm(a, wv_); return; }
    const int s = (ph - 4) / 7, sub = (ph - 4) % 7;
    switch (sub) {
    case 0: if (PHM(5)) phase_win(a, lds, s, wv_); break;
    case 1: if (PHM(6)) phase_small(a, wv_); break;
    case 2: {
        if (PHM(7)) { pg8::Gemm g{(const bf16_t*)(ws + WS_CQN), (const bf16_t*)(ws + WS_WUQ)}; pg8::EpiQ E{(bf16_t*)(ws + WS_Q), (const float*)(ws + WS_COS), (const float*)(ws + WS_SIN)};
          pg8::gemm_phase<pg8::EpiQ, SEQ, NQ, 512, 512, 0, 0>(lds, g, E, wv_); }
        if (PHM(15)) phase_kv(a, lds, wv_);
        if (PHM(8)) { pg8::Gemm g{(const bf16_t*)(ws + WS_XC), (const bf16_t*)(ws + WS_WG)};
          pg8::EpiGates E{(const bf16_t*)(ws + WS_XC), a.in[16], a.in[18], (const float*)(ws + WS_C8), (bf16_t*)(ws + WS_AF), (bf16_t*)(ws + WS_UF), (size_t)(WS_AB - WS_AF) / 2};
          pg8::gemm_phase<pg8::EpiGates, SEQ, 8192, 128, DM, 16, 128>(lds, g, E, wv_); }
        break; }
    case 3: if (PHM(9)) phase_attention(a, (char*)lds_g, wv_); if (PHM(10)) phase_scan1(a, wv_); break;
    case 4: {
        if (PHM(11)) phase_scan15(a, lds, wv_);
        if (PHM(12)) { pg8::Gemm g{(const bf16_t*)(ws + WS_ATTO), (const bf16_t*)(ws + WS_WOA)}; pg8::EpiT1 E{(const bf16_t*)(ws + WS_PROJ) + C_GA, NINP, (bf16_t*)(ws + WS_T1)};
        pg8::gemm_phase<pg8::EpiT1, SEQ, DM, DM, DM, 0, 0>(lds, g, E, wv_); } break; }
    case 5: if (PHM(13)) phase_scan2(a, wv_); break;
    case 6: {
        if (PHM(14)) { pg8::Gemm g{(const bf16_t*)(ws + WS_YG), (const bf16_t*)(ws + WS_WOR)}; pg8::EpiMerge E{(const bf16_t*)(ws + WS_PROJ) + C_GR, NINP, (const bf16_t*)(ws + WS_T1), (bf16_t*)(ws + WS_H) + (size_t)s * SEQ * DM};
        pg8::gemm_phase<pg8::EpiMerge, SEQ, DM, DM, DM, 0, 0>(lds, g, E, wv_); } break; }
    default: break;
    }
}

__global__ void __launch_bounds__(512, 2) mega(Args a) {
    extern __shared__ __attribute__((aligned(16))) unsigned char lds[];
    cg::grid_group grid = cg::this_grid();
    const int wv_ = __builtin_amdgcn_readfirstlane(threadIdx.x >> 6);
    volatile LAS unsigned* misc = (volatile LAS unsigned*)((LAS unsigned char*)lds + (LDS_BYTES - 64));
    if (threadIdx.x < 2) misc[threadIdx.x] = 0u;
    __syncthreads();
    XcdBarrier bar = xcd_barrier_post((unsigned*)(a.ws + WS_CTL), misc);
    for (int ph = a.ph_lo; ph < a.ph_hi; ++ph) {
#ifdef PROBE_REPEAT
        if (PROBE_REPEAT(ph)) { run_phase(a, ph, lds, wv_); xcd_barrier(bar); }
#endif
        run_phase(a, ph, lds, wv_);
        if (ph + 1 < a.ph_hi) { if (ph == a.ph_lo) grid.sync(); else xcd_barrier(bar); }
    }
}

extern "C" void kernel_launch(void* const* d_in, const int* in_sizes, int n_in, void* d_out, int out_size, void* d_ws, size_t ws_size, hipStream_t stream) {
    static int grid = 0;
    if (grid == 0) {
        if (n_in != 27 || out_size != MTOT * DM || ws_size < WS_END) { fprintf(stderr, "kernel_launch: unexpected shapes: n_in %d out %d ws %zu (need %zu)\n", n_in, out_size, ws_size, (size_t)WS_END); grid = -1; return; }
        int dev = 0, cus = 0, per_cu = 0;
        (void)hipGetDevice(&dev); (void)hipDeviceGetAttribute(&cus, hipDeviceAttributeMultiprocessorCount, dev);
        if (hipFuncSetAttribute((const void*)mega, hipFuncAttributeMaxDynamicSharedMemorySize, LDS_BYTES) != hipSuccess) { fprintf(stderr, "kernel_launch: hipFuncSetAttribute failed\n"); grid = -1; return; }
        (void)hipOccupancyMaxActiveBlocksPerMultiprocessor(&per_cu, (const void*)mega, 512, LDS_BYTES);
        if (per_cu < 1) { fprintf(stderr, "kernel_launch: occupancy query says %d blocks/CU\n", per_cu); per_cu = 1; }
        (void)hipGetLastError();
        grid = cus;
    }
    if (grid < 0) return;
    if (hipMemsetAsync((char*)d_ws + WS_CTL, 0, CTL_BYTES, stream) != hipSuccess) { fprintf(stderr, "kernel_launch: hipMemsetAsync failed\n"); return; }
    Args a{};
    for (int i = 0; i < 27; ++i) a.in[i] = (const float*)d_in[i];
    a.out = (float*)d_out; a.ws = (unsigned char*)d_ws;
#if MK_ONE_LAUNCH
    a.ph_lo = 0; a.ph_hi = NPH;
    { void* args[] = {&a}; hipError_t e = hipLaunchCooperativeKernel((const void*)mega, dim3(grid), dim3(512), args, LDS_BYTES, stream);
      if (e != hipSuccess) fprintf(stderr, "cooperative launch failed: %s (grid %d)\n", hipGetErrorString(e), grid); }
#else
    for (int ph = 0; ph < NPH; ++ph) {
        a.ph_lo = ph; a.ph_hi = ph + 1;
        void* args[] = {&a}; hipError_t e = hipLaunchCooperativeKernel((const void*)mega, dim3(grid), dim3(512), args, LDS_BYTES, stream);
        if (e != hipSuccess) { fprintf(stderr, "cooperative launch %d failed: %s (grid %d)\n", ph, hipGetErrorString(e), grid); break; }
    }
#endif
}
```

```cpp
#include <hip/hip_runtime.h>
#include <hip/hip_cooperative_groups.h>
#include <cstdio>
#include <cstdint>
namespace cg = cooperative_groups;

#ifndef MK_ONE_LAUNCH
#define MK_ONE_LAUNCH 1
#endif
#ifndef PH_MASK
#define PH_MASK 0xffffffffu
#endif
#define PHM(k) (((PH_MASK) >> (k)) & 1u)
#define LAUNDER_IDS int tidx_ = wv_ * 64 + (int)__builtin_amdgcn_mbcnt_hi(~0u, __builtin_amdgcn_mbcnt_lo(~0u, 0u)), bidx_ = blockIdx.x; asm volatile("" : "+v"(tidx_), "+s"(bidx_))

#define LAS __attribute__((address_space(3)))
typedef unsigned short bf16_t;
typedef short bf16x8 __attribute__((ext_vector_type(8)));
typedef short s16x4 __attribute__((ext_vector_type(4)));
typedef float f32x4 __attribute__((ext_vector_type(4)));
typedef float f32x2 __attribute__((ext_vector_type(2)));
typedef float f32x16 __attribute__((ext_vector_type(16)));
typedef unsigned u32x4 __attribute__((ext_vector_type(4)));
typedef unsigned u32x2 __attribute__((ext_vector_type(2)));

constexpr int DM = 2048, SEQ = 8192, NSEQ = 5, MTOT = NSEQ * SEQ, DFF = 5632;
constexpr int NIN = 9280, NINP = 9472;
constexpr int NQ = 3072, NKV = 4096;
constexpr int C_CQ = 0, C_CKV = 512, C_KPE = 1024, C_XREC = 1088, C_GREC = 3136, C_GA = 5184, C_GR = 7232;
constexpr float RMS_EPS = 1e-6f;
constexpr float QSCALE = 0.07216878364870322f * 1.4426950408889634f;

constexpr size_t MiB = 1u << 20;
constexpr size_t WS_COS = 0, WS_SIN = 1 * MiB, WS_C8 = 2 * MiB, WS_CTL = 3 * MiB, CTL_BYTES = 16384;
constexpr size_t WS_W1GU = 4 * MiB, WS_W1D = 48 * MiB, WS_W2GU = 70 * MiB, WS_W2D = 114 * MiB, WS_WIN = 136 * MiB, WS_WUQ = 173 * MiB,
                 WS_WUKV = 176 * MiB, WS_WOA = 180 * MiB, WS_WOR = 188 * MiB, WS_WOUT = 196 * MiB, WS_WG = 204 * MiB;
constexpr size_t WS_H = 206 * MiB, WS_ACT = 366 * MiB;
constexpr size_t WS_PROJ = 366 * MiB, WS_CQN = 514 * MiB, WS_CKVN = 522 * MiB, WS_KPE = 530 * MiB, WS_XC = 532 * MiB, WS_MERGED = 532 * MiB,
                 WS_Q = 564 * MiB, WS_KV = 612 * MiB, WS_T1 = 564 * MiB, WS_AF = 676 * MiB, WS_UF = 740 * MiB, WS_AB = 804 * MiB, WS_UB = 868 * MiB,
                 WS_ATTO = 932 * MiB, WS_YG = 964 * MiB, WS_AGGA = 996 * MiB, WS_AGGB = 1000 * MiB, WS_CARRY = 1004 * MiB, WS_END = 1008 * MiB;

constexpr int LDS_BYTES = 135168;
constexpr int NPH = 44;

__device__ __forceinline__ float bf2f(unsigned b) { return __uint_as_float(b << 16); }
__device__ __forceinline__ unsigned cvt_pk_bf16(float lo, float hi) { unsigned r; asm volatile("v_cvt_pk_bf16_f32 %0, %1, %2" : "=v"(r) : "v"(lo), "v"(hi)); return r; }
__device__ __forceinline__ float fsigmoid(float x) { return __builtin_amdgcn_rcpf(1.0f + __expf(-x)); }
__device__ __forceinline__ float wave_sum(float v) {
    v += __int_as_float(__builtin_amdgcn_ds_swizzle(__float_as_int(v), 0x041f));
    v += __int_as_float(__builtin_amdgcn_ds_swizzle(__float_as_int(v), 0x081f));
    v += __int_as_float(__builtin_amdgcn_ds_swizzle(__float_as_int(v), 0x101f));
    v += __int_as_float(__builtin_amdgcn_ds_swizzle(__float_as_int(v), 0x201f));
    v += __int_as_float(__builtin_amdgcn_ds_swizzle(__float_as_int(v), 0x401f));
    auto rr = __builtin_amdgcn_permlane32_swap(__float_as_uint(v), __float_as_uint(v), false, false);
    return __uint_as_float(rr[0]) + __uint_as_float(rr[1]);
}
__device__ __forceinline__ float gelu_tanh(float x) {
    const float z = 0.7978845608028654f * (x + 0.044715f * x * x * x);
    const float e = __expf(2.0f * z);
    const float t = 1.0f - 2.0f * __builtin_amdgcn_rcpf(1.0f + e);
    return 0.5f * x * (1.0f + t);
}

namespace pg8 {
constexpr int BM = 256, BK = 64, HALF = 128, HTB = HALF * BK * 2, STAGE_BYTES = 8 * HTB, NXCD = 8, WGM = 4;
__host__ __device__ __forceinline__ int lds_byte(int r, int c) { const int st = (r >> 4) * 2 + (c >> 5), rr = r & 15, cc = c & 31, ob = rr * 64 + cc * 2; return st * 1024 + (ob ^ (((ob >> 9) & 1) << 5)); }
__host__ __device__ __forceinline__ void stage_rc(int b, int& R, int& C) { const int st = b / 1024, sb = b % 1024, swz = sb ^ (((sb >> 9) & 1) << 5); R = (st >> 1) * 16 + swz / 64; C = (st & 1) * 32 + (swz % 64) / 2; }
__host__ __device__ __forceinline__ int perm32(int rho) { const int n = rho >> 4, i = rho & 15; return 8 * (i >> 2) + 4 * n + (i & 3); }

struct Unit { int pm, pn; };
struct Gemm { const bf16_t* A; const bf16_t* Bt; };

struct StaticOrder {
    int nM, nN, nwg, G, c;
    __device__ void init(int M, int N, int G_, int c_) { nM = M / BM; nN = N / BM; nwg = nM * nN; G = G_; c = c_; }
    __device__ bool next(int i, Unit& u) const {
        const long L = (long)i * G + c; if (L >= nwg) return false;
        int wgid = (int)L; { const int q = nwg / NXCD, r = nwg % NXCD, xcd = wgid % NXCD, off = wgid / NXCD; wgid = (xcd < r ? xcd * (q + 1) : r * (q + 1) + (xcd - r) * q) + off; }
        const int nig = WGM * nN, gid = wgid / nig, fm = gid * WGM, gsz = (nM - fm) < WGM ? (nM - fm) : WGM;
        u.pm = fm + ((wgid % nig) % gsz); u.pn = (wgid % nig) / gsz; return true;
    }
};

template <class Epi, int GM, int GN, int GK, int LDA, int AMOD, int ASTRIDE>
__device__ __forceinline__ void gemm_phase(LAS unsigned char* lds, const Gemm g, const Epi& E, int wv_) {
    int tid_ = wv_ * 64 + (int)__builtin_amdgcn_mbcnt_hi(~0u, __builtin_amdgcn_mbcnt_lo(~0u, 0u)), bid_ = blockIdx.x; asm volatile("" : "+v"(tid_), "+s"(bid_));
    const int tid = tid_, wid = __builtin_amdgcn_readfirstlane(tid >> 6), lane = tid & 63, wr = wid >> 2, wc = wid & 3, fr = lane & 15, fq = lane >> 4;
    constexpr int K = GK, lda = LDA; int nt = K / BK; asm volatile("" : "+s"(nt));
    StaticOrder S; S.init(GM, GN, (int)gridDim.x, bid_);
    unsigned voffA[2], voffB[2];
#pragma unroll
    for (int i = 0; i < 2; ++i) { int R, C; stage_rc(tid * 16 + i * 8192, R, C); const int Rb = Epi::PERM ? ((R & ~31) + perm32(R & 31)) : R;
        voffA[i] = (unsigned)(R * lda + C) * 2u; voffB[i] = (unsigned)(Rb * K + C) * 2u; }
    const size_t kstep = (size_t)(BK * 2);
    const size_t hstepA = (size_t)HALF * lda * 2, tstepA = 2 * hstepA;
    const size_t hstepB = (size_t)HALF * K * 2, tstepB = 2 * hstepB;
    const unsigned ldsw = (unsigned)wid * 1024u;
    const int aoff = lds_byte(wr * 64 + fr, fq * 8), boff = lds_byte(wc * 32 + fr, fq * 8);
#define PG8_SA(b, h) (((b) * 2 + (h)) * HTB)
#define PG8_SB(b, h) ((4 + (b) * 2 + (h)) * HTB)
#define PG8_STAGE(bufoff, gbase, voff) do { _Pragma("unroll") for (int _i = 0; _i < 2; ++_i) \
        __builtin_amdgcn_global_load_lds((const unsigned*)((const char*)(gbase) + (voff)[_i]), (LAS unsigned*)(lds + (bufoff) + ldsw + _i * 8192), 16, 0, 0); } while (0)
#define PG8_LDA(dst, b, h) do { _Pragma("unroll") for (int m = 0; m < 4; ++m) _Pragma("unroll") for (int k = 0; k < 2; ++k) dst[m][k] = *(const LAS bf16x8*)(lds + PG8_SA(b, h) + aoff + m * 2048 + k * 1024); } while (0)
#define PG8_LDB(dst, b, h) do { _Pragma("unroll") for (int n = 0; n < 2; ++n) _Pragma("unroll") for (int k = 0; k < 2; ++k) dst[n][k] = *(const LAS bf16x8*)(lds + PG8_SB(b, h) + boff + n * 2048 + k * 1024); } while (0)
#define PG8_MMA(ai, bj, At, Bt) do { __builtin_amdgcn_s_setprio(1); _Pragma("unroll") for (int m = 0; m < 4; ++m) _Pragma("unroll") for (int n = 0; n < 2; ++n) _Pragma("unroll") for (int k = 0; k < 2; ++k) \
        acc[ai][bj][m][n] = __builtin_amdgcn_mfma_f32_16x16x32_bf16(Bt[n][k], At[m][k], acc[ai][bj][m][n], 0, 0, 0); __builtin_amdgcn_s_setprio(0); } while (0)
#define PG8_WAIT_V(n) asm volatile("s_waitcnt vmcnt(" #n ")" ::: "memory")
#define PG8_WAIT_L(n) asm volatile("s_waitcnt lgkmcnt(" #n ")" ::: "memory")
#define PG8_BAR __builtin_amdgcn_s_barrier()
#define PG8_SCHED __builtin_amdgcn_sched_barrier(0)
#define PG8_AOFF(pn) (AMOD ? (size_t)((pn) % (AMOD ? AMOD : 1)) * (size_t)ASTRIDE * 2 : (size_t)0)
    Unit cur, nxt; int ui = 0;
    if (!S.next(0, cur)) return;
    f32x4 acc[2][2][4][2];
#pragma unroll
    for (int a = 0; a < 2; ++a)
#pragma unroll
        for (int b = 0; b < 2; ++b)
#pragma unroll
            for (int m = 0; m < 4; ++m)
#pragma unroll
                for (int n = 0; n < 2; ++n) acc[a][b][m][n] = (f32x4){0.f, 0.f, 0.f, 0.f};
    bf16x8 At[4][2], B0[2][2], B1[2][2];
    const char* cA = (const char*)g.A + (size_t)cur.pm * tstepA + PG8_AOFF(cur.pn); const char* cB = (const char*)g.Bt + (size_t)cur.pn * tstepB;
    PG8_STAGE(PG8_SB(0, 0), cB, voffB); PG8_STAGE(PG8_SB(0, 1), cB + hstepB, voffB); PG8_STAGE(PG8_SA(0, 0), cA, voffA); PG8_STAGE(PG8_SA(0, 1), cA + hstepA, voffA);
    if (wr == 1) PG8_BAR;
    PG8_WAIT_V(2); PG8_BAR;
    PG8_STAGE(PG8_SB(1, 0), cB + kstep, voffB); PG8_STAGE(PG8_SA(1, 0), cA + kstep, voffA); PG8_STAGE(PG8_SB(1, 1), cB + hstepB + kstep, voffB);
    PG8_WAIT_V(6); PG8_BAR;
    for (;;) {
        const bool has_next = S.next(ui + 1, nxt);
        const char* nA = has_next ? (const char*)g.A + (size_t)nxt.pm * tstepA + PG8_AOFF(nxt.pn) : cA; const char* nB = has_next ? (const char*)g.Bt + (size_t)nxt.pn * tstepB : cB;
        for (int t = 0; t < nt; t += 2) {
            const bool last = (t == nt - 2);
            const char* a1 = cA + (size_t)(t + 1) * kstep;
            const char* a2 = last ? nA : cA + (size_t)(t + 2) * kstep; const char* b2 = last ? nB : cB + (size_t)(t + 2) * kstep;
            const char* a3 = a2 + kstep; const char* b3 = b2 + kstep;
            PG8_LDB(B0, 0, 0); PG8_LDB(B1, 0, 1); PG8_SCHED; PG8_LDA(At, 0, 0); PG8_STAGE(PG8_SA(1, 1), a1 + hstepA, voffA);
            PG8_WAIT_V(8); PG8_WAIT_L(0); PG8_BAR; PG8_MMA(0, 0, At, B0); PG8_MMA(0, 1, At, B1); PG8_BAR; PG8_SCHED;
            PG8_LDA(At, 0, 1); PG8_STAGE(PG8_SB(0, 0), b2, voffB); PG8_STAGE(PG8_SB(0, 1), b2 + hstepB, voffB); PG8_STAGE(PG8_SA(0, 0), a2, voffA);
            PG8_WAIT_V(8); PG8_WAIT_L(0); PG8_BAR; PG8_MMA(1, 0, At, B0); PG8_MMA(1, 1, At, B1); PG8_BAR; PG8_SCHED;
            PG8_LDB(B0, 1, 0); PG8_LDB(B1, 1, 1); PG8_SCHED; PG8_LDA(At, 1, 0); PG8_STAGE(PG8_SA(0, 1), a2 + hstepA, voffA);
            PG8_WAIT_V(8); PG8_WAIT_L(0); PG8_BAR; PG8_MMA(0, 0, At, B0); PG8_MMA(0, 1, At, B1); PG8_BAR; PG8_SCHED;
            PG8_LDA(At, 1, 1); PG8_STAGE(PG8_SB(1, 0), b3, voffB); PG8_STAGE(PG8_SB(1, 1), b3 + hstepB, voffB); PG8_STAGE(PG8_SA(1, 0), a3, voffA);
            PG8_WAIT_V(8); PG8_WAIT_L(0); PG8_BAR; PG8_MMA(1, 0, At, B0); PG8_MMA(1, 1, At, B1); PG8_BAR; PG8_SCHED;
        }
        if (wr == 0) PG8_BAR;
        { int fr2 = fr, fq2 = fq; asm volatile("" : "+v"(fr2), "+v"(fq2)); E(acc, cur, wr, wc, fr2, fq2); }
        if (!has_next) break;
#pragma unroll
        for (int a = 0; a < 2; ++a)
#pragma unroll
            for (int b = 0; b < 2; ++b)
#pragma unroll
                for (int m = 0; m < 4; ++m)
#pragma unroll
                    for (int n = 0; n < 2; ++n) acc[a][b][m][n] = (f32x4){0.f, 0.f, 0.f, 0.f};
        cur = nxt; cA = nA; cB = nB; ++ui;
        if (wr == 1) PG8_BAR;
    }
    PG8_WAIT_V(0);
    PG8_BAR;
#undef PG8_SA
#undef PG8_SB
#undef PG8_STAGE
#undef PG8_LDA
#undef PG8_LDB
#undef PG8_MMA
#undef PG8_WAIT_V
#undef PG8_WAIT_L
#undef PG8_BAR
#undef PG8_SCHED
#undef PG8_AOFF
}

typedef f32x4 Acc[2][2][4][2];

struct EpiBf16 {
    static constexpr bool PERM = true;
    bf16_t* O; int ldc;
    __device__ __forceinline__ void operator()(const Acc& acc, const Unit& u, int wr, int wc, int fr, int fq) const {
        const int row0 = u.pm * BM + wr * 64 + fr, col0 = u.pn * BM + wc * 32 + 8 * fq;
#pragma unroll
        for (int ai = 0; ai < 2; ++ai)
#pragma unroll
            for (int m = 0; m < 4; ++m) { bf16_t* rowp = O + (size_t)(row0 + ai * HALF + m * 16) * ldc + col0;
#pragma unroll
                for (int bj = 0; bj < 2; ++bj) { const f32x4 v0 = acc[ai][bj][m][0], v1 = acc[ai][bj][m][1];
                    u32x4 w; w.x = cvt_pk_bf16(v0[0], v0[1]); w.y = cvt_pk_bf16(v0[2], v0[3]); w.z = cvt_pk_bf16(v1[0], v1[1]); w.w = cvt_pk_bf16(v1[2], v1[3]);
                    *(u32x4*)(rowp + bj * HALF) = w; } asm volatile("" ::: "memory"); }
    }
};
struct EpiSwiglu {
    static constexpr bool PERM = true;
    bf16_t* O; int ldc;
    __device__ __forceinline__ void operator()(const Acc& acc, const Unit& u, int wr, int wc, int fr, int fq) const {
        const int row0 = u.pm * BM + wr * 64 + fr, col0 = u.pn * HALF + wc * 32 + 8 * fq;
#pragma unroll
        for (int ai = 0; ai < 2; ++ai)
#pragma unroll
            for (int m = 0; m < 4; ++m) { bf16_t* rowp = O + (size_t)(row0 + ai * HALF + m * 16) * ldc + col0;
                float r[8];
#pragma unroll
                for (int n = 0; n < 2; ++n)
#pragma unroll
                    for (int j = 0; j < 4; ++j) { const float gv = acc[ai][0][m][n][j], uv = acc[ai][1][m][n][j]; r[n * 4 + j] = gv * fsigmoid(gv) * uv; }
                u32x4 w; w.x = cvt_pk_bf16(r[0], r[1]); w.y = cvt_pk_bf16(r[2], r[3]); w.z = cvt_pk_bf16(r[4], r[5]); w.w = cvt_pk_bf16(r[6], r[7]);
                *(u32x4*)rowp = w; asm volatile("" ::: "memory"); }
    }
};
struct EpiResid {
    static constexpr bool PERM = false;
    const float* res0; const float* res1; int split; float* out; float alpha; int row_base;
    __device__ __forceinline__ void operator()(const Acc& acc, const Unit& u, int wr, int wc, int fr, int fq) const {
        const int grow0 = row_base + u.pm * BM; const float* rb = grow0 < split ? res0 + (size_t)grow0 * DM : res1 + (size_t)(grow0 - split) * DM;
        float* ob = out + (size_t)grow0 * DM; const int col0 = u.pn * BM + wc * 32 + 4 * fq;
#pragma unroll
        for (int ai = 0; ai < 2; ++ai)
#pragma unroll
            for (int mp = 0; mp < 2; ++mp) {
                f32x4 bs[2][2][2];
#pragma unroll
                for (int mm = 0; mm < 2; ++mm) { const size_t off = (size_t)(ai * HALF + wr * 64 + (2 * mp + mm) * 16 + fr) * DM + col0;
#pragma unroll
                    for (int bj = 0; bj < 2; ++bj)
#pragma unroll
                        for (int n = 0; n < 2; ++n) bs[mm][bj][n] = *(const f32x4*)(rb + off + bj * HALF + n * 16); }
#pragma unroll
                for (int mm = 0; mm < 2; ++mm) { const int m = 2 * mp + mm; const size_t off = (size_t)(ai * HALF + wr * 64 + m * 16 + fr) * DM + col0;
#pragma unroll
                    for (int bj = 0; bj < 2; ++bj)
#pragma unroll
                        for (int n = 0; n < 2; ++n) *(f32x4*)(ob + off + bj * HALF + n * 16) = bs[mm][bj][n] + acc[ai][bj][m][n] * alpha; }
                asm volatile("" ::: "memory"); }
    }
};
struct EpiQ {
    static constexpr bool PERM = true;
    bf16_t* O; const float* cosT; const float* sinT;
    __device__ __forceinline__ void operator()(const Acc& acc, const Unit& u, int wr, int wc, int fr, int fq) const {
        const int row0 = u.pm * BM + wr * 64 + fr;
#pragma unroll
        for (int bj = 0; bj < 2; ++bj) { const int col0 = u.pn * BM + bj * HALF + wc * 32 + 8 * fq; const int d = col0 % 192; const bool rope = d >= 128; const int jp0 = (d - 128) >> 1;
#pragma unroll
            for (int ai = 0; ai < 2; ++ai)
#pragma unroll
                for (int m = 0; m < 4; ++m) { const int row = row0 + ai * HALF + m * 16; f32x4 v0 = acc[ai][bj][m][0], v1 = acc[ai][bj][m][1];
                    if (rope) { const f32x4 c = *(const f32x4*)(cosT + (size_t)row * 32 + jp0), s = *(const f32x4*)(sinT + (size_t)row * 32 + jp0);
                        const f32x4 a0 = v0, a1 = v1;
                        v0[0] = a0[0] * c[0] - a0[1] * s[0]; v0[1] = a0[1] * c[0] + a0[0] * s[0]; v0[2] = a0[2] * c[1] - a0[3] * s[1]; v0[3] = a0[3] * c[1] + a0[2] * s[1];
                        v1[0] = a1[0] * c[2] - a1[1] * s[2]; v1[1] = a1[1] * c[2] + a1[0] * s[2]; v1[2] = a1[2] * c[3] - a1[3] * s[3]; v1[3] = a1[3] * c[3] + a1[2] * s[3]; }
                    v0 = v0 * QSCALE; v1 = v1 * QSCALE;
                    u32x4 w; w.x = cvt_pk_bf16(v0[0], v0[1]); w.y = cvt_pk_bf16(v0[2], v0[3]); w.z = cvt_pk_bf16(v1[0], v1[1]); w.w = cvt_pk_bf16(v1[2], v1[3]);
                    *(u32x4*)(O + (size_t)row * NQ + col0) = w; asm volatile("" ::: "memory"); } }
    }
};
struct EpiGates {
    static constexpr bool PERM = true;
    const bf16_t* xc; const float* b_a; const float* b_i; const float* c8; bf16_t* Aout; bf16_t* Uout; size_t dir_stride;
    __device__ __forceinline__ void operator()(const Acc& acc, const Unit& u, int wr, int wc, int fr, int fq) const {
        const int dir = u.pn >> 4, blk = u.pn & 15; const int row0 = u.pm * BM + wr * 64 + fr; const int ch0 = blk * HALF + wc * 32 + 8 * fq;
        bf16_t* Ao = Aout + (size_t)dir * dir_stride; bf16_t* Uo = Uout + (size_t)dir * dir_stride;
        f32x4 ba[2], bi[2], cc[2];
#pragma unroll
        for (int n = 0; n < 2; ++n) { ba[n] = *(const f32x4*)(b_a + dir * DM + ch0 + 4 * n); bi[n] = *(const f32x4*)(b_i + dir * DM + ch0 + 4 * n); cc[n] = *(const f32x4*)(c8 + dir * DM + ch0 + 4 * n); }
#pragma unroll
        for (int ai = 0; ai < 2; ++ai)
#pragma unroll
            for (int m = 0; m < 4; ++m) { const int row = row0 + ai * HALF + m * 16; const size_t off = (size_t)row * DM + ch0;
                const u32x4 xw = *(const u32x4*)(xc + off);
                const float xv[8] = {bf2f(xw.x & 0xffffu), bf2f(xw.x >> 16), bf2f(xw.y & 0xffffu), bf2f(xw.y >> 16), bf2f(xw.z & 0xffffu), bf2f(xw.z >> 16), bf2f(xw.w & 0xffffu), bf2f(xw.w >> 16)};
                float om[8], uv[8];
#pragma unroll
                for (int n = 0; n < 2; ++n)
#pragma unroll
                    for (int j = 0; j < 4; ++j) { const float r = fsigmoid(acc[ai][0][m][n][j] + ba[n][j]), ig = fsigmoid(acc[ai][1][m][n][j] + bi[n][j]);
                        const float y = r * cc[n][j];
                        float o1 = y * (1.0f - y * (0.5f - y * (0.16666667f - y * (0.041666668f - y * 0.008333334f))));
                        if (__builtin_expect(__any(y >= 0.125f), 0)) { const float ome = 1.0f - __expf(-y); o1 = y < 0.125f ? o1 : ome; }
                        om[n * 4 + j] = o1; uv[n * 4 + j] = sqrtf(o1 * (2.0f - o1)) * (ig * xv[n * 4 + j]); }
                u32x4 wa, wu; wa.x = cvt_pk_bf16(om[0], om[1]); wa.y = cvt_pk_bf16(om[2], om[3]); wa.z = cvt_pk_bf16(om[4], om[5]); wa.w = cvt_pk_bf16(om[6], om[7]);
                wu.x = cvt_pk_bf16(uv[0], uv[1]); wu.y = cvt_pk_bf16(uv[2], uv[3]); wu.z = cvt_pk_bf16(uv[4], uv[5]); wu.w = cvt_pk_bf16(uv[6], uv[7]);
                *(u32x4*)(Ao + off) = wa; *(u32x4*)(Uo + off) = wu; asm volatile("" ::: "memory"); }
    }
};
struct EpiT1 {
    static constexpr bool PERM = true;
    const bf16_t* gate; int ldg; bf16_t* O;
    __device__ __forceinline__ void operator()(const Acc& acc, const Unit& u, int wr, int wc, int fr, int fq) const {
        const int row0 = u.pm * BM + wr * 64 + fr;
#pragma unroll
        for (int ai = 0; ai < 2; ++ai)
#pragma unroll
            for (int m = 0; m < 4; ++m) { const int row = row0 + ai * HALF + m * 16;
#pragma unroll
                for (int bj = 0; bj < 2; ++bj) { const int col0 = u.pn * BM + bj * HALF + wc * 32 + 8 * fq;
                    const u32x4 gw = *(const u32x4*)(gate + (size_t)row * ldg + col0); f32x4 v0 = acc[ai][bj][m][0], v1 = acc[ai][bj][m][1];
                    v0[0] *= fsigmoid(bf2f(gw.x & 0xffffu)); v0[1] *= fsigmoid(bf2f(gw.x >> 16)); v0[2] *= fsigmoid(bf2f(gw.y & 0xffffu)); v0[3] *= fsigmoid(bf2f(gw.y >> 16));
                    v1[0] *= fsigmoid(bf2f(gw.z & 0xffffu)); v1[1] *= fsigmoid(bf2f(gw.z >> 16)); v1[2] *= fsigmoid(bf2f(gw.w & 0xffffu)); v1[3] *= fsigmoid(bf2f(gw.w >> 16));
                    u32x4 w; w.x = cvt_pk_bf16(v0[0], v0[1]); w.y = cvt_pk_bf16(v0[2], v0[3]); w.z = cvt_pk_bf16(v1[0], v1[1]); w.w = cvt_pk_bf16(v1[2], v1[3]);
                    *(u32x4*)(O + (size_t)row * DM + col0) = w; } asm volatile("" ::: "memory"); }
    }
};
struct EpiMerge {
    static constexpr bool PERM = true;
    const bf16_t* gate; int ldg; const bf16_t* T1; bf16_t* O;
    __device__ __forceinline__ void operator()(const Acc& acc, const Unit& u, int wr, int wc, int fr, int fq) const {
        const int row0 = u.pm * BM + wr * 64 + fr;
#pragma unroll
        for (int ai = 0; ai < 2; ++ai)
#pragma unroll
            for (int m = 0; m < 4; ++m) { const int row = row0 + ai * HALF + m * 16;
#pragma unroll
                for (int bj = 0; bj < 2; ++bj) { const int col0 = u.pn * BM + bj * HALF + wc * 32 + 8 * fq;
                    const u32x4 gw = *(const u32x4*)(gate + (size_t)row * ldg + col0); const u32x4 tw = *(const u32x4*)(T1 + (size_t)row * DM + col0);
                    f32x4 v0 = acc[ai][bj][m][0], v1 = acc[ai][bj][m][1];
                    const f32x4 t0 = {bf2f(tw.x & 0xffffu), bf2f(tw.x >> 16), bf2f(tw.y & 0xffffu), bf2f(tw.y >> 16)}, t1 = {bf2f(tw.z & 0xffffu), bf2f(tw.z >> 16), bf2f(tw.w & 0xffffu), bf2f(tw.w >> 16)};
                    v0[0] = t0[0] + v0[0] * fsigmoid(bf2f(gw.x & 0xffffu)); v0[1] = t0[1] + v0[1] * fsigmoid(bf2f(gw.x >> 16)); v0[2] = t0[2] + v0[2] * fsigmoid(bf2f(gw.y & 0xffffu)); v0[3] = t0[3] + v0[3] * fsigmoid(bf2f(gw.y >> 16));
                    v1[0] = t1[0] + v1[0] * fsigmoid(bf2f(gw.z & 0xffffu)); v1[1] = t1[1] + v1[1] * fsigmoid(bf2f(gw.z >> 16)); v1[2] = t1[2] + v1[2] * fsigmoid(bf2f(gw.w & 0xffffu)); v1[3] = t1[3] + v1[3] * fsigmoid(bf2f(gw.w >> 16));
                    u32x4 w; w.x = cvt_pk_bf16(v0[0], v0[1]); w.y = cvt_pk_bf16(v0[2], v0[3]); w.z = cvt_pk_bf16(v1[0], v1[1]); w.w = cvt_pk_bf16(v1[2], v1[3]);
                    *(u32x4*)(O + (size_t)row * DM + col0) = w; } asm volatile("" ::: "memory"); }
    }
};
}

namespace att {
constexpr int NW = 8, QBLK = 32, KVBLK = 64;
constexpr int LDQ = NQ, LDKV = NKV, LDO = DM;
constexpr int SLOT_K = 24576, SLOT_V = 16384, KR_OFF = 16384;
constexpr int OFF_K = 0, OFF_V = 3 * SLOT_K, OFF_WS = OFF_V + 3 * SLOT_V;
constexpr float THRL = 11.0f;
#define KNSWZ(row, colB) ((row) * 256 + ((colB) ^ (((row) & 15) << 4)))
#define KRSWZ(row, colB) ((row) * 128 + ((colB) ^ ((((row) >> 1) & 7) << 4)))
#define SBAR() __builtin_amdgcn_sched_barrier(0)
__device__ __forceinline__ int crow(int r, int hi) { return (r & 3) + 8 * (r >> 2) + 4 * hi; }

__device__ __forceinline__ void partialSM(f32x16& p0, f32x16& p1, float& m_reg, float& mn, float& alpha) {
    float pmax = p0[0];
#pragma unroll
    for (int r = 1; r < 16; ++r) pmax = fmaxf(pmax, p0[r]);
#pragma unroll
    for (int r = 0; r < 16; ++r) pmax = fmaxf(pmax, p1[r]);
    { auto rr = __builtin_amdgcn_permlane32_swap(__float_as_uint(pmax), __float_as_uint(pmax), false, false);
      pmax = fmaxf(__uint_as_float(rr[0]), __uint_as_float(rr[1])); }
    if (__builtin_expect(__all(pmax - m_reg <= THRL), 1)) { mn = m_reg; alpha = 1.f; }
    else { mn = fmaxf(m_reg, pmax); alpha = __builtin_amdgcn_exp2f(m_reg - mn); m_reg = mn; }
#pragma unroll
    for (int r = 0; r < 16; ++r) p0[r] = p0[r] - mn;
#pragma unroll
    for (int r = 0; r < 16; ++r) p1[r] = p1[r] - mn;
#pragma unroll
    for (int r = 0; r < 16; ++r) p0[r] = __builtin_amdgcn_exp2f(p0[r]);
}
__device__ __forceinline__ void finishSM(f32x16& p0, f32x16& p1, float alpha, float& l_reg, bf16x8& pa0, bf16x8& pa1, bf16x8& pa2, bf16x8& pa3) {
#pragma unroll
    for (int r = 0; r < 16; ++r) p1[r] = __builtin_amdgcn_exp2f(p1[r]);
    float ps = 0;
#pragma unroll
    for (int r = 0; r < 16; ++r) ps += p0[r];
#pragma unroll
    for (int r = 0; r < 16; ++r) ps += p1[r];
    { auto rr = __builtin_amdgcn_permlane32_swap(__float_as_uint(ps), __float_as_uint(ps), false, false);
      ps = __uint_as_float(rr[0]) + __uint_as_float(rr[1]); }
    l_reg = l_reg * alpha + ps;
#define PK4(P, BASE, OUT) do { unsigned a0 = cvt_pk_bf16(P[BASE + 0], P[BASE + 1]), a1 = cvt_pk_bf16(P[BASE + 2], P[BASE + 3]);   \
    unsigned b0 = cvt_pk_bf16(P[BASE + 4], P[BASE + 5]), b1 = cvt_pk_bf16(P[BASE + 6], P[BASE + 7]);                              \
    auto r0 = __builtin_amdgcn_permlane32_swap(a0, b0, false, false); auto r1 = __builtin_amdgcn_permlane32_swap(a1, b1, false, false); \
    u32x4 w = {r0[0], r1[0], r0[1], r1[1]}; OUT = *reinterpret_cast<bf16x8*>(&w); } while (0)
    PK4(p0, 0, pa0); PK4(p0, 8, pa1); PK4(p1, 0, pa2); PK4(p1, 8, pa3);
#undef PK4
}
__device__ __forceinline__ void qkt(f32x16& p0, f32x16& p1, const char* Kn, const bf16x8* qr, int r32, int hi) {
    const char* Kr = Kn + KR_OFF;
    p0 = f32x16{}; p1 = f32x16{};
    __builtin_amdgcn_s_setprio(1);
#pragma unroll
    for (int d0 = 0; d0 < 8; ++d0) { const int cb = (d0 * 16 + hi * 8) * 2;
        const bf16x8 b0 = *reinterpret_cast<const bf16x8*>(Kn + KNSWZ(r32, cb));
        const bf16x8 b1 = *reinterpret_cast<const bf16x8*>(Kn + KNSWZ(32 + r32, cb));
        p0 = __builtin_amdgcn_mfma_f32_32x32x16_bf16(b0, qr[d0], p0, 0, 0, 0);
        p1 = __builtin_amdgcn_mfma_f32_32x32x16_bf16(b1, qr[d0], p1, 0, 0, 0); }
#pragma unroll
    for (int d0 = 0; d0 < 4; ++d0) { const int cb = (d0 * 16 + hi * 8) * 2;
        const bf16x8 b0 = *reinterpret_cast<const bf16x8*>(Kr + KRSWZ(r32, cb));
        const bf16x8 b1 = *reinterpret_cast<const bf16x8*>(Kr + KRSWZ(32 + r32, cb));
        p0 = __builtin_amdgcn_mfma_f32_32x32x16_bf16(b0, qr[8 + d0], p0, 0, 0, 0);
        p1 = __builtin_amdgcn_mfma_f32_32x32x16_bf16(b1, qr[8 + d0], p1, 0, 0, 0); }
}
__device__ __forceinline__ int v_st(int k, int c) { const int kk = (k & ~0xC) | ((k & 4) << 1) | ((k & 8) >> 1); return ((kk >> 3) * 4 + (c >> 5)) * 512 + ((kk & 7) * 32 + (c & 31)) * 2; }
__device__ __forceinline__ int v_rd_base(int lane) { return ((lane & 3) << 3) | (((lane >> 2) & 3) << 6) | (((lane >> 4) & 1) << 5) | (((lane >> 5) & 1) << 8); }
constexpr int v_rd_off(int d0, int ks, int half) { return d0 * 512 + ks * 4096 + half * 2048; }
template <int OFF> __device__ __forceinline__ s16x4 tr_read(int vb) {
    s16x4 r; asm volatile("ds_read_b64_tr_b16 %0, %1 offset:%2" : "=&v"(r) : "v"(vb), "i"(OFF) : "memory"); return r;
}
template <int D0> __device__ __forceinline__ void pv_one(f32x16& od, int vb, bf16x8 pa0, bf16x8 pa1, bf16x8 pa2, bf16x8 pa3) {
    const s16x4 l0 = tr_read<v_rd_off(D0, 0, 0)>(vb), h0 = tr_read<v_rd_off(D0, 0, 1)>(vb), l1 = tr_read<v_rd_off(D0, 1, 0)>(vb), h1 = tr_read<v_rd_off(D0, 1, 1)>(vb);
    const s16x4 l2 = tr_read<v_rd_off(D0, 2, 0)>(vb), h2 = tr_read<v_rd_off(D0, 2, 1)>(vb), l3 = tr_read<v_rd_off(D0, 3, 0)>(vb), h3 = tr_read<v_rd_off(D0, 3, 1)>(vb);
    asm volatile("s_waitcnt lgkmcnt(0)" ::: "memory"); SBAR();
#define PK(L, H) (bf16x8){L[0], L[1], L[2], L[3], H[0], H[1], H[2], H[3]}
    od = __builtin_amdgcn_mfma_f32_32x32x16_bf16(pa0, PK(l0, h0), od, 0, 0, 0);
    od = __builtin_amdgcn_mfma_f32_32x32x16_bf16(pa1, PK(l1, h1), od, 0, 0, 0);
    od = __builtin_amdgcn_mfma_f32_32x32x16_bf16(pa2, PK(l2, h2), od, 0, 0, 0);
    od = __builtin_amdgcn_mfma_f32_32x32x16_bf16(pa3, PK(l3, h3), od, 0, 0, 0);
#undef PK
}
__device__ __forceinline__ void pv_d0(f32x16* o, int vb, bf16x8 pa0, bf16x8 pa1, bf16x8 pa2, bf16x8 pa3) {
    pv_one<0>(o[0], vb, pa0, pa1, pa2, pa3); pv_one<1>(o[1], vb, pa0, pa1, pa2, pa3); pv_one<2>(o[2], vb, pa0, pa1, pa2, pa3); pv_one<3>(o[3], vb, pa0, pa1, pa2, pa3);
}

__device__ __forceinline__ void attn_unit(const bf16_t* __restrict__ Qb, const bf16_t* __restrict__ Kn, const bf16_t* __restrict__ Vh, const bf16_t* __restrict__ Kr,
                                          bf16_t* __restrict__ Ob, int seq, char* lds, int wv_) { LAUNDER_IDS;
    const int tid = tidx_, wid = __builtin_amdgcn_readfirstlane(tid >> 6), lane = tid & 63, r32 = lane & 31, hi = lane >> 5;
    LAS unsigned char* lds3 = (LAS unsigned char*)lds;
    float* ws = (float*)(lds + OFF_WS) + wid * 64; float* li_l = ws; float* al_l = ws + 32;
    float m_reg = -1e30f, l_reg = 0; f32x16 o[4] = {}; bf16x8 qr[12];
    const bf16_t* Qw = Qb + (long)(wid * QBLK + r32) * LDQ + hi * 8;
#pragma unroll
    for (int d0 = 0; d0 < 12; ++d0) qr[d0] = *reinterpret_cast<const bf16x8*>(Qw + d0 * 16);
    unsigned gkn[2], gv[2], gkr;
#pragma unroll
    for (int i = 0; i < 2; ++i) { const int c = wid * 2 + i; const int row = c * 4 + (lane >> 4), slot = lane & 15; gkn[i] = (unsigned)(row * (LDKV * 2) + ((slot ^ (row & 15)) << 4));
        const int st = c * 2 + (lane >> 5), kk = (st >> 2) * 8 + ((lane & 31) >> 2), k = (kk & ~0xC) | ((kk & 4) << 1) | ((kk & 8) >> 1), col = (st & 3) * 32 + (lane & 3) * 8; gv[i] = (unsigned)(k * (LDKV * 2) + col * 2); }
    { const int row = wid * 8 + (lane >> 3), slot = lane & 7; gkr = (unsigned)(row * 128 + ((slot ^ ((row >> 1) & 7)) << 4)); }
    const int vb0 = (int)(uintptr_t)(lds + OFF_V) + v_rd_base(lane);
#define DMA(t, slot) do { const char* kt_ = (const char*)Kn + (size_t)(t) * (KVBLK * LDKV * 2); const char* vt_ = (const char*)Vh + (size_t)(t) * (KVBLK * LDKV * 2); const char* rt_ = (const char*)Kr + (size_t)(t) * (KVBLK * 128); \
    _Pragma("unroll") for (int i_ = 0; i_ < 2; ++i_) { \
      __builtin_amdgcn_global_load_lds((const unsigned*)(kt_ + gkn[i_]), (LAS unsigned*)(lds3 + OFF_K + (slot) * SLOT_K + (wid * 2 + i_) * 1024), 16, 0, 0); \
      __builtin_amdgcn_global_load_lds((const unsigned*)(vt_ + gv[i_]), (LAS unsigned*)(lds3 + OFF_V + (slot) * SLOT_V + (wid * 2 + i_) * 1024), 16, 0, 0); } \
    __builtin_amdgcn_global_load_lds((const unsigned*)(rt_ + gkr), (LAS unsigned*)(lds3 + OFF_K + (slot) * SLOT_K + KR_OFF + wid * 1024), 16, 0, 0); } while (0)
#define WAIT_BAR() asm volatile("s_waitcnt vmcnt(0) lgkmcnt(0)\n\ts_barrier" ::: "memory")
#define RESC(a) do { if (__any((a) < 1.f)) { if (hi == 0) al_l[r32] = (a); asm volatile("s_waitcnt lgkmcnt(0)" ::: "memory"); \
    _Pragma("unroll") for (int d = 0; d < 4; ++d) _Pragma("unroll") for (int r = 0; r < 16; ++r) o[d][r] *= al_l[crow(r, hi)]; } } while (0)
    f32x16 pA0, pA1, pB0, pB1; float mnA, mnB, alA, alB; bf16x8 pa0, pa1, pa2, pa3; const int NT = seq / KVBLK;
    DMA(0, 0); DMA(1, 1); WAIT_BAR();
    qkt(pA0, pA1, lds + OFF_K, qr, r32, hi); __builtin_amdgcn_s_setprio(0); partialSM(pA0, pA1, m_reg, mnA, alA);
    int s_prev = 0, s_cur = 1, s_next = 2;
#define ROT() do { const int t_ = s_prev; s_prev = s_cur; s_cur = s_next; s_next = t_; } while (0)
    for (int j = 1; j + 1 < NT; j += 2) {
        DMA(j + 1, s_next); SBAR();
        qkt(pB0, pB1, lds + OFF_K + s_cur * SLOT_K, qr, r32, hi);
        finishSM(pA0, pA1, alA, l_reg, pa0, pa1, pa2, pa3); __builtin_amdgcn_s_setprio(0); SBAR();
        pv_d0(o, vb0 + s_prev * SLOT_V, pa0, pa1, pa2, pa3); partialSM(pB0, pB1, m_reg, mnB, alB);
        RESC(alB); WAIT_BAR(); ROT();
        DMA(j + 2, s_next); SBAR();
        qkt(pA0, pA1, lds + OFF_K + s_cur * SLOT_K, qr, r32, hi);
        finishSM(pB0, pB1, alB, l_reg, pa0, pa1, pa2, pa3); __builtin_amdgcn_s_setprio(0); SBAR();
        pv_d0(o, vb0 + s_prev * SLOT_V, pa0, pa1, pa2, pa3); partialSM(pA0, pA1, m_reg, mnA, alA);
        RESC(alA); WAIT_BAR(); ROT();
    }
    SBAR(); qkt(pB0, pB1, lds + OFF_K + s_cur * SLOT_K, qr, r32, hi);
    finishSM(pA0, pA1, alA, l_reg, pa0, pa1, pa2, pa3); __builtin_amdgcn_s_setprio(0); SBAR();
    pv_d0(o, vb0 + s_prev * SLOT_V, pa0, pa1, pa2, pa3); partialSM(pB0, pB1, m_reg, mnB, alB);
    RESC(alB);
    finishSM(pB0, pB1, alB, l_reg, pa0, pa1, pa2, pa3); __builtin_amdgcn_s_setprio(0); SBAR();
    pv_d0(o, vb0 + s_cur * SLOT_V, pa0, pa1, pa2, pa3);
    if (hi == 0) li_l[r32] = l_reg; asm volatile("s_waitcnt lgkmcnt(0)" ::: "memory");
    float rli[16];
#pragma unroll
    for (int r = 0; r < 16; ++r) rli[r] = __builtin_amdgcn_rcpf(li_l[crow(r, hi)]);
    bf16_t* Ow = Ob + (long)(wid * QBLK) * LDO;
#pragma unroll
    for (int r = 0; r < 16; ++r) { const int orow = crow(r, hi);
#pragma unroll
        for (int d0 = 0; d0 < 4; ++d0) Ow[(long)orow * LDO + d0 * 32 + r32] = (bf16_t)(cvt_pk_bf16(o[d0][r] * rli[r], 0.f) & 0xffffu); }
    WAIT_BAR();
#undef DMA
#undef WAIT_BAR
#undef RESC
#undef ROT
}
}


#define XB_TMO      128
#define XB_XCNT(j)  (256  + 64 * (j))
#define XB_XSUB(j)  (1280 + 64 * (j))
#define XB_XGEN(j)  (2304 + 64 * (j))
#define XB_TOP      3328
#define XB_TOPGEN   3392
#define XCD_BAR_WORDS 3456
#define XB_SPIN_CAP (1u << 22)
__device__ __forceinline__ unsigned xb_ld(unsigned* p)              { return __hip_atomic_load(p, __ATOMIC_RELAXED, __HIP_MEMORY_SCOPE_AGENT); }
__device__ __forceinline__ unsigned xb_add(unsigned* p, unsigned v) { return __hip_atomic_fetch_add(p, v, __ATOMIC_RELAXED, __HIP_MEMORY_SCOPE_AGENT); }
__device__ __forceinline__ unsigned xb_xcc_id() { return (unsigned)__builtin_amdgcn_s_getreg((3 << 11) | 20) & 0xFu; }
#define XB_SPIN(cond, bar) do { unsigned _sp = 0; while (cond) { __builtin_amdgcn_s_sleep(1); \
    if ((++_sp & 255u) == 0u) { if (xb_ld(&(bar)[XB_TMO])) break; if (_sp > XB_SPIN_CAP) { atomicAdd(&(bar)[XB_TMO], 1u); break; } } } } while (0)
struct XcdBarrier { unsigned* bar; unsigned x; volatile LAS unsigned* st; };
__device__ __forceinline__ XcdBarrier xcd_barrier_post(unsigned* bar, volatile LAS unsigned* st) {
    XcdBarrier b; b.bar = bar; b.x = xb_xcc_id(); b.st = st;
    if (threadIdx.x == 0) (void)xb_add(&bar[XB_XCNT(b.x)], 1u);
    return b;
}
__device__ __forceinline__ void xcd_barrier_complete(unsigned* bar, unsigned x, unsigned& nloc, unsigned& nx) {
    const unsigned G = gridDim.x * gridDim.y * gridDim.z;
    unsigned sum, cnt, mine, sp = 0u;
    for (;;) {
        sum = 0u; cnt = 0u; mine = 0u;
#pragma unroll
        for (unsigned j = 0; j < 16; ++j) { const unsigned c = xb_ld(&bar[XB_XCNT(j)]); sum += c; cnt += (c > 0u) ? 1u : 0u; mine = (j == x) ? c : mine; }
        if (sum == G) break;
        __builtin_amdgcn_s_sleep(1);
        if ((++sp & 255u) == 0u) { if (xb_ld(&bar[XB_TMO])) break; if (sp > XB_SPIN_CAP) { atomicAdd(&bar[XB_TMO], 1u); break; } }
    }
    nloc = mine > 0u ? mine : 1u; nx = cnt > 0u ? cnt : 1u;
}
__device__ __forceinline__ void xcd_barrier(const XcdBarrier& b) {
    asm volatile("s_waitcnt vmcnt(0)" ::: "memory");
    __syncthreads();
    if (threadIdx.x == 0) {
        unsigned* bar = b.bar;
        __builtin_amdgcn_s_waitcnt(0);
        unsigned nloc = b.st[0], nx = b.st[1];
        if (nloc == 0u) { xcd_barrier_complete(bar, b.x, nloc, nx); b.st[0] = nloc; b.st[1] = nx; }
        const unsigned old = xb_add(&bar[XB_XSUB(b.x)], 1u);
        const unsigned gen = old / nloc;
        if (old + 1u == (gen + 1u) * nloc) {
            __builtin_amdgcn_fence(__ATOMIC_RELEASE, "agent");
            asm volatile("s_waitcnt vmcnt(0)" ::: "memory");
            const unsigned og = xb_add(&bar[XB_TOP], 1u);
            const unsigned tg = og / nx;
            if (og + 1u == (tg + 1u) * nx) xb_add(&bar[XB_TOPGEN], 1u);
            else XB_SPIN(xb_ld(&bar[XB_TOPGEN]) == tg, bar);
            __builtin_amdgcn_fence(__ATOMIC_ACQUIRE, "agent");
            xb_add(&bar[XB_XGEN(b.x)], 1u);
            asm volatile("s_waitcnt vmcnt(0)" ::: "memory");
        } else {
            XB_SPIN(xb_ld(&bar[XB_XGEN(b.x)]) == gen, bar);
            __builtin_amdgcn_fence(__ATOMIC_ACQUIRE, "agent");
            asm volatile("s_waitcnt vmcnt(0)" ::: "memory");
        }
    }
    __syncthreads();
}

struct Args { const float* in[27]; float* out; unsigned char* ws; int ph_lo, ph_hi; };

__device__ __forceinline__ int map_row(int mode, int row_off, int n) {
    if (mode == 0) return row_off + n;
    if (mode == 1) return (n >> 7) * 256 + row_off + (n & 127);
    if (mode == 2) { if (n >= C_KPE && n < C_KPE + 64) { const int j = n - C_KPE; return C_KPE + (j < 32 ? 2 * j : 2 * (j - 32) + 1); } return n; }
    { const int h = n / 192, d = n % 192; if (d < 128) return n; const int j = d - 128; return h * 192 + 128 + (j < 32 ? 2 * j : 2 * (j - 32) + 1); }
}
__device__ __forceinline__ void transpose_item(const float* W, int K, int N, bf16_t* WT, int mode, int row_off, LAS float* scr, int item, int lane) {
    const int nblk = N / 32, kb = item / nblk, nb = item % nblk, k0 = 64 * kb, n0 = 32 * nb;
    float wv[32];
#pragma unroll
    for (int i = 0; i < 32; ++i) { const int kk = 2 * i + (lane >> 5); wv[i] = W[(size_t)(k0 + kk) * N + n0 + (lane & 31)]; }
#pragma unroll
    for (int i = 0; i < 32; ++i) { const int kk = 2 * i + (lane >> 5); scr[kk * 33 + (lane & 31)] = wv[i]; }
    asm volatile("s_waitcnt lgkmcnt(0)" ::: "memory");
    const int c = lane & 7;
#pragma unroll
    for (int j = 0; j < 4; ++j) { const int n = (lane >> 3) + 8 * j; const LAS float* s = scr + (8 * c) * 33 + n;
        u32x4 o; o.x = cvt_pk_bf16(s[0 * 33], s[1 * 33]); o.y = cvt_pk_bf16(s[2 * 33], s[3 * 33]); o.z = cvt_pk_bf16(s[4 * 33], s[5 * 33]); o.w = cvt_pk_bf16(s[6 * 33], s[7 * 33]);
        *(u32x4*)(WT + (size_t)map_row(mode, row_off, n0 + n) * K + k0 + 8 * c) = o; }
    asm volatile("s_waitcnt lgkmcnt(0)" ::: "memory");
}

__device__ __forceinline__ void rms_row2_bf16(const float* xrow0, const float* xrow1, const float* g, bf16_t* orow0, bf16_t* orow1, int lane) {
    const f32x4* xr0 = (const f32x4*)xrow0 + lane; const f32x4* xr1 = (const f32x4*)xrow1 + lane; const f32x4* gr = (const f32x4*)g + lane;
    f32x4 v0[8], v1[8]; float s0 = 0.f, s1 = 0.f;
#pragma unroll
    for (int j = 0; j < 8; ++j) { v0[j] = xr0[64 * j]; v1[j] = xr1[64 * j]; }
#pragma unroll
    for (int j = 0; j < 8; ++j) { s0 += (v0[j].x * v0[j].x + v0[j].y * v0[j].y) + (v0[j].z * v0[j].z + v0[j].w * v0[j].w); s1 += (v1[j].x * v1[j].x + v1[j].y * v1[j].y) + (v1[j].z * v1[j].z + v1[j].w * v1[j].w); }
    const float r0 = rsqrtf(wave_sum(s0) * (1.f / DM) + RMS_EPS), r1 = rsqrtf(wave_sum(s1) * (1.f / DM) + RMS_EPS);
    u32x2* o0 = (u32x2*)orow0 + lane; u32x2* o1 = (u32x2*)orow1 + lane;
#pragma unroll
    for (int j = 0; j < 8; ++j) { const f32x4 gg = gr[64 * j]; u32x2 w;
        w.x = cvt_pk_bf16(v0[j].x * r0 * gg.x, v0[j].y * r0 * gg.y); w.y = cvt_pk_bf16(v0[j].z * r0 * gg.z, v0[j].w * r0 * gg.w); o0[64 * j] = w;
        w.x = cvt_pk_bf16(v1[j].x * r1 * gg.x, v1[j].y * r1 * gg.y); w.y = cvt_pk_bf16(v1[j].z * r1 * gg.z, v1[j].w * r1 * gg.w); o1[64 * j] = w; }
}
__device__ __forceinline__ void rms_row2_f32_inplace(float* xrow0, float* xrow1, const float* g, int lane) {
    f32x4* xr0 = (f32x4*)xrow0 + lane; f32x4* xr1 = (f32x4*)xrow1 + lane; const f32x4* gr = (const f32x4*)g + lane;
    f32x4 v0[8], v1[8]; float s0 = 0.f, s1 = 0.f;
#pragma unroll
    for (int j = 0; j < 8; ++j) { v0[j] = xr0[64 * j]; v1[j] = xr1[64 * j]; }
#pragma unroll
    for (int j = 0; j < 8; ++j) { s0 += (v0[j].x * v0[j].x + v0[j].y * v0[j].y) + (v0[j].z * v0[j].z + v0[j].w * v0[j].w); s1 += (v1[j].x * v1[j].x + v1[j].y * v1[j].y) + (v1[j].z * v1[j].z + v1[j].w * v1[j].w); }
    const float r0 = rsqrtf(wave_sum(s0) * (1.f / DM) + RMS_EPS), r1 = rsqrtf(wave_sum(s1) * (1.f / DM) + RMS_EPS);
#pragma unroll
    for (int j = 0; j < 8; ++j) { const f32x4 gg = gr[64 * j]; xr0[64 * j] = v0[j] * r0 * gg; xr1[64 * j] = v1[j] * r1 * gg; }
}

__device__ __forceinline__ void phase_prologue(const Args& a, LAS unsigned char* lds, int wv_) { LAUNDER_IDS;
    const int tid = tidx_, lane = tid & 63, wave = tid >> 6;
    unsigned char* ws = a.ws;
    LAS float* scr = (LAS float*)(lds + wave * 16384);
    const int gw = bidx_ * 8 + wave, NGW = gridDim.x * 8;
    constexpr int I_GU = (DM / 64) * (DFF / 32), I_D = (DFF / 64) * (DM / 32), I_IN = (DM / 64) * (NIN / 32), I_UQ = (512 / 64) * (NQ / 32), I_UKV = (512 / 64) * (NKV / 32),
                  I_SQ = (DM / 64) * (DM / 32), I_G = 64 * 8;
    constexpr int NITEMS = 4 * I_GU + 2 * I_D + I_IN + I_UQ + I_UKV + 3 * I_SQ + I_G;
    for (int it = gw; it < NITEMS; it += NGW) {
        int r = it;
        if (r < I_GU) { transpose_item(a.in[3], DM, DFF, (bf16_t*)(ws + WS_W1GU), 1, 0, scr, r, lane); continue; } r -= I_GU;
        if (r < I_GU) { transpose_item(a.in[4], DM, DFF, (bf16_t*)(ws + WS_W1GU), 1, 128, scr, r, lane); continue; } r -= I_GU;
        if (r < I_GU) { transpose_item(a.in[23], DM, DFF, (bf16_t*)(ws + WS_W2GU), 1, 0, scr, r, lane); continue; } r -= I_GU;
        if (r < I_GU) { transpose_item(a.in[24], DM, DFF, (bf16_t*)(ws + WS_W2GU), 1, 128, scr, r, lane); continue; } r -= I_GU;
        if (r < I_D) { transpose_item(a.in[5], DFF, DM, (bf16_t*)(ws + WS_W1D), 0, 0, scr, r, lane); continue; } r -= I_D;
        if (r < I_D) { transpose_item(a.in[25], DFF, DM, (bf16_t*)(ws + WS_W2D), 0, 0, scr, r, lane); continue; } r -= I_D;
        if (r < I_IN) { transpose_item(a.in[7], DM, NIN, (bf16_t*)(ws + WS_WIN), 2, 0, scr, r, lane); continue; } r -= I_IN;
        if (r < I_UQ) { transpose_item(a.in[9], 512, NQ, (bf16_t*)(ws + WS_WUQ), 3, 0, scr, r, lane); continue; } r -= I_UQ;
        if (r < I_UKV) { transpose_item(a.in[11], 512, NKV, (bf16_t*)(ws + WS_WUKV), 0, 0, scr, r, lane); continue; } r -= I_UKV;
        if (r < I_SQ) { transpose_item(a.in[12], DM, DM, (bf16_t*)(ws + WS_WOA), 0, 0, scr, r, lane); continue; } r -= I_SQ;
        if (r < I_SQ) { transpose_item(a.in[20], DM, DM, (bf16_t*)(ws + WS_WOR), 0, 0, scr, r, lane); continue; } r -= I_SQ;
        if (r < I_SQ) { transpose_item(a.in[21], DM, DM, (bf16_t*)(ws + WS_WOUT), 0, 0, scr, r, lane); continue; } r -= I_SQ;
        { const int mat = r >> 3, sub = r & 7, type = mat & 1, db = mat >> 1;
          transpose_item((type ? a.in[17] : a.in[15]) + (size_t)db * 128 * 128, 128, 128, (bf16_t*)(ws + WS_WG), 0, mat * 128, scr, sub, lane); }
    }
    { const int gt = bidx_ * 512 + tid, NT = gridDim.x * 512; u32x4* p = (u32x4*)((bf16_t*)(ws + WS_WIN) + (size_t)NIN * DM);
      for (int i = gt; i < (NINP - NIN) * DM / 8; i += NT) p[i] = (u32x4){0u, 0u, 0u, 0u}; }
    { const int gt = bidx_ * 512 + tid, NT = gridDim.x * 512; float* cosT = (float*)(ws + WS_COS); float* sinT = (float*)(ws + WS_SIN); float* c8 = (float*)(ws + WS_C8);
      for (int i = gt; i < SEQ * 32; i += NT) { const int pos = i >> 5, j = i & 31; const float inv = powf(10000.0f, -(float)(2 * j) / 64.0f); const float ang = (float)pos * inv; cosT[i] = cosf(ang); sinT[i] = sinf(ang); }
      for (int i = gt; i < 2 * DM; i += NT) { const float l = a.in[19][i]; const float sp = (-l > 20.f) ? -l : log1pf(expf(-l)); c8[i] = 8.0f * sp; } }
    for (int m = 2 * gw; m < MTOT; m += 2 * NGW) { const float* xr = m < SEQ ? a.in[0] + (size_t)m * DM : a.in[1] + (size_t)(m - SEQ) * DM;
        rms_row2_bf16(xr, xr + DM, a.in[2], (bf16_t*)(ws + WS_H) + (size_t)m * DM, (bf16_t*)(ws + WS_H) + (size_t)(m + 1) * DM, lane); }
}

__device__ __forceinline__ void phase_norm(const Args& a, const float* g, int wv_) { LAUNDER_IDS;
    const int lane = tidx_ & 63, gw = bidx_ * 8 + (tidx_ >> 6), NGW = gridDim.x * 8;
    for (int m = 2 * gw; m < MTOT; m += 2 * NGW) rms_row2_bf16(a.out + (size_t)m * DM, a.out + (size_t)(m + 1) * DM, g, (bf16_t*)(a.ws + WS_H) + (size_t)m * DM, (bf16_t*)(a.ws + WS_H) + (size_t)(m + 1) * DM, lane);
}
__device__ __forceinline__ void phase_final_norm(const Args& a, int wv_) { LAUNDER_IDS;
    const int lane = tidx_ & 63, gw = bidx_ * 8 + (tidx_ >> 6), NGW = gridDim.x * 8;
    for (int m = 2 * gw; m < MTOT; m += 2 * NGW) rms_row2_f32_inplace(a.out + (size_t)m * DM, a.out + (size_t)(m + 1) * DM, a.in[26], lane);
}

__device__ __forceinline__ void phase_small(const Args& a, int wv_) { LAUNDER_IDS;
    unsigned char* ws = a.ws; const int tid = tidx_, lane = tid & 63, gw = bidx_ * 8 + (tid >> 6), NGW = gridDim.x * 8;
    const bf16_t* proj = (const bf16_t*)(ws + WS_PROJ);
    for (int row = gw; row < SEQ; row += NGW) {
        const u32x4 wq = *(const u32x4*)(proj + (size_t)row * NINP + C_CQ + lane * 8), wk = *(const u32x4*)(proj + (size_t)row * NINP + C_CKV + lane * 8);
        const unsigned pw = *(const unsigned*)(proj + (size_t)row * NINP + C_KPE + 2 * (lane & 31));
        const f32x4 gq0 = *(const f32x4*)(a.in[8] + lane * 8), gq1 = *(const f32x4*)(a.in[8] + lane * 8 + 4), gk0 = *(const f32x4*)(a.in[10] + lane * 8), gk1 = *(const f32x4*)(a.in[10] + lane * 8 + 4);
        const float c = ((const float*)(ws + WS_COS))[row * 32 + (lane & 31)], sn = ((const float*)(ws + WS_SIN))[row * 32 + (lane & 31)];
        float vq[8] = {bf2f(wq.x & 0xffffu), bf2f(wq.x >> 16), bf2f(wq.y & 0xffffu), bf2f(wq.y >> 16), bf2f(wq.z & 0xffffu), bf2f(wq.z >> 16), bf2f(wq.w & 0xffffu), bf2f(wq.w >> 16)};
        float vk[8] = {bf2f(wk.x & 0xffffu), bf2f(wk.x >> 16), bf2f(wk.y & 0xffffu), bf2f(wk.y >> 16), bf2f(wk.z & 0xffffu), bf2f(wk.z >> 16), bf2f(wk.w & 0xffffu), bf2f(wk.w >> 16)};
        float sq = 0.f, sk = 0.f;
#pragma unroll
        for (int j = 0; j < 8; ++j) { sq += vq[j] * vq[j]; sk += vk[j] * vk[j]; }
        const float rq = rsqrtf(wave_sum(sq) * (1.f / 512.f) + RMS_EPS), rk = rsqrtf(wave_sum(sk) * (1.f / 512.f) + RMS_EPS);
        u32x4 oq, ok;
        oq.x = cvt_pk_bf16(vq[0] * rq * gq0.x, vq[1] * rq * gq0.y); oq.y = cvt_pk_bf16(vq[2] * rq * gq0.z, vq[3] * rq * gq0.w); oq.z = cvt_pk_bf16(vq[4] * rq * gq1.x, vq[5] * rq * gq1.y); oq.w = cvt_pk_bf16(vq[6] * rq * gq1.z, vq[7] * rq * gq1.w);
        ok.x = cvt_pk_bf16(vk[0] * rk * gk0.x, vk[1] * rk * gk0.y); ok.y = cvt_pk_bf16(vk[2] * rk * gk0.z, vk[3] * rk * gk0.w); ok.z = cvt_pk_bf16(vk[4] * rk * gk1.x, vk[5] * rk * gk1.y); ok.w = cvt_pk_bf16(vk[6] * rk * gk1.z, vk[7] * rk * gk1.w);
        *(u32x4*)((bf16_t*)(ws + WS_CQN) + (size_t)row * 512 + lane * 8) = oq; *(u32x4*)((bf16_t*)(ws + WS_CKVN) + (size_t)row * 512 + lane * 8) = ok;
        if (lane < 32) { const float x1 = bf2f(pw & 0xffffu), x2 = bf2f(pw >> 16); *(unsigned*)((bf16_t*)(ws + WS_KPE) + (size_t)row * 64 + 2 * lane) = cvt_pk_bf16(x1 * c - x2 * sn, x2 * c + x1 * sn); }
    }
    const int gt = bidx_ * 512 + tid, NT = gridDim.x * 512; bf16_t* xc = (bf16_t*)(ws + WS_XC);
    for (int i = gt; i < (SEQ / 4) * (DM / 8); i += NT) {
        const int r0 = (i >> 8) * 4, c0 = (i & 255) * 8;
        u32x4 xr[7];
#pragma unroll
        for (int k = 0; k < 7; ++k) { const int t = r0 + k - 2; xr[k] = (t >= 0 && t < SEQ) ? *(const u32x4*)(proj + (size_t)t * NINP + C_XREC + c0) : (u32x4){0u, 0u, 0u, 0u}; }
        f32x4 wlo[4], whi[4];
#pragma unroll
        for (int k = 0; k < 4; ++k) { wlo[k] = *(const f32x4*)(a.in[13] + k * DM + c0); whi[k] = *(const f32x4*)(a.in[13] + k * DM + c0 + 4); }
        const f32x4 b0 = *(const f32x4*)(a.in[14] + c0), b1 = *(const f32x4*)(a.in[14] + c0 + 4);
#pragma unroll
        for (int r = 0; r < 4; ++r) { f32x4 lo = b0, hi = b1;
#pragma unroll
            for (int k = 0; k < 4; ++k) { const u32x4 w = xr[r + k];
                lo += (f32x4){bf2f(w.x & 0xffffu), bf2f(w.x >> 16), bf2f(w.y & 0xffffu), bf2f(w.y >> 16)} * wlo[k]; hi += (f32x4){bf2f(w.z & 0xffffu), bf2f(w.z >> 16), bf2f(w.w & 0xffffu), bf2f(w.w >> 16)} * whi[k]; }
            u32x4 o; o.x = cvt_pk_bf16(lo[0], lo[1]); o.y = cvt_pk_bf16(lo[2], lo[3]); o.z = cvt_pk_bf16(hi[0], hi[1]); o.w = cvt_pk_bf16(hi[2], hi[3]);
            *(u32x4*)(xc + (size_t)(r0 + r) * DM + c0) = o; }
    }
}

__device__ __forceinline__ void phase_scan1(const Args& a, int wv_) { LAUNDER_IDS;
    unsigned char* ws = a.ws; const int tid = tidx_;
    for (int it = bidx_; it < 1024; it += gridDim.x) {
        const int half = it & 1, dir = (it >> 1) & 1, c = it >> 2, ch = half * 1024 + tid * 2;
        const bf16_t* A = (const bf16_t*)(ws + (dir ? WS_AB : WS_AF)) + ch; const bf16_t* U = (const bf16_t*)(ws + (dir ? WS_UB : WS_UF)) + ch;
        f32x2 P = {1.f, 1.f}, Hh = {0.f, 0.f};
        unsigned awv[32], uwv[32];
#pragma unroll
        for (int i = 0; i < 32; ++i) { const int t = dir ? (c * 32 + 31 - i) : (c * 32 + i); awv[i] = *(const unsigned*)(A + (size_t)t * DM); uwv[i] = *(const unsigned*)(U + (size_t)t * DM); }
#pragma unroll
        for (int i = 0; i < 32; ++i) { const unsigned aw = awv[i], uw = uwv[i];
            const f32x2 av = {1.0f - bf2f(aw & 0xffffu), 1.0f - bf2f(aw >> 16)}, uv = {bf2f(uw & 0xffffu), bf2f(uw >> 16)}; Hh = av * Hh + uv; P = P * av; }
        *(f32x2*)((float*)(ws + WS_AGGA) + (size_t)(dir * 256 + c) * DM + ch) = P; *(f32x2*)((float*)(ws + WS_AGGB) + (size_t)(dir * 256 + c) * DM + ch) = Hh;
    }
}
__device__ __forceinline__ void phase_scan15(const Args& a, LAS unsigned char* lds, int wv_) { LAUNDER_IDS;
    if (bidx_ >= 32) return;
    unsigned char* ws = a.ws; const int tid = tidx_, seg = tid >> 6, cpl = tid & 63, idx = bidx_ * 64 + cpl, dir = idx >> 10, ch = (idx & 1023) * 2;
    const float* GA = (const float*)(ws + WS_AGGA) + (size_t)dir * 256 * DM + ch; const float* GB = (const float*)(ws + WS_AGGB) + (size_t)dir * 256 * DM + ch; float* CR = (float*)(ws + WS_CARRY) + (size_t)dir * 256 * DM + ch;
    LAS f32x4* seg_agg = (LAS f32x4*)lds;
    f32x2 A = {1.f, 1.f}, B = {0.f, 0.f};
#pragma unroll 8
    for (int i = 0; i < 32; ++i) { const int c = dir ? 255 - (seg * 32 + i) : seg * 32 + i; const f32x2 av = *(const f32x2*)(GA + (size_t)c * DM), bv = *(const f32x2*)(GB + (size_t)c * DM); B = av * B + bv; A = A * av; }
    seg_agg[seg * 64 + cpl] = (f32x4){A.x, A.y, B.x, B.y};
    __syncthreads();
    f32x2 carry = {0.f, 0.f};
    for (int k = 0; k < seg; ++k) { const f32x4 g = seg_agg[k * 64 + cpl]; carry = (f32x2){g.x, g.y} * carry + (f32x2){g.z, g.w}; }
    __syncthreads();
#pragma unroll 8
    for (int i = 0; i < 32; ++i) { const int c = dir ? 255 - (seg * 32 + i) : seg * 32 + i; *(f32x2*)(CR + (size_t)c * DM) = carry; const f32x2 av = *(const f32x2*)(GA + (size_t)c * DM), bv = *(const f32x2*)(GB + (size_t)c * DM); carry = av * carry + bv; }
}
__device__ __forceinline__ void phase_scan2(const Args& a, int wv_) { LAUNDER_IDS;
    unsigned char* ws = a.ws; const int tid = tidx_;
    const bf16_t* proj = (const bf16_t*)(ws + WS_PROJ); bf16_t* yg = (bf16_t*)(ws + WS_YG);
    for (int it = bidx_; it < 512; it += gridDim.x) {
        const int half = it & 1, c = it >> 1, ch = half * 1024 + tid * 2;
        const bf16_t* AF = (const bf16_t*)(ws + WS_AF) + ch; const bf16_t* UF = (const bf16_t*)(ws + WS_UF) + ch; const bf16_t* AB = (const bf16_t*)(ws + WS_AB) + ch; const bf16_t* UB = (const bf16_t*)(ws + WS_UB) + ch;
        f32x2 hf[32]; f32x2 h = *(const f32x2*)((const float*)(ws + WS_CARRY) + (size_t)c * DM + ch);
        { unsigned awv[32], uwv[32];
#pragma unroll
          for (int i = 0; i < 32; ++i) { const int t = c * 32 + i; awv[i] = *(const unsigned*)(AF + (size_t)t * DM); uwv[i] = *(const unsigned*)(UF + (size_t)t * DM); }
#pragma unroll
          for (int i = 0; i < 32; ++i) { const unsigned aw = awv[i], uw = uwv[i];
            const f32x2 av = {1.0f - bf2f(aw & 0xffffu), 1.0f - bf2f(aw >> 16)}, uv = {bf2f(uw & 0xffffu), bf2f(uw >> 16)}; h = av * h + uv; hf[i] = h; } }
        h = *(const f32x2*)((const float*)(ws + WS_CARRY) + (size_t)(256 + c) * DM + ch);
        { unsigned awv[32], uwv[32], gwv[32];
#pragma unroll
          for (int i = 0; i < 32; ++i) { const int t = c * 32 + i; awv[i] = *(const unsigned*)(AB + (size_t)t * DM); uwv[i] = *(const unsigned*)(UB + (size_t)t * DM); gwv[i] = *(const unsigned*)(proj + (size_t)t * NINP + C_GREC + ch); }
#pragma unroll
          for (int i = 31; i >= 0; --i) { const int t = c * 32 + i; const unsigned aw = awv[i], uw = uwv[i], gw = gwv[i];
            const f32x2 av = {1.0f - bf2f(aw & 0xffffu), 1.0f - bf2f(aw >> 16)}, uv = {bf2f(uw & 0xffffu), bf2f(uw >> 16)}; h = av * h + uv;
            const f32x2 hs = hf[i] + h;
            *(unsigned*)(yg + (size_t)t * DM + ch) = cvt_pk_bf16(gelu_tanh(bf2f(gw & 0xffffu)) * hs.x, gelu_tanh(bf2f(gw >> 16)) * hs.y); } }
    }
}

__device__ __forceinline__ void phase_attention(const Args& a, char* lds, int wv_) { LAUNDER_IDS;
    unsigned char* ws = a.ws; const int G = gridDim.x, bx = bidx_; const int vcu = (G % 8 == 0) ? (bx % 8) * (G / 8) + bx / 8 : bx;
    const bf16_t* Q = (const bf16_t*)(ws + WS_Q); const bf16_t* KV = (const bf16_t*)(ws + WS_KV); const bf16_t* KPE = (const bf16_t*)(ws + WS_KPE); bf16_t* O = (bf16_t*)(ws + WS_ATTO);
    for (int u = vcu; u < 512; u += G) { const int h = u >> 5, qb = u & 31;
        att::attn_unit(Q + (size_t)qb * 256 * NQ + h * 192, KV + h * 256, KV + h * 256 + 128, KPE, O + (size_t)qb * 256 * DM + h * 128, SEQ, lds, wv_); }
}

__device__ __forceinline__ void phase_ffn_up(const Args& a, LAS unsigned char* lds, int which, int wv_) {
    pg8::Gemm g{(const bf16_t*)(a.ws + WS_H), (const bf16_t*)(a.ws + (which ? WS_W2GU : WS_W1GU))};
    pg8::EpiSwiglu E{(bf16_t*)(a.ws + WS_ACT), DFF};
    pg8::gemm_phase<pg8::EpiSwiglu, MTOT, 2 * DFF, DM, DM, 0, 0>(lds, g, E, wv_);
}
__device__ __forceinline__ void phase_ffn_down(const Args& a, LAS unsigned char* lds, int which, int wv_) {
    pg8::Gemm g{(const bf16_t*)(a.ws + WS_ACT), (const bf16_t*)(a.ws + (which ? WS_W2D : WS_W1D))};
    pg8::EpiResid E{which ? a.out : a.in[0], which ? a.out : a.in[1], which ? MTOT : SEQ, a.out, 0.5f, 0};
    pg8::gemm_phase<pg8::EpiResid, MTOT, DM, DFF, DFF, 0, 0>(lds, g, E, wv_);
}
__device__ __forceinline__ void phase_wout(const Args& a, LAS unsigned char* lds, int s, int wv_) {
    pg8::Gemm g{(const bf16_t*)(a.ws + WS_H), (const bf16_t*)(a.ws + WS_WOUT)};
    pg8::EpiResid E{a.out, a.out, MTOT, a.out, 1.0f, 0};
    pg8::gemm_phase<pg8::EpiResid, MTOT, DM, DM, DM, 0, 0>(lds, g, E, wv_);
}
__device__ __forceinline__ void phase_win(const Args& a, LAS unsigned char* lds, int s, int wv_) {
    pg8::Gemm g{(const bf16_t*)(a.ws + WS_H) + (size_t)s * SEQ * DM, (const bf16_t*)(a.ws + WS_WIN)}; pg8::EpiBf16 E{(bf16_t*)(a.ws + WS_PROJ), NINP};
    pg8::gemm_phase<pg8::EpiBf16, SEQ, NINP, DM, DM, 0, 0>(lds, g, E, wv_);
}
__device__ __forceinline__ void phase_kv(const Args& a, LAS unsigned char* lds, int wv_) {
    pg8::Gemm g{(const bf16_t*)(a.ws + WS_CKVN), (const bf16_t*)(a.ws + WS_WUKV)}; pg8::EpiBf16 E{(bf16_t*)(a.ws + WS_KV), NKV};
    pg8::gemm_phase<pg8::EpiBf16, SEQ, NKV, 512, 512, 0, 0>(lds, g, E, wv_);
}

__device__ __forceinline__ void run_phase(const Args& a, int ph, unsigned char* lds_g, int wv_) {
    LAS unsigned char* lds = (LAS unsigned char*)lds_g; unsigned char* ws = a.ws;
    if (ph == 0) { if (PHM(0)) phase_prologue(a, lds, wv_); return; }
    if (ph == 1 || ph == 41) { if (PHM(1)) phase_ffn_up(a, lds, ph == 41, wv_); return; }
    if (ph == 2 || ph == 42) { if (PHM(2)) phase_ffn_down(a, lds, ph == 42, wv_); return; }
    if (ph == 3) { if (PHM(3)) phase_norm(a, a.in[6], wv_); return; }
    if (ph == 40) { if (PHM(3)) phase_norm(a, a.in[22], wv_); return; }
    if (ph == 39) { if (PHM(16)) phase_wout(a, lds, 0, wv_); return; }
    if (ph == 43) { if (PHM(4)) phase_final_norm(a, wv_); return; }
    const int s = (ph - 4) / 7, sub = (ph - 4) % 7;
    switch (sub) {
    case 0: if (PHM(5)) phase_win(a, lds, s, wv_); break;
    case 1: if (PHM(6)) phase_small(a, wv_); break;
    case 2: {
        if (PHM(7)) { pg8::Gemm g{(const bf16_t*)(ws + WS_CQN), (const bf16_t*)(ws + WS_WUQ)}; pg8::EpiQ E{(bf16_t*)(ws + WS_Q), (const float*)(ws + WS_COS), (const float*)(ws + WS_SIN)};
          pg8::gemm_phase<pg8::EpiQ, SEQ, NQ, 512, 512, 0, 0>(lds, g, E, wv_); }
        if (PHM(15)) phase_kv(a, lds, wv_);
        if (PHM(8)) { pg8::Gemm g{(const bf16_t*)(ws + WS_XC), (const bf16_t*)(ws + WS_WG)};
          pg8::EpiGates E{(const bf16_t*)(ws + WS_XC), a.in[16], a.in[18], (const float*)(ws + WS_C8), (bf16_t*)(ws + WS_AF), (bf16_t*)(ws + WS_UF), (size_t)(WS_AB - WS_AF) / 2};
          pg8::gemm_phase<pg8::EpiGates, SEQ, 8192, 128, DM, 16, 128>(lds, g, E, wv_); }
        break; }
    case 3: if (PHM(9)) phase_attention(a, (char*)lds_g, wv_); if (PHM(10)) phase_scan1(a, wv_); break;
    case 4: {
        if (PHM(11)) phase_scan15(a, lds, wv_);
        if (PHM(12)) { pg8::Gemm g{(const bf16_t*)(ws + WS_ATTO), (const bf16_t*)(ws + WS_WOA)}; pg8::EpiT1 E{(const bf16_t*)(ws + WS_PROJ) + C_GA, NINP, (bf16_t*)(ws + WS_T1)};
        pg8::gemm_phase<pg8::EpiT1, SEQ, DM, DM, DM, 0, 0>(lds, g, E, wv_); } break; }
    case 5: if (PHM(13)) phase_scan2(a, wv_); break;
    case 6: {
        if (PHM(14)) { pg8::Gemm g{(const bf16_t*)(ws + WS_YG), (const bf16_t*)(ws + WS_WOR)}; pg8::EpiMerge E{(const bf16_t*)(ws + WS_PROJ) + C_GR, NINP, (const bf16_t*)(ws + WS_T1), (bf16_t*)(ws + WS_H) + (size_t)s * SEQ * DM};
        pg8::gemm_phase<pg8::EpiMerge, SEQ, DM, DM, DM, 0, 0>(lds, g, E, wv_); } break; }
    default: break;
    }
}

__global__ void __launch_bounds__(512, 2) mega(Args a) {
    extern __shared__ __attribute__((aligned(16))) unsigned char lds[];
    cg::grid_group grid = cg::this_grid();
    const int wv_ = __builtin_amdgcn_readfirstlane(threadIdx.x >> 6);
    volatile LAS unsigned* misc = (volatile LAS unsigned*)((LAS unsigned char*)lds + (LDS_BYTES - 64));
    if (threadIdx.x < 2) misc[threadIdx.x] = 0u;
    __syncthreads();
    XcdBarrier bar = xcd_barrier_post((unsigned*)(a.ws + WS_CTL), misc);
    for (int ph = a.ph_lo; ph < a.ph_hi; ++ph) {
#ifdef PROBE_REPEAT
        if (PROBE_REPEAT(ph)) { run_phase(a, ph, lds, wv_); xcd_barrier(bar); }
#endif
        run_phase(a, ph, lds, wv_);
        if (ph + 1 < a.ph_hi) { if (ph == a.ph_lo) grid.sync(); else xcd_barrier(bar); }
    }
}

extern "C" void kernel_launch(void* const* d_in, const int* in_sizes, int n_in, void* d_out, int out_size, void* d_ws, size_t ws_size, hipStream_t stream) {
    static int grid = 0;
    if (grid == 0) {
        if (n_in != 27 || out_size != MTOT * DM || ws_size < WS_END) { fprintf(stderr, "kernel_launch: unexpected shapes: n_in %d out %d ws %zu (need %zu)\n", n_in, out_size, ws_size, (size_t)WS_END); grid = -1; return; }
        int dev = 0, cus = 0, per_cu = 0;
        (void)hipGetDevice(&dev); (void)hipDeviceGetAttribute(&cus, hipDeviceAttributeMultiprocessorCount, dev);
        if (hipFuncSetAttribute((const void*)mega, hipFuncAttributeMaxDynamicSharedMemorySize, LDS_BYTES) != hipSuccess) { fprintf(stderr, "kernel_launch: hipFuncSetAttribute failed\n"); grid = -1; return; }
        (void)hipOccupancyMaxActiveBlocksPerMultiprocessor(&per_cu, (const void*)mega, 512, LDS_BYTES);
        if (per_cu < 1) { fprintf(stderr, "kernel_launch: occupancy query says %d blocks/CU\n", per_cu); per_cu = 1; }
        (void)hipGetLastError();
        grid = cus;
    }
    if (grid < 0) return;
    if (hipMemsetAsync((char*)d_ws + WS_CTL, 0, CTL_BYTES, stream) != hipSuccess) { fprintf(stderr, "kernel_launch: hipMemsetAsync failed\n"); return; }
    Args a{};
    for (int i = 0; i < 27; ++i) a.in[i] = (const float*)d_in[i];
    a.out = (float*)d_out; a.ws = (unsigned char*)d_ws;
#if MK_ONE_LAUNCH
    a.ph_lo = 0; a.ph_hi = NPH;
    { void* args[] = {&a}; hipError_t e = hipLaunchCooperativeKernel((const void*)mega, dim3(grid), dim3(512), args, LDS_BYTES, stream);
      if (e != hipSuccess) fprintf(stderr, "cooperative launch failed: %s (grid %d)\n", hipGetErrorString(e), grid); }
#else
    for (int ph = 0; ph < NPH; ++ph) {
        a.ph_lo = ph; a.ph_hi = ph + 1;
        void* args[] = {&a}; hipError_t e = hipLaunchCooperativeKernel((const void*)mega, dim3(grid), dim3(512), args, LDS_BYTES, stream);
        if (e != hipSuccess) { fprintf(stderr, "cooperative launch %d failed: %s (grid %d)\n", ph, hipGetErrorString(e), grid); break; }
    }
#endif
}
```

```cpp
#include <hip/hip_runtime.h>
#include <hip/hip_cooperative_groups.h>
#include <cstdio>
#include <cstdint>
namespace cg = cooperative_groups;

#ifndef MK_ONE_LAUNCH
#define MK_ONE_LAUNCH 1
#endif
#ifndef PH_MASK
#define PH_MASK 0xffffffffu
#endif
#define PHM(k) (((PH_MASK) >> (k)) & 1u)
#define LANE_ID_ASM(l) asm volatile("v_mbcnt_lo_u32_b32 %0, -1, 0\n\tv_mbcnt_hi_u32_b32 %0, -1, %0" : "=v"(l))
#define LAUNDER_IDS int tidx_; LANE_ID_ASM(tidx_); tidx_ += wv_ * 64; int bidx_ = blockIdx.x; asm volatile("" : "+s"(bidx_))

#define LAS __attribute__((address_space(3)))
typedef unsigned short bf16_t;
typedef short bf16x8 __attribute__((ext_vector_type(8)));
typedef short s16x4 __attribute__((ext_vector_type(4)));
typedef float f32x4 __attribute__((ext_vector_type(4)));
typedef float f32x2 __attribute__((ext_vector_type(2)));
typedef float f32x16 __attribute__((ext_vector_type(16)));
typedef unsigned u32x4 __attribute__((ext_vector_type(4)));
typedef unsigned u32x2 __attribute__((ext_vector_type(2)));

constexpr int DM = 2048, SEQ = 8192, NSEQ = 5, MTOT = NSEQ * SEQ, DFF = 5632;
constexpr int NIN = 9280, NINP = 9472;
constexpr int NQ = 3072, NKV = 4096;
constexpr int C_CQ = 0, C_CKV = 512, C_KPE = 1024, C_XREC = 1088, C_GREC = 3136, C_GA = 5184, C_GR = 7232;
constexpr float RMS_EPS = 1e-6f;
constexpr float QSCALE = 0.07216878364870322f * 1.4426950408889634f;

constexpr size_t MiB = 1u << 20;
constexpr size_t WS_COS = 0, WS_SIN = 1 * MiB, WS_C8 = 2 * MiB, WS_CTL = 3 * MiB, CTL_BYTES = 16384;
constexpr size_t WS_W1GU = 4 * MiB, WS_W1D = 48 * MiB, WS_W2GU = 70 * MiB, WS_W2D = 114 * MiB, WS_WIN = 136 * MiB, WS_WUQ = 173 * MiB,
                 WS_WUKV = 176 * MiB, WS_WOA = 180 * MiB, WS_WOR = 188 * MiB, WS_WOUT = 196 * MiB, WS_WG = 204 * MiB;
constexpr size_t WS_H = 206 * MiB, WS_ACT = 366 * MiB;
constexpr size_t WS_PROJ = 366 * MiB, WS_CQN = 514 * MiB, WS_CKVN = 522 * MiB, WS_KPE = 530 * MiB, WS_XC = 532 * MiB, WS_MERGED = 532 * MiB,
                 WS_Q = 564 * MiB, WS_KV = 612 * MiB, WS_T1 = 564 * MiB, WS_AF = 676 * MiB, WS_UF = 740 * MiB, WS_AB = 804 * MiB, WS_UB = 868 * MiB,
                 WS_ATTO = 932 * MiB, WS_YG = 964 * MiB, WS_AGGA = 996 * MiB, WS_AGGB = 1000 * MiB, WS_CARRY = 1004 * MiB, WS_END = 1008 * MiB;

constexpr int LDS_BYTES = 135168;
constexpr int NPH = 44;

__device__ __forceinline__ float bf2f(unsigned b) { return __uint_as_float(b << 16); }
__device__ __forceinline__ unsigned cvt_pk_bf16(float lo, float hi) { unsigned r; asm volatile("v_cvt_pk_bf16_f32 %0, %1, %2" : "=v"(r) : "v"(lo), "v"(hi)); return r; }
__device__ __forceinline__ float fsigmoid(float x) { return __builtin_amdgcn_rcpf(1.0f + __expf(-x)); }
__device__ __forceinline__ float wave_sum(float v) {
    v += __int_as_float(__builtin_amdgcn_ds_swizzle(__float_as_int(v), 0x041f));
    v += __int_as_float(__builtin_amdgcn_ds_swizzle(__float_as_int(v), 0x081f));
    v += __int_as_float(__builtin_amdgcn_ds_swizzle(__float_as_int(v), 0x101f));
    v += __int_as_float(__builtin_amdgcn_ds_swizzle(__float_as_int(v), 0x201f));
    v += __int_as_float(__builtin_amdgcn_ds_swizzle(__float_as_int(v), 0x401f));
    auto rr = __builtin_amdgcn_permlane32_swap(__float_as_uint(v), __float_as_uint(v), false, false);
    return __uint_as_float(rr[0]) + __uint_as_float(rr[1]);
}
__device__ __forceinline__ float gelu_tanh(float x) {
    const float z = 0.7978845608028654f * (x + 0.044715f * x * x * x);
    const float e = __expf(2.0f * z);
    const float t = 1.0f - 2.0f * __builtin_amdgcn_rcpf(1.0f + e);
    return 0.5f * x * (1.0f + t);
}

namespace pg8 {
constexpr int BM = 256, BK = 64, HALF = 128, HTB = HALF * BK * 2, STAGE_BYTES = 8 * HTB, NXCD = 8, WGM = 4;
__host__ __device__ __forceinline__ int lds_byte(int r, int c) { const int st = (r >> 4) * 2 + (c >> 5), rr = r & 15, cc = c & 31, ob = rr * 64 + cc * 2; return st * 1024 + (ob ^ (((ob >> 9) & 1) << 5)); }
__host__ __device__ __forceinline__ void stage_rc(int b, int& R, int& C) { const int st = b / 1024, sb = b % 1024, swz = sb ^ (((sb >> 9) & 1) << 5); R = (st >> 1) * 16 + swz / 64; C = (st & 1) * 32 + (swz % 64) / 2; }
__host__ __device__ __forceinline__ int perm32(int rho) { const int n = rho >> 4, i = rho & 15; return 8 * (i >> 2) + 4 * n + (i & 3); }

struct Unit { int pm, pn; };
struct Gemm { const bf16_t* A; const bf16_t* Bt; };

struct StaticOrder {
    int nM, nN, nwg, G, c;
    __device__ void init(int M, int N, int G_, int c_) { nM = M / BM; nN = N / BM; nwg = nM * nN; G = G_; c = c_; }
    __device__ bool next(int i, Unit& u) const {
        const long L = (long)i * G + c; if (L >= nwg) return false;
        int wgid = (int)L; { const int q = nwg / NXCD, r = nwg % NXCD, xcd = wgid % NXCD, off = wgid / NXCD; wgid = (xcd < r ? xcd * (q + 1) : r * (q + 1) + (xcd - r) * q) + off; }
        const int nig = WGM * nN, gid = wgid / nig, fm = gid * WGM, gsz = (nM - fm) < WGM ? (nM - fm) : WGM;
        u.pm = fm + ((wgid % nig) % gsz); u.pn = (wgid % nig) / gsz; return true;
    }
};

template <class Epi, int GM, int GN, int GK, int LDA, int AMOD, int ASTRIDE>
__device__ __forceinline__ void gemm_phase(LAS unsigned char* lds, const Gemm g, const Epi& E, int wv_) {
    int tid_; LANE_ID_ASM(tid_); tid_ += wv_ * 64; int bid_ = blockIdx.x; asm volatile("" : "+s"(bid_));
    const int tid = tid_, wid = __builtin_amdgcn_readfirstlane(tid >> 6), lane = tid & 63, wr = wid >> 2, wc = wid & 3, fr = lane & 15, fq = lane >> 4;
    constexpr int K = GK, lda = LDA; int nt = K / BK; asm volatile("" : "+s"(nt));
    StaticOrder S; S.init(GM, GN, (int)gridDim.x, bid_);
    unsigned voffA[2], voffB[2];
#pragma unroll
    for (int i = 0; i < 2; ++i) { int R, C; stage_rc(tid * 16 + i * 8192, R, C); const int Rb = Epi::PERM ? ((R & ~31) + perm32(R & 31)) : R;
        voffA[i] = (unsigned)(R * lda + C) * 2u; voffB[i] = (unsigned)(Rb * K + C) * 2u; }
    const size_t kstep = (size_t)(BK * 2);
    const size_t hstepA = (size_t)HALF * lda * 2, tstepA = 2 * hstepA;
    const size_t hstepB = (size_t)HALF * K * 2, tstepB = 2 * hstepB;
    const unsigned ldsw = (unsigned)wid * 1024u;
    const int aoff = lds_byte(wr * 64 + fr, fq * 8), boff = lds_byte(wc * 32 + fr, fq * 8);
#define PG8_SA(b, h) (((b) * 2 + (h)) * HTB)
#define PG8_SB(b, h) ((4 + (b) * 2 + (h)) * HTB)
#define PG8_STAGE(bufoff, gbase, voff) do { _Pragma("unroll") for (int _i = 0; _i < 2; ++_i) \
        __builtin_amdgcn_global_load_lds((const unsigned*)((const char*)(gbase) + (voff)[_i]), (LAS unsigned*)(lds + (bufoff) + ldsw + _i * 8192), 16, 0, 0); } while (0)
#define PG8_LDA(dst, b, h) do { _Pragma("unroll") for (int m = 0; m < 4; ++m) _Pragma("unroll") for (int k = 0; k < 2; ++k) dst[m][k] = *(const LAS bf16x8*)(lds + PG8_SA(b, h) + aoff + m * 2048 + k * 1024); } while (0)
#define PG8_LDB(dst, b, h) do { _Pragma("unroll") for (int n = 0; n < 2; ++n) _Pragma("unroll") for (int k = 0; k < 2; ++k) dst[n][k] = *(const LAS bf16x8*)(lds + PG8_SB(b, h) + boff + n * 2048 + k * 1024); } while (0)
#define PG8_MMA(ai, bj, At, Bt) do { __builtin_amdgcn_s_setprio(1); _Pragma("unroll") for (int m = 0; m < 4; ++m) _Pragma("unroll") for (int n = 0; n < 2; ++n) _Pragma("unroll") for (int k = 0; k < 2; ++k) \
        acc[ai][bj][m][n] = __builtin_amdgcn_mfma_f32_16x16x32_bf16(Bt[n][k], At[m][k], acc[ai][bj][m][n], 0, 0, 0); __builtin_amdgcn_s_setprio(0); } while (0)
#define PG8_WAIT_V(n) asm volatile("s_waitcnt vmcnt(" #n ")" ::: "memory")
#define PG8_WAIT_L(n) asm volatile("s_waitcnt lgkmcnt(" #n ")" ::: "memory")
#define PG8_BAR __builtin_amdgcn_s_barrier()
#define PG8_SCHED __builtin_amdgcn_sched_barrier(0)
#define PG8_AOFF(pn) (AMOD ? (size_t)((pn) % (AMOD ? AMOD : 1)) * (size_t)ASTRIDE * 2 : (size_t)0)
    Unit cur, nxt; int ui = 0;
    if (!S.next(0, cur)) return;
    f32x4 acc[2][2][4][2];
#pragma unroll
    for (int a = 0; a < 2; ++a)
#pragma unroll
        for (int b = 0; b < 2; ++b)
#pragma unroll
            for (int m = 0; m < 4; ++m)
#pragma unroll
                for (int n = 0; n < 2; ++n) acc[a][b][m][n] = (f32x4){0.f, 0.f, 0.f, 0.f};
    bf16x8 At[4][2], B0[2][2], B1[2][2];
    const char* cA = (const char*)g.A + (size_t)cur.pm * tstepA + PG8_AOFF(cur.pn); const char* cB = (const char*)g.Bt + (size_t)cur.pn * tstepB;
    PG8_STAGE(PG8_SB(0, 0), cB, voffB); PG8_STAGE(PG8_SB(0, 1), cB + hstepB, voffB); PG8_STAGE(PG8_SA(0, 0), cA, voffA); PG8_STAGE(PG8_SA(0, 1), cA + hstepA, voffA);
    if (wr == 1) PG8_BAR;
    PG8_WAIT_V(2); PG8_BAR;
    PG8_STAGE(PG8_SB(1, 0), cB + kstep, voffB); PG8_STAGE(PG8_SA(1, 0), cA + kstep, voffA); PG8_STAGE(PG8_SB(1, 1), cB + hstepB + kstep, voffB);
    PG8_WAIT_V(6); PG8_BAR;
    for (;;) {
        const bool has_next = S.next(ui + 1, nxt);
        const char* nA = has_next ? (const char*)g.A + (size_t)nxt.pm * tstepA + PG8_AOFF(nxt.pn) : cA; const char* nB = has_next ? (const char*)g.Bt + (size_t)nxt.pn * tstepB : cB;
        for (int t = 0; t < nt; t += 2) {
            const bool last = (t == nt - 2);
            const char* a1 = cA + (size_t)(t + 1) * kstep;
            const char* a2 = last ? nA : cA + (size_t)(t + 2) * kstep; const char* b2 = last ? nB : cB + (size_t)(t + 2) * kstep;
            const char* a3 = a2 + kstep; const char* b3 = b2 + kstep;
            PG8_LDB(B0, 0, 0); PG8_LDB(B1, 0, 1); PG8_SCHED; PG8_LDA(At, 0, 0); PG8_STAGE(PG8_SA(1, 1), a1 + hstepA, voffA);
            PG8_WAIT_V(8); PG8_WAIT_L(0); PG8_BAR; PG8_MMA(0, 0, At, B0); PG8_MMA(0, 1, At, B1); PG8_BAR; PG8_SCHED;
            PG8_LDA(At, 0, 1); PG8_STAGE(PG8_SB(0, 0), b2, voffB); PG8_STAGE(PG8_SB(0, 1), b2 + hstepB, voffB); PG8_STAGE(PG8_SA(0, 0), a2, voffA);
            PG8_WAIT_V(8); PG8_WAIT_L(0); PG8_BAR; PG8_MMA(1, 0, At, B0); PG8_MMA(1, 1, At, B1); PG8_BAR; PG8_SCHED;
            PG8_LDB(B0, 1, 0); PG8_LDB(B1, 1, 1); PG8_SCHED; PG8_LDA(At, 1, 0); PG8_STAGE(PG8_SA(0, 1), a2 + hstepA, voffA);
            PG8_WAIT_V(8); PG8_WAIT_L(0); PG8_BAR; PG8_MMA(0, 0, At, B0); PG8_MMA(0, 1, At, B1); PG8_BAR; PG8_SCHED;
            PG8_LDA(At, 1, 1); PG8_STAGE(PG8_SB(1, 0), b3, voffB); PG8_STAGE(PG8_SB(1, 1), b3 + hstepB, voffB); PG8_STAGE(PG8_SA(1, 0), a3, voffA);
            PG8_WAIT_V(8); PG8_WAIT_L(0); PG8_BAR; PG8_MMA(1, 0, At, B0); PG8_MMA(1, 1, At, B1); PG8_BAR; PG8_SCHED;
        }
        if (wr == 0) PG8_BAR;
        { int fr2 = fr, fq2 = fq; asm volatile("" : "+v"(fr2), "+v"(fq2)); E(acc, cur, wr, wc, fr2, fq2); }
        if (!has_next) break;
#pragma unroll
        for (int a = 0; a < 2; ++a)
#pragma unroll
            for (int b = 0; b < 2; ++b)
#pragma unroll
                for (int m = 0; m < 4; ++m)
#pragma unroll
                    for (int n = 0; n < 2; ++n) acc[a][b][m][n] = (f32x4){0.f, 0.f, 0.f, 0.f};
        cur = nxt; cA = nA; cB = nB; ++ui;
        if (wr == 1) PG8_BAR;
    }
    PG8_WAIT_V(0);
    PG8_BAR;
#undef PG8_SA
#undef PG8_SB
#undef PG8_STAGE
#undef PG8_LDA
#undef PG8_LDB
#undef PG8_MMA
#undef PG8_WAIT_V
#undef PG8_WAIT_L
#undef PG8_BAR
#undef PG8_SCHED
#undef PG8_AOFF
}

typedef f32x4 Acc[2][2][4][2];

struct EpiBf16 {
    static constexpr bool PERM = true;
    bf16_t* O; int ldc;
    __device__ __forceinline__ void operator()(const Acc& acc, const Unit& u, int wr, int wc, int fr, int fq) const {
        const int row0 = u.pm * BM + wr * 64 + fr, col0 = u.pn * BM + wc * 32 + 8 * fq;
#pragma unroll
        for (int ai = 0; ai < 2; ++ai)
#pragma unroll
            for (int m = 0; m < 4; ++m) { bf16_t* rowp = O + (size_t)(row0 + ai * HALF + m * 16) * ldc + col0;
#pragma unroll
                for (int bj = 0; bj < 2; ++bj) { const f32x4 v0 = acc[ai][bj][m][0], v1 = acc[ai][bj][m][1];
                    u32x4 w; w.x = cvt_pk_bf16(v0[0], v0[1]); w.y = cvt_pk_bf16(v0[2], v0[3]); w.z = cvt_pk_bf16(v1[0], v1[1]); w.w = cvt_pk_bf16(v1[2], v1[3]);
                    *(u32x4*)(rowp + bj * HALF) = w; } asm volatile("" ::: "memory"); }
    }
};
struct EpiSwiglu {
    static constexpr bool PERM = true;
    bf16_t* O; int ldc;
    __device__ __forceinline__ void operator()(const Acc& acc, const Unit& u, int wr, int wc, int fr, int fq) const {
        const int row0 = u.pm * BM + wr * 64 + fr, col0 = u.pn * HALF + wc * 32 + 8 * fq;
#pragma unroll
        for (int ai = 0; ai < 2; ++ai)
#pragma unroll
            for (int m = 0; m < 4; ++m) { bf16_t* rowp = O + (size_t)(row0 + ai * HALF + m * 16) * ldc + col0;
                float r[8];
#pragma unroll
                for (int n = 0; n < 2; ++n)
#pragma unroll
                    for (int j = 0; j < 4; ++j) { const float gv = acc[ai][0][m][n][j], uv = acc[ai][1][m][n][j]; r[n * 4 + j] = gv * fsigmoid(gv) * uv; }
                u32x4 w; w.x = cvt_pk_bf16(r[0], r[1]); w.y = cvt_pk_bf16(r[2], r[3]); w.z = cvt_pk_bf16(r[4], r[5]); w.w = cvt_pk_bf16(r[6], r[7]);
                *(u32x4*)rowp = w; asm volatile("" ::: "memory"); }
    }
};
struct EpiResid {
    static constexpr bool PERM = false;
    const float* res0; const float* res1; int split; float* out; float alpha; int row_base;
    __device__ __forceinline__ void operator()(const Acc& acc, const Unit& u, int wr, int wc, int fr, int fq) const {
        const int grow0 = row_base + u.pm * BM; const float* rb = grow0 < split ? res0 + (size_t)grow0 * DM : res1 + (size_t)(grow0 - split) * DM;
        float* ob = out + (size_t)grow0 * DM; const int col0 = u.pn * BM + wc * 32 + 4 * fq;
#pragma unroll
        for (int ai = 0; ai < 2; ++ai)
#pragma unroll
            for (int mp = 0; mp < 2; ++mp) {
                f32x4 bs[2][2][2];
#pragma unroll
                for (int mm = 0; mm < 2; ++mm) { const size_t off = (size_t)(ai * HALF + wr * 64 + (2 * mp + mm) * 16 + fr) * DM + col0;
#pragma unroll
                    for (int bj = 0; bj < 2; ++bj)
#pragma unroll
                        for (int n = 0; n < 2; ++n) bs[mm][bj][n] = *(const f32x4*)(rb + off + bj * HALF + n * 16); }
#pragma unroll
                for (int mm = 0; mm < 2; ++mm) { const int m = 2 * mp + mm; const size_t off = (size_t)(ai * HALF + wr * 64 + m * 16 + fr) * DM + col0;
#pragma unroll
                    for (int bj = 0; bj < 2; ++bj)
#pragma unroll
                        for (int n = 0; n < 2; ++n) *(f32x4*)(ob + off + bj * HALF + n * 16) = bs[mm][bj][n] + acc[ai][bj][m][n] * alpha; }
                asm volatile("" ::: "memory"); }
    }
};
struct EpiQ {
    static constexpr bool PERM = true;
    bf16_t* O; const float* cosT; const float* sinT;
    __device__ __forceinline__ void operator()(const Acc& acc, const Unit& u, int wr, int wc, int fr, int fq) const {
        const int row0 = u.pm * BM + wr * 64 + fr;
#pragma unroll
        for (int bj = 0; bj < 2; ++bj) { const int col0 = u.pn * BM + bj * HALF + wc * 32 + 8 * fq; const int d = col0 % 192; const bool rope = d >= 128; const int jp0 = (d - 128) >> 1;
#pragma unroll
            for (int ai = 0; ai < 2; ++ai)
#pragma unroll
                for (int m = 0; m < 4; ++m) { const int row = row0 + ai * HALF + m * 16; f32x4 v0 = acc[ai][bj][m][0], v1 = acc[ai][bj][m][1];
                    if (rope) { const f32x4 c = *(const f32x4*)(cosT + (size_t)row * 32 + jp0), s = *(const f32x4*)(sinT + (size_t)row * 32 + jp0);
                        const f32x4 a0 = v0, a1 = v1;
                        v0[0] = a0[0] * c[0] - a0[1] * s[0]; v0[1] = a0[1] * c[0] + a0[0] * s[0]; v0[2] = a0[2] * c[1] - a0[3] * s[1]; v0[3] = a0[3] * c[1] + a0[2] * s[1];
                        v1[0] = a1[0] * c[2] - a1[1] * s[2]; v1[1] = a1[1] * c[2] + a1[0] * s[2]; v1[2] = a1[2] * c[3] - a1[3] * s[3]; v1[3] = a1[3] * c[3] + a1[2] * s[3]; }
                    v0 = v0 * QSCALE; v1 = v1 * QSCALE;
                    u32x4 w; w.x = cvt_pk_bf16(v0[0], v0[1]); w.y = cvt_pk_bf16(v0[2], v0[3]); w.z = cvt_pk_bf16(v1[0], v1[1]); w.w = cvt_pk_bf16(v1[2], v1[3]);
                    *(u32x4*)(O + (size_t)row * NQ + col0) = w; asm volatile("" ::: "memory"); } }
    }
};
struct EpiGates {
    static constexpr bool PERM = true;
    const bf16_t* xc; const float* b_a; const float* b_i; const float* c8; bf16_t* Aout; bf16_t* Uout; size_t dir_stride;
    __device__ __forceinline__ void operator()(const Acc& acc, const Unit& u, int wr, int wc, int fr, int fq) const {
        const int dir = u.pn >> 4, blk = u.pn & 15; const int row0 = u.pm * BM + wr * 64 + fr; const int ch0 = blk * HALF + wc * 32 + 8 * fq;
        bf16_t* Ao = Aout + (size_t)dir * dir_stride; bf16_t* Uo = Uout + (size_t)dir * dir_stride;
        f32x4 ba[2], bi[2], cc[2];
#pragma unroll
        for (int n = 0; n < 2; ++n) { ba[n] = *(const f32x4*)(b_a + dir * DM + ch0 + 4 * n); bi[n] = *(const f32x4*)(b_i + dir * DM + ch0 + 4 * n); cc[n] = *(const f32x4*)(c8 + dir * DM + ch0 + 4 * n); }
#pragma unroll
        for (int ai = 0; ai < 2; ++ai)
#pragma unroll
            for (int m = 0; m < 4; ++m) { const int row = row0 + ai * HALF + m * 16; const size_t off = (size_t)row * DM + ch0;
                const u32x4 xw = *(const u32x4*)(xc + off);
                const float xv[8] = {bf2f(xw.x & 0xffffu), bf2f(xw.x >> 16), bf2f(xw.y & 0xffffu), bf2f(xw.y >> 16), bf2f(xw.z & 0xffffu), bf2f(xw.z >> 16), bf2f(xw.w & 0xffffu), bf2f(xw.w >> 16)};
                float om[8], uv[8];
#pragma unroll
                for (int n = 0; n < 2; ++n)
#pragma unroll
                    for (int j = 0; j < 4; ++j) { const float r = fsigmoid(acc[ai][0][m][n][j] + ba[n][j]), ig = fsigmoid(acc[ai][1][m][n][j] + bi[n][j]);
                        const float y = r * cc[n][j];
                        float o1 = y * (1.0f - y * (0.5f - y * (0.16666667f - y * (0.041666668f - y * 0.008333334f))));
                        if (__builtin_expect(__any(y >= 0.125f), 0)) { const float ome = 1.0f - __expf(-y); o1 = y < 0.125f ? o1 : ome; }
                        om[n * 4 + j] = o1; uv[n * 4 + j] = sqrtf(o1 * (2.0f - o1)) * (ig * xv[n * 4 + j]); }
                u32x4 wa, wu; wa.x = cvt_pk_bf16(om[0], om[1]); wa.y = cvt_pk_bf16(om[2], om[3]); wa.z = cvt_pk_bf16(om[4], om[5]); wa.w = cvt_pk_bf16(om[6], om[7]);
                wu.x = cvt_pk_bf16(uv[0], uv[1]); wu.y = cvt_pk_bf16(uv[2], uv[3]); wu.z = cvt_pk_bf16(uv[4], uv[5]); wu.w = cvt_pk_bf16(uv[6], uv[7]);
                *(u32x4*)(Ao + off) = wa; *(u32x4*)(Uo + off) = wu; asm volatile("" ::: "memory"); }
    }
};
struct EpiT1 {
    static constexpr bool PERM = true;
    const bf16_t* gate; int ldg; bf16_t* O;
    __device__ __forceinline__ void operator()(const Acc& acc, const Unit& u, int wr, int wc, int fr, int fq) const {
        const int row0 = u.pm * BM + wr * 64 + fr;
#pragma unroll
        for (int ai = 0; ai < 2; ++ai)
#pragma unroll
            for (int m = 0; m < 4; ++m) { const int row = row0 + ai * HALF + m * 16;
#pragma unroll
                for (int bj = 0; bj < 2; ++bj) { const int col0 = u.pn * BM + bj * HALF + wc * 32 + 8 * fq;
                    const u32x4 gw = *(const u32x4*)(gate + (size_t)row * ldg + col0); f32x4 v0 = acc[ai][bj][m][0], v1 = acc[ai][bj][m][1];
                    v0[0] *= fsigmoid(bf2f(gw.x & 0xffffu)); v0[1] *= fsigmoid(bf2f(gw.x >> 16)); v0[2] *= fsigmoid(bf2f(gw.y & 0xffffu)); v0[3] *= fsigmoid(bf2f(gw.y >> 16));
                    v1[0] *= fsigmoid(bf2f(gw.z & 0xffffu)); v1[1] *= fsigmoid(bf2f(gw.z >> 16)); v1[2] *= fsigmoid(bf2f(gw.w & 0xffffu)); v1[3] *= fsigmoid(bf2f(gw.w >> 16));
                    u32x4 w; w.x = cvt_pk_bf16(v0[0], v0[1]); w.y = cvt_pk_bf16(v0[2], v0[3]); w.z = cvt_pk_bf16(v1[0], v1[1]); w.w = cvt_pk_bf16(v1[2], v1[3]);
                    *(u32x4*)(O + (size_t)row * DM + col0) = w; } asm volatile("" ::: "memory"); }
    }
};
struct EpiMerge {
    static constexpr bool PERM = true;
    const bf16_t* gate; int ldg; const bf16_t* T1; bf16_t* O;
    __device__ __forceinline__ void operator()(const Acc& acc, const Unit& u, int wr, int wc, int fr, int fq) const {
        const int row0 = u.pm * BM + wr * 64 + fr;
#pragma unroll
        for (int ai = 0; ai < 2; ++ai)
#pragma unroll
            for (int m = 0; m < 4; ++m) { const int row = row0 + ai * HALF + m * 16;
#pragma unroll
                for (int bj = 0; bj < 2; ++bj) { const int col0 = u.pn * BM + bj * HALF + wc * 32 + 8 * fq;
                    const u32x4 gw = *(const u32x4*)(gate + (size_t)row * ldg + col0); const u32x4 tw = *(const u32x4*)(T1 + (size_t)row * DM + col0);
                    f32x4 v0 = acc[ai][bj][m][0], v1 = acc[ai][bj][m][1];
                    const f32x4 t0 = {bf2f(tw.x & 0xffffu), bf2f(tw.x >> 16), bf2f(tw.y & 0xffffu), bf2f(tw.y >> 16)}, t1 = {bf2f(tw.z & 0xffffu), bf2f(tw.z >> 16), bf2f(tw.w & 0xffffu), bf2f(tw.w >> 16)};
                    v0[0] = t0[0] + v0[0] * fsigmoid(bf2f(gw.x & 0xffffu)); v0[1] = t0[1] + v0[1] * fsigmoid(bf2f(gw.x >> 16)); v0[2] = t0[2] + v0[2] * fsigmoid(bf2f(gw.y & 0xffffu)); v0[3] = t0[3] + v0[3] * fsigmoid(bf2f(gw.y >> 16));
                    v1[0] = t1[0] + v1[0] * fsigmoid(bf2f(gw.z & 0xffffu)); v1[1] = t1[1] + v1[1] * fsigmoid(bf2f(gw.z >> 16)); v1[2] = t1[2] + v1[2] * fsigmoid(bf2f(gw.w & 0xffffu)); v1[3] = t1[3] + v1[3] * fsigmoid(bf2f(gw.w >> 16));
                    u32x4 w; w.x = cvt_pk_bf16(v0[0], v0[1]); w.y = cvt_pk_bf16(v0[2], v0[3]); w.z = cvt_pk_bf16(v1[0], v1[1]); w.w = cvt_pk_bf16(v1[2], v1[3]);
                    *(u32x4*)(O + (size_t)row * DM + col0) = w; } asm volatile("" ::: "memory"); }
    }
};
}

namespace att {
constexpr int NW = 8, QBLK = 32, KVBLK = 64;
constexpr int LDQ = NQ, LDKV = NKV, LDO = DM;
constexpr int SLOT_K = 24576, SLOT_V = 16384, KR_OFF = 16384;
constexpr int OFF_K = 0, OFF_V = 3 * SLOT_K, OFF_WS = OFF_V + 3 * SLOT_V;
constexpr float THRL = 11.0f;
#define KNSWZ(row, colB) ((row) * 256 + ((colB) ^ (((row) & 15) << 4)))
#define KRSWZ(row, colB) ((row) * 128 + ((colB) ^ ((((row) >> 1) & 7) << 4)))
#define SBAR() __builtin_amdgcn_sched_barrier(0)
__device__ __forceinline__ int crow(int r, int hi) { return (r & 3) + 8 * (r >> 2) + 4 * hi; }

template <bool FIRST>
__device__ __forceinline__ void partialSM(f32x16& p0, f32x16& p1, float& m_reg, float& mn, float& alpha) {
    float pmax = p0[0];
#pragma unroll
    for (int r = 1; r < 16; ++r) pmax = fmaxf(pmax, p0[r]);
#pragma unroll
    for (int r = 0; r < 16; ++r) pmax = fmaxf(pmax, p1[r]);
    { auto rr = __builtin_amdgcn_permlane32_swap(__float_as_uint(pmax), __float_as_uint(pmax), false, false);
      pmax = fmaxf(__uint_as_float(rr[0]), __uint_as_float(rr[1])); }
    if (FIRST) { mn = (fabsf(pmax) <= THRL) ? 0.f : pmax; m_reg = mn; alpha = 1.f; }
    else if (__builtin_expect(__all(pmax - m_reg <= THRL), 1)) { mn = m_reg; alpha = 1.f; }
    else { mn = fmaxf(m_reg, pmax); alpha = __builtin_amdgcn_exp2f(m_reg - mn); m_reg = mn; }
    if (!__builtin_expect(__all(mn == 0.f), 1)) {
#pragma unroll
        for (int r = 0; r < 16; ++r) p0[r] = p0[r] - mn;
#pragma unroll
        for (int r = 0; r < 16; ++r) p1[r] = p1[r] - mn; }
#pragma unroll
    for (int r = 0; r < 16; ++r) p0[r] = __builtin_amdgcn_exp2f(p0[r]);
}
__device__ __forceinline__ void finishSM(f32x16& p0, f32x16& p1, float alpha, float& l_reg, bf16x8& pa0, bf16x8& pa1, bf16x8& pa2, bf16x8& pa3) {
#pragma unroll
    for (int r = 0; r < 16; ++r) p1[r] = __builtin_amdgcn_exp2f(p1[r]);
    float ps = 0;
#pragma unroll
    for (int r = 0; r < 16; ++r) ps += p0[r];
#pragma unroll
    for (int r = 0; r < 16; ++r) ps += p1[r];
    { auto rr = __builtin_amdgcn_permlane32_swap(__float_as_uint(ps), __float_as_uint(ps), false, false);
      ps = __uint_as_float(rr[0]) + __uint_as_float(rr[1]); }
    l_reg = l_reg * alpha + ps;
#define PK4(P, BASE, OUT) do { unsigned a0 = cvt_pk_bf16(P[BASE + 0], P[BASE + 1]), a1 = cvt_pk_bf16(P[BASE + 2], P[BASE + 3]);   \
    unsigned b0 = cvt_pk_bf16(P[BASE + 4], P[BASE + 5]), b1 = cvt_pk_bf16(P[BASE + 6], P[BASE + 7]);                              \
    auto r0 = __builtin_amdgcn_permlane32_swap(a0, b0, false, false); auto r1 = __builtin_amdgcn_permlane32_swap(a1, b1, false, false); \
    u32x4 w = {r0[0], r1[0], r0[1], r1[1]}; OUT = *reinterpret_cast<bf16x8*>(&w); } while (0)
    PK4(p0, 0, pa0); PK4(p0, 8, pa1); PK4(p1, 0, pa2); PK4(p1, 8, pa3);
#undef PK4
}
__device__ __forceinline__ void qkt(f32x16& p0, f32x16& p1, const char* Kn, const bf16x8* qr, int r32, int hi) {
    const char* Kr = Kn + KR_OFF;
    p0 = f32x16{}; p1 = f32x16{};
    __builtin_amdgcn_s_setprio(1);
#pragma unroll
    for (int d0 = 0; d0 < 8; ++d0) { const int cb = (d0 * 16 + hi * 8) * 2;
        const bf16x8 b0 = *reinterpret_cast<const bf16x8*>(Kn + KNSWZ(r32, cb));
        const bf16x8 b1 = *reinterpret_cast<const bf16x8*>(Kn + KNSWZ(32 + r32, cb));
        p0 = __builtin_amdgcn_mfma_f32_32x32x16_bf16(b0, qr[d0], p0, 0, 0, 0);
        p1 = __builtin_amdgcn_mfma_f32_32x32x16_bf16(b1, qr[d0], p1, 0, 0, 0); }
#pragma unroll
    for (int d0 = 0; d0 < 4; ++d0) { const int cb = (d0 * 16 + hi * 8) * 2;
        const bf16x8 b0 = *reinterpret_cast<const bf16x8*>(Kr + KRSWZ(r32, cb));
        const bf16x8 b1 = *reinterpret_cast<const bf16x8*>(Kr + KRSWZ(32 + r32, cb));
        p0 = __builtin_amdgcn_mfma_f32_32x32x16_bf16(b0, qr[8 + d0], p0, 0, 0, 0);
        p1 = __builtin_amdgcn_mfma_f32_32x32x16_bf16(b1, qr[8 + d0], p1, 0, 0, 0); }
}
__device__ __forceinline__ int v_st(int k, int c) { const int kk = (k & ~0xC) | ((k & 4) << 1) | ((k & 8) >> 1); return ((kk >> 3) * 4 + (c >> 5)) * 512 + ((kk & 7) * 32 + (c & 31)) * 2; }
__device__ __forceinline__ int v_rd_base(int lane) { return ((lane & 3) << 3) | (((lane >> 2) & 3) << 6) | (((lane >> 4) & 1) << 5) | (((lane >> 5) & 1) << 8); }
constexpr int v_rd_off(int d0, int ks, int half) { return d0 * 512 + ks * 4096 + half * 2048; }
template <int OFF> __device__ __forceinline__ s16x4 tr_read(int vb) {
    s16x4 r; asm volatile("ds_read_b64_tr_b16 %0, %1 offset:%2" : "=&v"(r) : "v"(vb), "i"(OFF) : "memory"); return r;
}
template <int D0> __device__ __forceinline__ void pv_one(f32x16& od, int vb, bf16x8 pa0, bf16x8 pa1, bf16x8 pa2, bf16x8 pa3) {
    const s16x4 l0 = tr_read<v_rd_off(D0, 0, 0)>(vb), h0 = tr_read<v_rd_off(D0, 0, 1)>(vb), l1 = tr_read<v_rd_off(D0, 1, 0)>(vb), h1 = tr_read<v_rd_off(D0, 1, 1)>(vb);
    const s16x4 l2 = tr_read<v_rd_off(D0, 2, 0)>(vb), h2 = tr_read<v_rd_off(D0, 2, 1)>(vb), l3 = tr_read<v_rd_off(D0, 3, 0)>(vb), h3 = tr_read<v_rd_off(D0, 3, 1)>(vb);
    asm volatile("s_waitcnt lgkmcnt(0)" ::: "memory"); SBAR();
#define PK(L, H) (bf16x8){L[0], L[1], L[2], L[3], H[0], H[1], H[2], H[3]}
    od = __builtin_amdgcn_mfma_f32_32x32x16_bf16(pa0, PK(l0, h0), od, 0, 0, 0);
    od = __builtin_amdgcn_mfma_f32_32x32x16_bf16(pa1, PK(l1, h1), od, 0, 0, 0);
    od = __builtin_amdgcn_mfma_f32_32x32x16_bf16(pa2, PK(l2, h2), od, 0, 0, 0);
    od = __builtin_amdgcn_mfma_f32_32x32x16_bf16(pa3, PK(l3, h3), od, 0, 0, 0);
#undef PK
}
__device__ __forceinline__ void pv_d0(f32x16* o, int vb, bf16x8 pa0, bf16x8 pa1, bf16x8 pa2, bf16x8 pa3) {
    pv_one<0>(o[0], vb, pa0, pa1, pa2, pa3); pv_one<1>(o[1], vb, pa0, pa1, pa2, pa3); pv_one<2>(o[2], vb, pa0, pa1, pa2, pa3); pv_one<3>(o[3], vb, pa0, pa1, pa2, pa3);
}

__device__ __forceinline__ void attn_unit(const bf16_t* __restrict__ Qb, const bf16_t* __restrict__ Kn, const bf16_t* __restrict__ Vh, const bf16_t* __restrict__ Kr,
                                          bf16_t* __restrict__ Ob, int seq, char* lds, int wv_) { LAUNDER_IDS;
    const int tid = tidx_, wid = __builtin_amdgcn_readfirstlane(tid >> 6), lane = tid & 63, r32 = lane & 31, hi = lane >> 5;
    LAS unsigned char* lds3 = (LAS unsigned char*)lds;
    float* ws = (float*)(lds + OFF_WS) + wid * 64; float* li_l = ws; float* al_l = ws + 32;
    float m_reg = 0.f, l_reg = 0; f32x16 o[4] = {}; bf16x8 qr[12];
    const bf16_t* Qw = Qb + (long)(wid * QBLK + r32) * LDQ + hi * 8;
#pragma unroll
    for (int d0 = 0; d0 < 12; ++d0) qr[d0] = *reinterpret_cast<const bf16x8*>(Qw + d0 * 16);
    unsigned gkn[2], gv[2], gkr;
#pragma unroll
    for (int i = 0; i < 2; ++i) { const int c = wid * 2 + i; const int row = c * 4 + (lane >> 4), slot = lane & 15; gkn[i] = (unsigned)(row * (LDKV * 2) + ((slot ^ (row & 15)) << 4));
        const int st = c * 2 + (lane >> 5), kk = (st >> 2) * 8 + ((lane & 31) >> 2), k = (kk & ~0xC) | ((kk & 4) << 1) | ((kk & 8) >> 1), col = (st & 3) * 32 + (lane & 3) * 8; gv[i] = (unsigned)(k * (LDKV * 2) + col * 2); }
    { const int row = wid * 8 + (lane >> 3), slot = lane & 7; gkr = (unsigned)(row * 128 + ((slot ^ ((row >> 1) & 7)) << 4)); }
    const int vb0 = (int)(uintptr_t)(lds + OFF_V) + v_rd_base(lane);
#define DMA(t, slot) do { const char* kt_ = (const char*)Kn + (size_t)(t) * (KVBLK * LDKV * 2); const char* vt_ = (const char*)Vh + (size_t)(t) * (KVBLK * LDKV * 2); const char* rt_ = (const char*)Kr + (size_t)(t) * (KVBLK * 128); \
    _Pragma("unroll") for (int i_ = 0; i_ < 2; ++i_) { \
      __builtin_amdgcn_global_load_lds((const unsigned*)(kt_ + gkn[i_]), (LAS unsigned*)(lds3 + OFF_K + (slot) * SLOT_K + (wid * 2 + i_) * 1024), 16, 0, 0); \
      __builtin_amdgcn_global_load_lds((const unsigned*)(vt_ + gv[i_]), (LAS unsigned*)(lds3 + OFF_V + (slot) * SLOT_V + (wid * 2 + i_) * 1024), 16, 0, 0); } \
    __builtin_amdgcn_global_load_lds((const unsigned*)(rt_ + gkr), (LAS unsigned*)(lds3 + OFF_K + (slot) * SLOT_K + KR_OFF + wid * 1024), 16, 0, 0); } while (0)
#define WAIT_BAR() asm volatile("s_waitcnt vmcnt(0) lgkmcnt(0)\n\ts_barrier" ::: "memory")
#define RESC(a) do { if (__any((a) < 1.f)) { if (hi == 0) al_l[r32] = (a); asm volatile("s_waitcnt lgkmcnt(0)" ::: "memory"); \
    _Pragma("unroll") for (int d = 0; d < 4; ++d) _Pragma("unroll") for (int r = 0; r < 16; ++r) o[d][r] *= al_l[crow(r, hi)]; } } while (0)
    f32x16 pA0, pA1, pB0, pB1; float mnA, mnB, alA, alB; bf16x8 pa0, pa1, pa2, pa3; const int NT = seq / KVBLK;
    DMA(0, 0); DMA(1, 1); WAIT_BAR();
    qkt(pA0, pA1, lds + OFF_K, qr, r32, hi); __builtin_amdgcn_s_setprio(0); partialSM<true>(pA0, pA1, m_reg, mnA, alA);
    int s_prev = 0, s_cur = 1, s_next = 2;
#define ROT() do { const int t_ = s_prev; s_prev = s_cur; s_cur = s_next; s_next = t_; } while (0)
    for (int j = 1; j + 1 < NT; j += 2) {
        DMA(j + 1, s_next); SBAR();
        qkt(pB0, pB1, lds + OFF_K + s_cur * SLOT_K, qr, r32, hi);
        finishSM(pA0, pA1, alA, l_reg, pa0, pa1, pa2, pa3); __builtin_amdgcn_s_setprio(0); SBAR();
        pv_d0(o, vb0 + s_prev * SLOT_V, pa0, pa1, pa2, pa3); partialSM<false>(pB0, pB1, m_reg, mnB, alB);
        RESC(alB); WAIT_BAR(); ROT();
        DMA(j + 2, s_next); SBAR();
        qkt(pA0, pA1, lds + OFF_K + s_cur * SLOT_K, qr, r32, hi);
        finishSM(pB0, pB1, alB, l_reg, pa0, pa1, pa2, pa3); __builtin_amdgcn_s_setprio(0); SBAR();
        pv_d0(o, vb0 + s_prev * SLOT_V, pa0, pa1, pa2, pa3); partialSM<false>(pA0, pA1, m_reg, mnA, alA);
        RESC(alA); WAIT_BAR(); ROT();
    }
    SBAR(); qkt(pB0, pB1, lds + OFF_K + s_cur * SLOT_K, qr, r32, hi);
    finishSM(pA0, pA1, alA, l_reg, pa0, pa1, pa2, pa3); __builtin_amdgcn_s_setprio(0); SBAR();
    pv_d0(o, vb0 + s_prev * SLOT_V, pa0, pa1, pa2, pa3); partialSM<false>(pB0, pB1, m_reg, mnB, alB);
    RESC(alB);
    finishSM(pB0, pB1, alB, l_reg, pa0, pa1, pa2, pa3); __builtin_amdgcn_s_setprio(0); SBAR();
    pv_d0(o, vb0 + s_cur * SLOT_V, pa0, pa1, pa2, pa3);
    if (hi == 0) li_l[r32] = l_reg; asm volatile("s_waitcnt lgkmcnt(0)" ::: "memory");
    float rli[16];
#pragma unroll
    for (int r = 0; r < 16; ++r) rli[r] = __builtin_amdgcn_rcpf(li_l[crow(r, hi)]);
    bf16_t* Ow = Ob + (long)(wid * QBLK) * LDO;
#pragma unroll
    for (int r = 0; r < 16; ++r) { const int orow = crow(r, hi);
#pragma unroll
        for (int d0 = 0; d0 < 4; ++d0) Ow[(long)orow * LDO + d0 * 32 + r32] = (bf16_t)(cvt_pk_bf16(o[d0][r] * rli[r], 0.f) & 0xffffu); }
    WAIT_BAR();
#undef DMA
#undef WAIT_BAR
#undef RESC
#undef ROT
}
}


#define XB_TMO      128
#define XB_XCNT(j)  (256  + 64 * (j))
#define XB_XSUB(j)  (1280 + 64 * (j))
#define XB_XGEN(j)  (2304 + 64 * (j))
#define XB_TOP      3328
#define XB_TOPGEN   3392
#define XCD_BAR_WORDS 3456
#define XB_SPIN_CAP (1u << 22)
__device__ __forceinline__ unsigned xb_ld(unsigned* p)              { return __hip_atomic_load(p, __ATOMIC_RELAXED, __HIP_MEMORY_SCOPE_AGENT); }
__device__ __forceinline__ unsigned xb_add(unsigned* p, unsigned v) { return __hip_atomic_fetch_add(p, v, __ATOMIC_RELAXED, __HIP_MEMORY_SCOPE_AGENT); }
__device__ __forceinline__ unsigned xb_xcc_id() { return (unsigned)__builtin_amdgcn_s_getreg((3 << 11) | 20) & 0xFu; }
#define XB_SPIN(cond, bar) do { unsigned _sp = 0; while (cond) { __builtin_amdgcn_s_sleep(1); \
    if ((++_sp & 255u) == 0u) { if (xb_ld(&(bar)[XB_TMO])) break; if (_sp > XB_SPIN_CAP) { atomicAdd(&(bar)[XB_TMO], 1u); break; } } } } while (0)
struct XcdBarrier { unsigned* bar; unsigned x; volatile LAS unsigned* st; };
__device__ __forceinline__ XcdBarrier xcd_barrier_post(unsigned* bar, volatile LAS unsigned* st) {
    XcdBarrier b; b.bar = bar; b.x = xb_xcc_id(); b.st = st;
    if (threadIdx.x == 0) (void)xb_add(&bar[XB_XCNT(b.x)], 1u);
    return b;
}
__device__ __forceinline__ void xcd_barrier_complete(unsigned* bar, unsigned x, unsigned& nloc, unsigned& nx) {
    const unsigned G = gridDim.x * gridDim.y * gridDim.z;
    unsigned sum, cnt, mine, sp = 0u;
    for (;;) {
        sum = 0u; cnt = 0u; mine = 0u;
#pragma unroll
        for (unsigned j = 0; j < 16; ++j) { const unsigned c = xb_ld(&bar[XB_XCNT(j)]); sum += c; cnt += (c > 0u) ? 1u : 0u; mine = (j == x) ? c : mine; }
        if (sum == G) break;
        __builtin_amdgcn_s_sleep(1);
        if ((++sp & 255u) == 0u) { if (xb_ld(&bar[XB_TMO])) break; if (sp > XB_SPIN_CAP) { atomicAdd(&bar[XB_TMO], 1u); break; } }
    }
    nloc = mine > 0u ? mine : 1u; nx = cnt > 0u ? cnt : 1u;
}
__device__ __forceinline__ void xcd_barrier(const XcdBarrier& b) {
    asm volatile("s_waitcnt vmcnt(0)" ::: "memory");
    __syncthreads();
    if (threadIdx.x == 0) {
        unsigned* bar = b.bar;
        __builtin_amdgcn_s_waitcnt(0);
        unsigned nloc = b.st[0], nx = b.st[1];
        if (nloc == 0u) { xcd_barrier_complete(bar, b.x, nloc, nx); b.st[0] = nloc; b.st[1] = nx; }
        const unsigned old = xb_add(&bar[XB_XSUB(b.x)], 1u);
        const unsigned gen = old / nloc;
        if (old + 1u == (gen + 1u) * nloc) {
            __builtin_amdgcn_fence(__ATOMIC_RELEASE, "agent");
            asm volatile("s_waitcnt vmcnt(0)" ::: "memory");
            const unsigned og = xb_add(&bar[XB_TOP], 1u);
            const unsigned tg = og / nx;
            if (og + 1u == (tg + 1u) * nx) xb_add(&bar[XB_TOPGEN], 1u);
            else XB_SPIN(xb_ld(&bar[XB_TOPGEN]) == tg, bar);
            __builtin_amdgcn_fence(__ATOMIC_ACQUIRE, "agent");
            xb_add(&bar[XB_XGEN(b.x)], 1u);
            asm volatile("s_waitcnt vmcnt(0)" ::: "memory");
        } else {
            XB_SPIN(xb_ld(&bar[XB_XGEN(b.x)]) == gen, bar);
            __builtin_amdgcn_fence(__ATOMIC_ACQUIRE, "agent");
            asm volatile("s_waitcnt vmcnt(0)" ::: "memory");
        }
    }
    __syncthreads();
}

struct Args { const float* in[27]; float* out; unsigned char* ws; int ph_lo, ph_hi; };

__device__ __forceinline__ int map_row(int mode, int row_off, int n) {
    if (mode == 0) return row_off + n;
    if (mode == 1) return (n >> 7) * 256 + row_off + (n & 127);
    if (mode == 2) { if (n >= C_KPE && n < C_KPE + 64) { const int j = n - C_KPE; return C_KPE + (j < 32 ? 2 * j : 2 * (j - 32) + 1); } return n; }
    { const int h = n / 192, d = n % 192; if (d < 128) return n; const int j = d - 128; return h * 192 + 128 + (j < 32 ? 2 * j : 2 * (j - 32) + 1); }
}
__device__ __forceinline__ void transpose_item(const float* W, int K, int N, bf16_t* WT, int mode, int row_off, LAS float* scr, int item, int lane) {
    const int nblk = N / 32, kb = item / nblk, nb = item % nblk, k0 = 64 * kb, n0 = 32 * nb;
    float wv[32];
#pragma unroll
    for (int i = 0; i < 32; ++i) { const int kk = 2 * i + (lane >> 5); wv[i] = W[(size_t)(k0 + kk) * N + n0 + (lane & 31)]; }
#pragma unroll
    for (int i = 0; i < 32; ++i) { const int kk = 2 * i + (lane >> 5); scr[kk * 33 + (lane & 31)] = wv[i]; }
    asm volatile("s_waitcnt lgkmcnt(0)" ::: "memory");
    const int c = lane & 7;
#pragma unroll
    for (int j = 0; j < 4; ++j) { const int n = (lane >> 3) + 8 * j; const LAS float* s = scr + (8 * c) * 33 + n;
        u32x4 o; o.x = cvt_pk_bf16(s[0 * 33], s[1 * 33]); o.y = cvt_pk_bf16(s[2 * 33], s[3 * 33]); o.z = cvt_pk_bf16(s[4 * 33], s[5 * 33]); o.w = cvt_pk_bf16(s[6 * 33], s[7 * 33]);
        *(u32x4*)(WT + (size_t)map_row(mode, row_off, n0 + n) * K + k0 + 8 * c) = o; }
    asm volatile("s_waitcnt lgkmcnt(0)" ::: "memory");
}

__device__ __forceinline__ void rms_row2_bf16(const float* xrow0, const float* xrow1, const float* g, bf16_t* orow0, bf16_t* orow1, int lane) {
    const f32x4* xr0 = (const f32x4*)xrow0 + lane; const f32x4* xr1 = (const f32x4*)xrow1 + lane; const f32x4* gr = (const f32x4*)g + lane;
    f32x4 v0[8], v1[8]; float s0 = 0.f, s1 = 0.f;
#pragma unroll
    for (int j = 0; j < 8; ++j) { v0[j] = xr0[64 * j]; v1[j] = xr1[64 * j]; }
#pragma unroll
    for (int j = 0; j < 8; ++j) { s0 += (v0[j].x * v0[j].x + v0[j].y * v0[j].y) + (v0[j].z * v0[j].z + v0[j].w * v0[j].w); s1 += (v1[j].x * v1[j].x + v1[j].y * v1[j].y) + (v1[j].z * v1[j].z + v1[j].w * v1[j].w); }
    const float r0 = rsqrtf(wave_sum(s0) * (1.f / DM) + RMS_EPS), r1 = rsqrtf(wave_sum(s1) * (1.f / DM) + RMS_EPS);
    u32x2* o0 = (u32x2*)orow0 + lane; u32x2* o1 = (u32x2*)orow1 + lane;
#pragma unroll
    for (int j = 0; j < 8; ++j) { const f32x4 gg = gr[64 * j]; u32x2 w;
        w.x = cvt_pk_bf16(v0[j].x * r0 * gg.x, v0[j].y * r0 * gg.y); w.y = cvt_pk_bf16(v0[j].z * r0 * gg.z, v0[j].w * r0 * gg.w); o0[64 * j] = w;
        w.x = cvt_pk_bf16(v1[j].x * r1 * gg.x, v1[j].y * r1 * gg.y); w.y = cvt_pk_bf16(v1[j].z * r1 * gg.z, v1[j].w * r1 * gg.w); o1[64 * j] = w; }
}
__device__ __forceinline__ void rms_row2_f32_inplace(float* xrow0, float* xrow1, const float* g, int lane) {
    f32x4* xr0 = (f32x4*)xrow0 + lane; f32x4* xr1 = (f32x4*)xrow1 + lane; const f32x4* gr = (const f32x4*)g + lane;
    f32x4 v0[8], v1[8]; float s0 = 0.f, s1 = 0.f;
#pragma unroll
    for (int j = 0; j < 8; ++j) { v0[j] = xr0[64 * j]; v1[j] = xr1[64 * j]; }
#pragma unroll
    for (int j = 0; j < 8; ++j) { s0 += (v0[j].x * v0[j].x + v0[j].y * v0[j].y) + (v0[j].z * v0[j].z + v0[j].w * v0[j].w); s1 += (v1[j].x * v1[j].x + v1[j].y * v1[j].y) + (v1[j].z * v1[j].z + v1[j].w * v1[j].w); }
    const float r0 = rsqrtf(wave_sum(s0) * (1.f / DM) + RMS_EPS), r1 = rsqrtf(wave_sum(s1) * (1.f / DM) + RMS_EPS);
#pragma unroll
    for (int j = 0; j < 8; ++j) { const f32x4 gg = gr[64 * j]; xr0[64 * j] = v0[j] * r0 * gg; xr1[64 * j] = v1[j] * r1 * gg; }
}

__device__ __forceinline__ void phase_prologue(const Args& a, LAS unsigned char* lds, int wv_) { LAUNDER_IDS;
    const int tid = tidx_, lane = tid & 63, wave = tid >> 6;
    unsigned char* ws = a.ws;
    LAS float* scr = (LAS float*)(lds + wave * 16384);
    const int gw = bidx_ * 8 + wave, NGW = gridDim.x * 8;
    constexpr int I_GU = (DM / 64) * (DFF / 32), I_D = (DFF / 64) * (DM / 32), I_IN = (DM / 64) * (NIN / 32), I_UQ = (512 / 64) * (NQ / 32), I_UKV = (512 / 64) * (NKV / 32),
                  I_SQ = (DM / 64) * (DM / 32), I_G = 64 * 8;
    constexpr int NITEMS = 4 * I_GU + 2 * I_D + I_IN + I_UQ + I_UKV + 3 * I_SQ + I_G;
    for (int it = gw; it < NITEMS; it += NGW) {
        int r = it;
        if (r < I_GU) { transpose_item(a.in[3], DM, DFF, (bf16_t*)(ws + WS_W1GU), 1, 0, scr, r, lane); continue; } r -= I_GU;
        if (r < I_GU) { transpose_item(a.in[4], DM, DFF, (bf16_t*)(ws + WS_W1GU), 1, 128, scr, r, lane); continue; } r -= I_GU;
        if (r < I_GU) { transpose_item(a.in[23], DM, DFF, (bf16_t*)(ws + WS_W2GU), 1, 0, scr, r, lane); continue; } r -= I_GU;
        if (r < I_GU) { transpose_item(a.in[24], DM, DFF, (bf16_t*)(ws + WS_W2GU), 1, 128, scr, r, lane); continue; } r -= I_GU;
        if (r < I_D) { transpose_item(a.in[5], DFF, DM, (bf16_t*)(ws + WS_W1D), 0, 0, scr, r, lane); continue; } r -= I_D;
        if (r < I_D) { transpose_item(a.in[25], DFF, DM, (bf16_t*)(ws + WS_W2D), 0, 0, scr, r, lane); continue; } r -= I_D;
        if (r < I_IN) { transpose_item(a.in[7], DM, NIN, (bf16_t*)(ws + WS_WIN), 2, 0, scr, r, lane); continue; } r -= I_IN;
        if (r < I_UQ) { transpose_item(a.in[9], 512, NQ, (bf16_t*)(ws + WS_WUQ), 3, 0, scr, r, lane); continue; } r -= I_UQ;
        if (r < I_UKV) { transpose_item(a.in[11], 512, NKV, (bf16_t*)(ws + WS_WUKV), 0, 0, scr, r, lane); continue; } r -= I_UKV;
        if (r < I_SQ) { transpose_item(a.in[12], DM, DM, (bf16_t*)(ws + WS_WOA), 0, 0, scr, r, lane); continue; } r -= I_SQ;
        if (r < I_SQ) { transpose_item(a.in[20], DM, DM, (bf16_t*)(ws + WS_WOR), 0, 0, scr, r, lane); continue; } r -= I_SQ;
        if (r < I_SQ) { transpose_item(a.in[21], DM, DM, (bf16_t*)(ws + WS_WOUT), 0, 0, scr, r, lane); continue; } r -= I_SQ;
        { const int mat = r >> 3, sub = r & 7, type = mat & 1, db = mat >> 1;
          transpose_item((type ? a.in[17] : a.in[15]) + (size_t)db * 128 * 128, 128, 128, (bf16_t*)(ws + WS_WG), 0, mat * 128, scr, sub, lane); }
    }
    { const int gt = bidx_ * 512 + tid, NT = gridDim.x * 512; u32x4* p = (u32x4*)((bf16_t*)(ws + WS_WIN) + (size_t)NIN * DM);
      unsigned z = 0u; asm volatile("" : "+v"(z));
      for (int i = gt; i < (NINP - NIN) * DM / 8; i += NT) p[i] = (u32x4){z, z, z, z}; }
    { const int gt = bidx_ * 512 + tid, NT = gridDim.x * 512; float* cosT = (float*)(ws + WS_COS); float* sinT = (float*)(ws + WS_SIN); float* c8 = (float*)(ws + WS_C8);
      for (int i = gt; i < SEQ * 32; i += NT) { const int pos = i >> 5, j = i & 31;
          const float inv = __builtin_amdgcn_exp2f(-(float)j * 0.41524101186092029f);
          const float ang = (float)pos * inv;
          const double t = (double)ang * 0.15915494309189535; const float fr = (float)(t - __builtin_floor(t));
          cosT[i] = __builtin_amdgcn_cosf(fr); sinT[i] = __builtin_amdgcn_sinf(fr); }
      for (int i = gt; i < 2 * DM; i += NT) { const float l = a.in[19][i]; const float x = __expf(-l);
          const float ser = x * (1.0f - x * (0.5f - x * (0.33333334f - x * (0.25f - x * 0.2f))));
          const float sp = (-l > 20.f) ? -l : (x < 0.05f ? ser : __logf(1.0f + x)); c8[i] = 8.0f * sp; } }
    for (int m = 2 * gw; m < MTOT; m += 2 * NGW) { const float* xr = m < SEQ ? a.in[0] + (size_t)m * DM : a.in[1] + (size_t)(m - SEQ) * DM;
        rms_row2_bf16(xr, xr + DM, a.in[2], (bf16_t*)(ws + WS_H) + (size_t)m * DM, (bf16_t*)(ws + WS_H) + (size_t)(m + 1) * DM, lane); }
}

__device__ __forceinline__ void phase_norm(const Args& a, const float* g, int wv_) { LAUNDER_IDS;
    const int lane = tidx_ & 63, gw = bidx_ * 8 + (tidx_ >> 6), NGW = gridDim.x * 8;
    for (int m = 2 * gw; m < MTOT; m += 2 * NGW) rms_row2_bf16(a.out + (size_t)m * DM, a.out + (size_t)(m + 1) * DM, g, (bf16_t*)(a.ws + WS_H) + (size_t)m * DM, (bf16_t*)(a.ws + WS_H) + (size_t)(m + 1) * DM, lane);
}
__device__ __forceinline__ void phase_final_norm(const Args& a, int wv_) { LAUNDER_IDS;
    const int lane = tidx_ & 63, gw = bidx_ * 8 + (tidx_ >> 6), NGW = gridDim.x * 8;
    for (int m = 2 * gw; m < MTOT; m += 2 * NGW) rms_row2_f32_inplace(a.out + (size_t)m * DM, a.out + (size_t)(m + 1) * DM, a.in[26], lane);
}

__device__ __forceinline__ void phase_small(const Args& a, int wv_) { LAUNDER_IDS;
    unsigned char* ws = a.ws; const int tid = tidx_, lane = tid & 63, gw = bidx_ * 8 + (tid >> 6), NGW = gridDim.x * 8;
    const bf16_t* proj = (const bf16_t*)(ws + WS_PROJ);
    for (int row = gw; row < SEQ; row += NGW) {
        const u32x4 wq = *(const u32x4*)(proj + (size_t)row * NINP + C_CQ + lane * 8), wk = *(const u32x4*)(proj + (size_t)row * NINP + C_CKV + lane * 8);
        const unsigned pw = *(const unsigned*)(proj + (size_t)row * NINP + C_KPE + 2 * (lane & 31));
        const f32x4 gq0 = *(const f32x4*)(a.in[8] + lane * 8), gq1 = *(const f32x4*)(a.in[8] + lane * 8 + 4), gk0 = *(const f32x4*)(a.in[10] + lane * 8), gk1 = *(const f32x4*)(a.in[10] + lane * 8 + 4);
        const float c = ((const float*)(ws + WS_COS))[row * 32 + (lane & 31)], sn = ((const float*)(ws + WS_SIN))[row * 32 + (lane & 31)];
        float vq[8] = {bf2f(wq.x & 0xffffu), bf2f(wq.x >> 16), bf2f(wq.y & 0xffffu), bf2f(wq.y >> 16), bf2f(wq.z & 0xffffu), bf2f(wq.z >> 16), bf2f(wq.w & 0xffffu), bf2f(wq.w >> 16)};
        float vk[8] = {bf2f(wk.x & 0xffffu), bf2f(wk.x >> 16), bf2f(wk.y & 0xffffu), bf2f(wk.y >> 16), bf2f(wk.z & 0xffffu), bf2f(wk.z >> 16), bf2f(wk.w & 0xffffu), bf2f(wk.w >> 16)};
        float sq = 0.f, sk = 0.f;
#pragma unroll
        for (int j = 0; j < 8; ++j) { sq += vq[j] * vq[j]; sk += vk[j] * vk[j]; }
        const float rq = rsqrtf(wave_sum(sq) * (1.f / 512.f) + RMS_EPS), rk = rsqrtf(wave_sum(sk) * (1.f / 512.f) + RMS_EPS);
        u32x4 oq, ok;
        oq.x = cvt_pk_bf16(vq[0] * rq * gq0.x, vq[1] * rq * gq0.y); oq.y = cvt_pk_bf16(vq[2] * rq * gq0.z, vq[3] * rq * gq0.w); oq.z = cvt_pk_bf16(vq[4] * rq * gq1.x, vq[5] * rq * gq1.y); oq.w = cvt_pk_bf16(vq[6] * rq * gq1.z, vq[7] * rq * gq1.w);
        ok.x = cvt_pk_bf16(vk[0] * rk * gk0.x, vk[1] * rk * gk0.y); ok.y = cvt_pk_bf16(vk[2] * rk * gk0.z, vk[3] * rk * gk0.w); ok.z = cvt_pk_bf16(vk[4] * rk * gk1.x, vk[5] * rk * gk1.y); ok.w = cvt_pk_bf16(vk[6] * rk * gk1.z, vk[7] * rk * gk1.w);
        *(u32x4*)((bf16_t*)(ws + WS_CQN) + (size_t)row * 512 + lane * 8) = oq; *(u32x4*)((bf16_t*)(ws + WS_CKVN) + (size_t)row * 512 + lane * 8) = ok;
        if (lane < 32) { const float x1 = bf2f(pw & 0xffffu), x2 = bf2f(pw >> 16); *(unsigned*)((bf16_t*)(ws + WS_KPE) + (size_t)row * 64 + 2 * lane) = cvt_pk_bf16(x1 * c - x2 * sn, x2 * c + x1 * sn); }
    }
    const int gt = bidx_ * 512 + tid, NT = gridDim.x * 512; bf16_t* xc = (bf16_t*)(ws + WS_XC);
    for (int i = gt; i < (SEQ / 4) * (DM / 8); i += NT) {
        const int r0 = (i >> 8) * 4, c0 = (i & 255) * 8;
        u32x4 xr[7]; unsigned z = 0u; asm volatile("" : "+v"(z));
#pragma unroll
        for (int k = 0; k < 7; ++k) { const int t = r0 + k - 2; xr[k] = (t >= 0 && t < SEQ) ? *(const u32x4*)(proj + (size_t)t * NINP + C_XREC + c0) : (u32x4){z, z, z, z}; }
        f32x4 wlo[4], whi[4];
#pragma unroll
        for (int k = 0; k < 4; ++k) { wlo[k] = *(const f32x4*)(a.in[13] + k * DM + c0); whi[k] = *(const f32x4*)(a.in[13] + k * DM + c0 + 4); }
        const f32x4 b0 = *(const f32x4*)(a.in[14] + c0), b1 = *(const f32x4*)(a.in[14] + c0 + 4);
#pragma unroll
        for (int r = 0; r < 4; ++r) { f32x4 lo = b0, hi = b1;
#pragma unroll
            for (int k = 0; k < 4; ++k) { const u32x4 w = xr[r + k];
                lo += (f32x4){bf2f(w.x & 0xffffu), bf2f(w.x >> 16), bf2f(w.y & 0xffffu), bf2f(w.y >> 16)} * wlo[k]; hi += (f32x4){bf2f(w.z & 0xffffu), bf2f(w.z >> 16), bf2f(w.w & 0xffffu), bf2f(w.w >> 16)} * whi[k]; }
            u32x4 o; o.x = cvt_pk_bf16(lo[0], lo[1]); o.y = cvt_pk_bf16(lo[2], lo[3]); o.z = cvt_pk_bf16(hi[0], hi[1]); o.w = cvt_pk_bf16(hi[2], hi[3]);
            *(u32x4*)(xc + (size_t)(r0 + r) * DM + c0) = o; }
    }
}

__device__ __forceinline__ void phase_scan1(const Args& a, int wv_) { LAUNDER_IDS;
    unsigned char* ws = a.ws; const int tid = tidx_;
    for (int it = bidx_; it < 1024; it += gridDim.x) {
        const int half = it & 1, dir = (it >> 1) & 1, c = it >> 2, ch = half * 1024 + tid * 2;
        const bf16_t* A = (const bf16_t*)(ws + (dir ? WS_AB : WS_AF)) + ch; const bf16_t* U = (const bf16_t*)(ws + (dir ? WS_UB : WS_UF)) + ch;
        f32x2 P = {1.f, 1.f}, Hh = {0.f, 0.f};
        unsigned awv[32], uwv[32];
#pragma unroll
        for (int i = 0; i < 32; ++i) { const int t = dir ? (c * 32 + 31 - i) : (c * 32 + i); awv[i] = *(const unsigned*)(A + (size_t)t * DM); uwv[i] = *(const unsigned*)(U + (size_t)t * DM); }
#pragma unroll
        for (int i = 0; i < 32; ++i) { const unsigned aw = awv[i], uw = uwv[i];
            const f32x2 av = {1.0f - bf2f(aw & 0xffffu), 1.0f - bf2f(aw >> 16)}, uv = {bf2f(uw & 0xffffu), bf2f(uw >> 16)}; Hh = av * Hh + uv; P = P * av; }
        *(f32x2*)((float*)(ws + WS_AGGA) + (size_t)(dir * 256 + c) * DM + ch) = P; *(f32x2*)((float*)(ws + WS_AGGB) + (size_t)(dir * 256 + c) * DM + ch) = Hh;
    }
}
__device__ __forceinline__ void phase_scan15(const Args& a, LAS unsigned char* lds, int wv_) { LAUNDER_IDS;
    if (bidx_ >= 32) return;
    unsigned char* ws = a.ws; const int tid = tidx_, seg = tid >> 6, cpl = tid & 63, idx = bidx_ * 64 + cpl, dir = idx >> 10, ch = (idx & 1023) * 2;
    const float* GA = (const float*)(ws + WS_AGGA) + (size_t)dir * 256 * DM + ch; const float* GB = (const float*)(ws + WS_AGGB) + (size_t)dir * 256 * DM + ch; float* CR = (float*)(ws + WS_CARRY) + (size_t)dir * 256 * DM + ch;
    LAS f32x4* seg_agg = (LAS f32x4*)lds;
    f32x2 A = {1.f, 1.f}, B = {0.f, 0.f};
#pragma unroll 8
    for (int i = 0; i < 32; ++i) { const int c = dir ? 255 - (seg * 32 + i) : seg * 32 + i; const f32x2 av = *(const f32x2*)(GA + (size_t)c * DM), bv = *(const f32x2*)(GB + (size_t)c * DM); B = av * B + bv; A = A * av; }
    seg_agg[seg * 64 + cpl] = (f32x4){A.x, A.y, B.x, B.y};
    __syncthreads();
    f32x2 carry = {0.f, 0.f};
    for (int k = 0; k < seg; ++k) { const f32x4 g = seg_agg[k * 64 + cpl]; carry = (f32x2){g.x, g.y} * carry + (f32x2){g.z, g.w}; }
    __syncthreads();
#pragma unroll 8
    for (int i = 0; i < 32; ++i) { const int c = dir ? 255 - (seg * 32 + i) : seg * 32 + i; *(f32x2*)(CR + (size_t)c * DM) = carry; const f32x2 av = *(const f32x2*)(GA + (size_t)c * DM), bv = *(const f32x2*)(GB + (size_t)c * DM); carry = av * carry + bv; }
}
__device__ __forceinline__ void phase_scan2(const Args& a, int wv_) { LAUNDER_IDS;
    unsigned char* ws = a.ws; const int tid = tidx_;
    const bf16_t* proj = (const bf16_t*)(ws + WS_PROJ); bf16_t* yg = (bf16_t*)(ws + WS_YG);
    for (int it = bidx_; it < 512; it += gridDim.x) {
        const int half = it & 1, c = it >> 1, ch = half * 1024 + tid * 2;
        const bf16_t* AF = (const bf16_t*)(ws + WS_AF) + ch; const bf16_t* UF = (const bf16_t*)(ws + WS_UF) + ch; const bf16_t* AB = (const bf16_t*)(ws + WS_AB) + ch; const bf16_t* UB = (const bf16_t*)(ws + WS_UB) + ch;
        f32x2 hf[32]; f32x2 h = *(const f32x2*)((const float*)(ws + WS_CARRY) + (size_t)c * DM + ch);
        { unsigned awv[32], uwv[32];
#pragma unroll
          for (int i = 0; i < 32; ++i) { const int t = c * 32 + i; awv[i] = *(const unsigned*)(AF + (size_t)t * DM); uwv[i] = *(const unsigned*)(UF + (size_t)t * DM); }
#pragma unroll
          for (int i = 0; i < 32; ++i) { const unsigned aw = awv[i], uw = uwv[i];
            const f32x2 av = {1.0f - bf2f(aw & 0xffffu), 1.0f - bf2f(aw >> 16)}, uv = {bf2f(uw & 0xffffu), bf2f(uw >> 16)}; h = av * h + uv; hf[i] = h; } }
        h = *(const f32x2*)((const float*)(ws + WS_CARRY) + (size_t)(256 + c) * DM + ch);
        { unsigned awv[32], uwv[32], gwv[32];
#pragma unroll
          for (int i = 0; i < 32; ++i) { const int t = c * 32 + i; awv[i] = *(const unsigned*)(AB + (size_t)t * DM); uwv[i] = *(const unsigned*)(UB + (size_t)t * DM); gwv[i] = *(const unsigned*)(proj + (size_t)t * NINP + C_GREC + ch); }
#pragma unroll
          for (int i = 31; i >= 0; --i) { const int t = c * 32 + i; const unsigned aw = awv[i], uw = uwv[i], gw = gwv[i];
            const f32x2 av = {1.0f - bf2f(aw & 0xffffu), 1.0f - bf2f(aw >> 16)}, uv = {bf2f(uw & 0xffffu), bf2f(uw >> 16)}; h = av * h + uv;
            const f32x2 hs = hf[i] + h;
            *(unsigned*)(yg + (size_t)t * DM + ch) = cvt_pk_bf16(gelu_tanh(bf2f(gw & 0xffffu)) * hs.x, gelu_tanh(bf2f(gw >> 16)) * hs.y); } }
    }
}

__device__ __forceinline__ void phase_attention(const Args& a, char* lds, int wv_) { LAUNDER_IDS;
    unsigned char* ws = a.ws; const int G = gridDim.x, bx = bidx_; const int vcu = (G % 8 == 0) ? (bx % 8) * (G / 8) + bx / 8 : bx;
    const bf16_t* Q = (const bf16_t*)(ws + WS_Q); const bf16_t* KV = (const bf16_t*)(ws + WS_KV); const bf16_t* KPE = (const bf16_t*)(ws + WS_KPE); bf16_t* O = (bf16_t*)(ws + WS_ATTO);
    for (int u = vcu; u < 512; u += G) { const int h = u >> 5, qb = u & 31;
        att::attn_unit(Q + (size_t)qb * 256 * NQ + h * 192, KV + h * 256, KV + h * 256 + 128, KPE, O + (size_t)qb * 256 * DM + h * 128, SEQ, lds, wv_); }
}

__device__ __forceinline__ void phase_ffn_up(const Args& a, LAS unsigned char* lds, int which, int wv_) {
    pg8::Gemm g{(const bf16_t*)(a.ws + WS_H), (const bf16_t*)(a.ws + (which ? WS_W2GU : WS_W1GU))};
    pg8::EpiSwiglu E{(bf16_t*)(a.ws + WS_ACT), DFF};
    pg8::gemm_phase<pg8::EpiSwiglu, MTOT, 2 * DFF, DM, DM, 0, 0>(lds, g, E, wv_);
}
__device__ __forceinline__ void phase_ffn_down(const Args& a, LAS unsigned char* lds, int which, int wv_) {
    pg8::Gemm g{(const bf16_t*)(a.ws + WS_ACT), (const bf16_t*)(a.ws + (which ? WS_W2D : WS_W1D))};
    pg8::EpiResid E{which ? a.out : a.in[0], which ? a.out : a.in[1], which ? MTOT : SEQ, a.out, 0.5f, 0};
    pg8::gemm_phase<pg8::EpiResid, MTOT, DM, DFF, DFF, 0, 0>(lds, g, E, wv_);
}
__device__ __forceinline__ void phase_wout(const Args& a, LAS unsigned char* lds, int s, int wv_) {
    pg8::Gemm g{(const bf16_t*)(a.ws + WS_H), (const bf16_t*)(a.ws + WS_WOUT)};
    pg8::EpiResid E{a.out, a.out, MTOT, a.out, 1.0f, 0};
    pg8::gemm_phase<pg8::EpiResid, MTOT, DM, DM, DM, 0, 0>(lds, g, E, wv_);
}
__device__ __forceinline__ void phase_win(const Args& a, LAS unsigned char* lds, int s, int wv_) {
    pg8::Gemm g{(const bf16_t*)(a.ws + WS_H) + (size_t)s * SEQ * DM, (const bf16_t*)(a.ws + WS_WIN)}; pg8::EpiBf16 E{(bf16_t*)(a.ws + WS_PROJ), NINP};
    pg8::gemm_phase<pg8::EpiBf16, SEQ, NINP, DM, DM, 0, 0>(lds, g, E, wv_);
}
__device__ __forceinline__ void phase_kv(const Args& a, LAS unsigned char* lds, int wv_) {
    pg8::Gemm g{(const bf16_t*)(a.ws + WS_CKVN), (const bf16_t*)(a.ws + WS_WUKV)}; pg8::EpiBf16 E{(bf16_t*)(a.ws + WS_KV), NKV};
    pg8::gemm_phase<pg8::EpiBf16, SEQ, NKV, 512, 512, 0, 0>(lds, g, E, wv_);
}

__device__ __forceinline__ void run_phase(const Args& a, int ph, unsigned char* lds_g, int wv_) {
    LAS unsigned char* lds = (LAS unsigned char*)lds_g; unsigned char* ws = a.ws;
    if (ph == 0) { if (PHM(0)) phase_prologue(a, lds, wv_); return; }
    if (ph == 1 || ph == 41) { if (PHM(1)) phase_ffn_up(a, lds, ph == 41, wv_); return; }
    if (ph == 2 || ph == 42) { if (PHM(2)) phase_ffn_down(a, lds, ph == 42, wv_); return; }
    if (ph == 3) { if (PHM(3)) phase_norm(a, a.in[6], wv_); return; }
    if (ph == 40) { if (PHM(3)) phase_norm(a, a.in[22], wv_); return; }
    if (ph == 39) { if (PHM(16)) phase_wout(a, lds, 0, wv_); return; }
    if (ph == 43) { if (PHM(4)) phase_final_norm(a, wv_); return; }
    const int s = (ph - 4) / 7, sub = (ph - 4) % 7;
    switch (sub) {
    case 0: if (PHM(5)) phase_win(a, lds, s, wv_); break;
    case 1: if (PHM(6)) phase_small(a, wv_); break;
    case 2: {
        if (PHM(7)) { pg8::Gemm g{(const bf16_t*)(ws + WS_CQN), (const bf16_t*)(ws + WS_WUQ)}; pg8::EpiQ E{(bf16_t*)(ws + WS_Q), (const float*)(ws + WS_COS), (const float*)(ws + WS_SIN)};
          pg8::gemm_phase<pg8::EpiQ, SEQ, NQ, 512, 512, 0, 0>(lds, g, E, wv_); }
        if (PHM(15)) phase_kv(a, lds, wv_);
        if (PHM(8)) { pg8::Gemm g{(const bf16_t*)(ws + WS_XC), (const bf16_t*)(ws + WS_WG)};
          pg8::EpiGates E{(const bf16_t*)(ws + WS_XC), a.in[16], a.in[18], (const float*)(ws + WS_C8), (bf16_t*)(ws + WS_AF), (bf16_t*)(ws + WS_UF), (size_t)(WS_AB - WS_AF) / 2};
          pg8::gemm_phase<pg8::EpiGates, SEQ, 8192, 128, DM, 16, 128>(lds, g, E, wv_); }
        break; }
    case 3: if (PHM(9)) phase_attention(a, (char*)lds_g, wv_); if (PHM(10)) phase_scan1(a, wv_); break;
    case 4: {
        if (PHM(11)) phase_scan15(a, lds, wv_);
        if (PHM(12)) { pg8::Gemm g{(const bf16_t*)(ws + WS_ATTO), (const bf16_t*)(ws + WS_WOA)}; pg8::EpiT1 E{(const bf16_t*)(ws + WS_PROJ) + C_GA, NINP, (bf16_t*)(ws + WS_T1)};
        pg8::gemm_phase<pg8::EpiT1, SEQ, DM, DM, DM, 0, 0>(lds, g, E, wv_); } break; }
    case 5: if (PHM(13)) phase_scan2(a, wv_); break;
    case 6: {
        if (PHM(14)) { pg8::Gemm g{(const bf16_t*)(ws + WS_YG), (const bf16_t*)(ws + WS_WOR)}; pg8::EpiMerge E{(const bf16_t*)(ws + WS_PROJ) + C_GR, NINP, (const bf16_t*)(ws + WS_T1), (bf16_t*)(ws + WS_H) + (size_t)s * SEQ * DM};
        pg8::gemm_phase<pg8::EpiMerge, SEQ, DM, DM, DM, 0, 0>(lds, g, E, wv_); } break; }
    default: break;
    }
}

__global__ void __launch_bounds__(512, 2) mega(Args a) {
    extern __shared__ __attribute__((aligned(16))) unsigned char lds[];
    cg::grid_group grid = cg::this_grid();
    const int wv_ = __builtin_amdgcn_readfirstlane(threadIdx.x >> 6);
    volatile LAS unsigned* misc = (volatile LAS unsigned*)((LAS unsigned char*)lds + (LDS_BYTES - 64));
    if (threadIdx.x < 2) misc[threadIdx.x] = 0u;
    __syncthreads();
    XcdBarrier bar = xcd_barrier_post((unsigned*)(a.ws + WS_CTL), misc);
    for (int ph = a.ph_lo; ph < a.ph_hi; ++ph) {
#ifdef PROBE_REPEAT
        if (PROBE_REPEAT(ph)) { run_phase(a, ph, lds, wv_); xcd_barrier(bar); }
#endif
        run_phase(a, ph, lds, wv_);
        if (ph + 1 < a.ph_hi) { if (ph == a.ph_lo) grid.sync(); else xcd_barrier(bar); }
    }
}

extern "C" void kernel_launch(void* const* d_in, const int* in_sizes, int n_in, void* d_out, int out_size, void* d_ws, size_t ws_size, hipStream_t stream) {
    static int grid = 0;
    if (grid == 0) {
        if (n_in != 27 || out_size != MTOT * DM || ws_size < WS_END) { fprintf(stderr, "kernel_launch: unexpected shapes: n_in %d out %d ws %zu (need %zu)\n", n_in, out_size, ws_size, (size_t)WS_END); grid = -1; return; }
        int dev = 0, cus = 0, per_cu = 0;
        (void)hipGetDevice(&dev); (void)hipDeviceGetAttribute(&cus, hipDeviceAttributeMultiprocessorCount, dev);
        if (hipFuncSetAttribute((const void*)mega, hipFuncAttributeMaxDynamicSharedMemorySize, LDS_BYTES) != hipSuccess) { fprintf(stderr, "kernel_launch: hipFuncSetAttribute failed\n"); grid = -1; return; }
        (void)hipOccupancyMaxActiveBlocksPerMultiprocessor(&per_cu, (const void*)mega, 512, LDS_BYTES);
        if (per_cu < 1) { fprintf(stderr, "kernel_launch: occupancy query says %d blocks/CU\n", per_cu); per_cu = 1; }
        (void)hipGetLastError();
        grid = cus;
    }
    if (grid < 0) return;
    if (hipMemsetAsync((char*)d_ws + WS_CTL, 0, CTL_BYTES, stream) != hipSuccess) { fprintf(stderr, "kernel_launch: hipMemsetAsync failed\n"); return; }
    Args a{};
    for (int i = 0; i < 27; ++i) a.in[i] = (const float*)d_in[i];
    a.out = (float*)d_out; a.ws = (unsigned char*)d_ws;
#if MK_ONE_LAUNCH
    a.ph_lo = 0; a.ph_hi = NPH;
    { void* args[] = {&a}; hipError_t e = hipLaunchCooperativeKernel((const void*)mega, dim3(grid), dim3(512), args, LDS_BYTES, stream);
      if (e != hipSuccess) fprintf(stderr, "cooperative launch failed: %s (grid %d)\n", hipGetErrorString(e), grid); }
#else
    for (int ph = 0; ph < NPH; ++ph) {
        a.ph_lo = ph; a.ph_hi = ph + 1;
        void* args[] = {&a}; hipError_t e = hipLaunchCooperativeKernel((const void*)mega, dim3(grid), dim3(512), args, LDS_BYTES, stream);
        if (e != hipSuccess) { fprintf(stderr, "cooperative launch %d failed: %s (grid %d)\n", ph, hipGetErrorString(e), grid); break; }
    }
#endif
}
```

```cpp
#include <hip/hip_runtime.h>
#include <hip/hip_cooperative_groups.h>
#include <cstdio>
#include <cstdint>
namespace cg = cooperative_groups;

#ifndef MK_ONE_LAUNCH
#define MK_ONE_LAUNCH 1
#endif
#ifndef PH_MASK
#define PH_MASK 0xffffffffu
#endif
#define PHM(k) (((PH_MASK) >> (k)) & 1u)
#define LANE_ID_ASM(l) asm volatile("v_mbcnt_lo_u32_b32 %0, -1, 0\n\tv_mbcnt_hi_u32_b32 %0, -1, %0" : "=v"(l))
#define LAUNDER_IDS int tidx_; LANE_ID_ASM(tidx_); tidx_ += wv_ * 64; int bidx_ = blockIdx.x; asm volatile("" : "+s"(bidx_))

#define LAS __attribute__((address_space(3)))
typedef unsigned short bf16_t;
typedef short bf16x8 __attribute__((ext_vector_type(8)));
typedef short s16x4 __attribute__((ext_vector_type(4)));
typedef float f32x4 __attribute__((ext_vector_type(4)));
typedef float f32x2 __attribute__((ext_vector_type(2)));
typedef float f32x16 __attribute__((ext_vector_type(16)));
typedef unsigned u32x4 __attribute__((ext_vector_type(4)));
typedef unsigned u32x2 __attribute__((ext_vector_type(2)));

constexpr int DM = 2048, SEQ = 8192, NSEQ = 5, MTOT = NSEQ * SEQ, DFF = 5632;
constexpr int NIN = 9280, NINP = 9472;
constexpr int NQ = 3072, NKV = 4096;
constexpr int C_CQ = 0, C_CKV = 512, C_KPE = 1024, C_XREC = 1088, C_GREC = 3136, C_GA = 5184, C_GR = 7232;
constexpr float RMS_EPS = 1e-6f;
constexpr float QSCALE = 0.07216878364870322f * 1.4426950408889634f;

constexpr size_t MiB = 1u << 20;
constexpr size_t WS_COS = 0, WS_SIN = 1 * MiB, WS_C8 = 2 * MiB, WS_CTL = 3 * MiB, CTL_BYTES = 16384;
constexpr size_t WS_W1GU = 4 * MiB, WS_W1D = 48 * MiB, WS_W2GU = 70 * MiB, WS_W2D = 114 * MiB, WS_WIN = 136 * MiB, WS_WUQ = 173 * MiB,
                 WS_WUKV = 176 * MiB, WS_WOA = 180 * MiB, WS_WOR = 188 * MiB, WS_WOUT = 196 * MiB, WS_WG = 204 * MiB;
constexpr size_t WS_H = 206 * MiB, WS_ACT = 366 * MiB;
constexpr size_t WS_PROJ = 366 * MiB, WS_CQN = 514 * MiB, WS_CKVN = 522 * MiB, WS_KPE = 530 * MiB, WS_XC = 532 * MiB, WS_MERGED = 532 * MiB,
                 WS_Q = 564 * MiB, WS_KV = 612 * MiB, WS_T1 = 564 * MiB, WS_AF = 676 * MiB, WS_UF = 740 * MiB, WS_AB = 804 * MiB, WS_UB = 868 * MiB,
                 WS_ATTO = 932 * MiB, WS_YG = 964 * MiB, WS_AGGA = 996 * MiB, WS_AGGB = 1000 * MiB, WS_CARRY = 1004 * MiB, WS_END = 1008 * MiB;

constexpr int LDS_BYTES = 135168;
constexpr int NPH = 44;
#ifndef FFN_UP_WG
#define FFN_UP_WG 8
#endif

__device__ __forceinline__ float bf2f(unsigned b) { return __uint_as_float(b << 16); }
__device__ __forceinline__ unsigned cvt_pk_bf16(float lo, float hi) { unsigned r; asm volatile("v_cvt_pk_bf16_f32 %0, %1, %2" : "=v"(r) : "v"(lo), "v"(hi)); return r; }
__device__ __forceinline__ float fsigmoid(float x) { return __builtin_amdgcn_rcpf(1.0f + __expf(-x)); }
__device__ __forceinline__ float wave_sum(float v) {
    v += __int_as_float(__builtin_amdgcn_ds_swizzle(__float_as_int(v), 0x041f));
    v += __int_as_float(__builtin_amdgcn_ds_swizzle(__float_as_int(v), 0x081f));
    v += __int_as_float(__builtin_amdgcn_ds_swizzle(__float_as_int(v), 0x101f));
    v += __int_as_float(__builtin_amdgcn_ds_swizzle(__float_as_int(v), 0x201f));
    v += __int_as_float(__builtin_amdgcn_ds_swizzle(__float_as_int(v), 0x401f));
    auto rr = __builtin_amdgcn_permlane32_swap(__float_as_uint(v), __float_as_uint(v), false, false);
    return __uint_as_float(rr[0]) + __uint_as_float(rr[1]);
}
__device__ __forceinline__ float gelu_tanh(float x) {
    const float z = 0.7978845608028654f * (x + 0.044715f * x * x * x);
    const float e = __expf(2.0f * z);
    const float t = 1.0f - 2.0f * __builtin_amdgcn_rcpf(1.0f + e);
    return 0.5f * x * (1.0f + t);
}

namespace pg8 {
constexpr int BM = 256, BK = 64, HALF = 128, HTB = HALF * BK * 2, STAGE_BYTES = 8 * HTB, NXCD = 8, WGM = 4;
__host__ __device__ __forceinline__ int lds_byte(int r, int c) { const int st = (r >> 4) * 2 + (c >> 5), rr = r & 15, cc = c & 31, ob = rr * 64 + cc * 2; return st * 1024 + (ob ^ (((ob >> 9) & 1) << 5)); }
__host__ __device__ __forceinline__ void stage_rc(int b, int& R, int& C) { const int st = b / 1024, sb = b % 1024, swz = sb ^ (((sb >> 9) & 1) << 5); R = (st >> 1) * 16 + swz / 64; C = (st & 1) * 32 + (swz % 64) / 2; }
__host__ __device__ __forceinline__ int perm32(int rho) { const int n = rho >> 4, i = rho & 15; return 8 * (i >> 2) + 4 * n + (i & 3); }

struct Unit { int pm, pn; };
struct Gemm { const bf16_t* A; const bf16_t* Bt; };

struct StaticOrder {
    int nM, nN, nwg, G, c, wgm;
    __device__ void init(int M, int N, int G_, int c_, int wgm_) { nM = M / BM; nN = N / BM; nwg = nM * nN; G = G_; c = c_; wgm = wgm_; }
    __device__ bool next(int i, Unit& u) const {
        const long L = (long)i * G + c; if (L >= nwg) return false;
        int wgid = (int)L; { const int q = nwg / NXCD, r = nwg % NXCD, xcd = wgid % NXCD, off = wgid / NXCD; wgid = (xcd < r ? xcd * (q + 1) : r * (q + 1) + (xcd - r) * q) + off; }
        const int nig = wgm * nN, gid = wgid / nig, fm = gid * wgm, gsz = (nM - fm) < wgm ? (nM - fm) : wgm;
        u.pm = fm + ((wgid % nig) % gsz); u.pn = (wgid % nig) / gsz; return true;
    }
};

template <class Epi, int GM, int GN, int GK, int LDA, int AMOD, int ASTRIDE, int WG = WGM>
__device__ __forceinline__ void gemm_phase(LAS unsigned char* lds, const Gemm g, const Epi& E, int wv_) {
    int tid_; LANE_ID_ASM(tid_); tid_ += wv_ * 64; int bid_ = blockIdx.x; asm volatile("" : "+s"(bid_));
    const int tid = tid_, wid = __builtin_amdgcn_readfirstlane(tid >> 6), lane = tid & 63, wr = wid >> 2, wc = wid & 3, fr = lane & 15, fq = lane >> 4;
    constexpr int K = GK, lda = LDA; int nt = K / BK; asm volatile("" : "+s"(nt));
    StaticOrder S; S.init(GM, GN, (int)gridDim.x, bid_, WG);
    unsigned voffA[2], voffB[2];
#pragma unroll
    for (int i = 0; i < 2; ++i) { int R, C; stage_rc(tid * 16 + i * 8192, R, C); const int Rb = Epi::PERM ? ((R & ~31) + perm32(R & 31)) : R;
        voffA[i] = (unsigned)(R * lda + C) * 2u; voffB[i] = (unsigned)(Rb * K + C) * 2u; }
    const size_t kstep = (size_t)(BK * 2);
    const size_t hstepA = (size_t)HALF * lda * 2, tstepA = 2 * hstepA;
    const size_t hstepB = (size_t)HALF * K * 2, tstepB = 2 * hstepB;
    const unsigned ldsw = (unsigned)wid * 1024u;
    const int aoff = lds_byte(wr * 64 + fr, fq * 8), boff = lds_byte(wc * 32 + fr, fq * 8);
#define PG8_SA(b, h) (((b) * 2 + (h)) * HTB)
#define PG8_SB(b, h) ((4 + (b) * 2 + (h)) * HTB)
#define PG8_STAGE(bufoff, gbase, voff) do { _Pragma("unroll") for (int _i = 0; _i < 2; ++_i) \
        __builtin_amdgcn_global_load_lds((const unsigned*)((const char*)(gbase) + (voff)[_i]), (LAS unsigned*)(lds + (bufoff) + ldsw + _i * 8192), 16, 0, 0); } while (0)
#define PG8_LDA(dst, b, h) do { _Pragma("unroll") for (int m = 0; m < 4; ++m) _Pragma("unroll") for (int k = 0; k < 2; ++k) dst[m][k] = *(const LAS bf16x8*)(lds + PG8_SA(b, h) + aoff + m * 2048 + k * 1024); } while (0)
#define PG8_LDB(dst, b, h) do { _Pragma("unroll") for (int n = 0; n < 2; ++n) _Pragma("unroll") for (int k = 0; k < 2; ++k) dst[n][k] = *(const LAS bf16x8*)(lds + PG8_SB(b, h) + boff + n * 2048 + k * 1024); } while (0)
#define PG8_MMA(ai, bj, At, Bt) do { __builtin_amdgcn_s_setprio(1); _Pragma("unroll") for (int m = 0; m < 4; ++m) _Pragma("unroll") for (int n = 0; n < 2; ++n) _Pragma("unroll") for (int k = 0; k < 2; ++k) \
        acc[ai][bj][m][n] = __builtin_amdgcn_mfma_f32_16x16x32_bf16(Bt[n][k], At[m][k], acc[ai][bj][m][n], 0, 0, 0); __builtin_amdgcn_s_setprio(0); } while (0)
#define PG8_WAIT_V(n) asm volatile("s_waitcnt vmcnt(" #n ")" ::: "memory")
#define PG8_WAIT_L(n) asm volatile("s_waitcnt lgkmcnt(" #n ")" ::: "memory")
#define PG8_BAR __builtin_amdgcn_s_barrier()
#define PG8_SCHED __builtin_amdgcn_sched_barrier(0)
#define PG8_AOFF(pn) (AMOD ? (size_t)((pn) % (AMOD ? AMOD : 1)) * (size_t)ASTRIDE * 2 : (size_t)0)
    Unit cur, nxt; int ui = 0;
    if (!S.next(0, cur)) return;
    f32x4 acc[2][2][4][2];
#pragma unroll
    for (int a = 0; a < 2; ++a)
#pragma unroll
        for (int b = 0; b < 2; ++b)
#pragma unroll
            for (int m = 0; m < 4; ++m)
#pragma unroll
                for (int n = 0; n < 2; ++n) acc[a][b][m][n] = (f32x4){0.f, 0.f, 0.f, 0.f};
    bf16x8 At[4][2], B0[2][2], B1[2][2];
    const char* cA = (const char*)g.A + (size_t)cur.pm * tstepA + PG8_AOFF(cur.pn); const char* cB = (const char*)g.Bt + (size_t)cur.pn * tstepB;
    PG8_STAGE(PG8_SB(0, 0), cB, voffB); PG8_STAGE(PG8_SB(0, 1), cB + hstepB, voffB); PG8_STAGE(PG8_SA(0, 0), cA, voffA); PG8_STAGE(PG8_SA(0, 1), cA + hstepA, voffA);
    if (wr == 1) PG8_BAR;
    PG8_WAIT_V(2); PG8_BAR;
    PG8_STAGE(PG8_SB(1, 0), cB + kstep, voffB); PG8_STAGE(PG8_SA(1, 0), cA + kstep, voffA); PG8_STAGE(PG8_SB(1, 1), cB + hstepB + kstep, voffB);
    PG8_WAIT_V(6); PG8_BAR;
    for (;;) {
        const bool has_next = S.next(ui + 1, nxt);
        const char* nA = has_next ? (const char*)g.A + (size_t)nxt.pm * tstepA + PG8_AOFF(nxt.pn) : cA; const char* nB = has_next ? (const char*)g.Bt + (size_t)nxt.pn * tstepB : cB;
        for (int t = 0; t < nt; t += 2) {
            const bool last = (t == nt - 2);
            const char* a1 = cA + (size_t)(t + 1) * kstep;
            const char* a2 = last ? nA : cA + (size_t)(t + 2) * kstep; const char* b2 = last ? nB : cB + (size_t)(t + 2) * kstep;
            const char* a3 = a2 + kstep; const char* b3 = b2 + kstep;
            PG8_LDB(B0, 0, 0); PG8_LDB(B1, 0, 1); PG8_SCHED; PG8_LDA(At, 0, 0); PG8_STAGE(PG8_SA(1, 1), a1 + hstepA, voffA);
            PG8_WAIT_V(8); PG8_WAIT_L(0); PG8_BAR; PG8_MMA(0, 0, At, B0); PG8_MMA(0, 1, At, B1); PG8_BAR; PG8_SCHED;
            PG8_LDA(At, 0, 1); PG8_STAGE(PG8_SB(0, 0), b2, voffB); PG8_STAGE(PG8_SB(0, 1), b2 + hstepB, voffB); PG8_STAGE(PG8_SA(0, 0), a2, voffA);
            PG8_WAIT_V(8); PG8_WAIT_L(0); PG8_BAR; PG8_MMA(1, 0, At, B0); PG8_MMA(1, 1, At, B1); PG8_BAR; PG8_SCHED;
            PG8_LDB(B0, 1, 0); PG8_LDB(B1, 1, 1); PG8_SCHED; PG8_LDA(At, 1, 0); PG8_STAGE(PG8_SA(0, 1), a2 + hstepA, voffA);
            PG8_WAIT_V(8); PG8_WAIT_L(0); PG8_BAR; PG8_MMA(0, 0, At, B0); PG8_MMA(0, 1, At, B1); PG8_BAR; PG8_SCHED;
            PG8_LDA(At, 1, 1); PG8_STAGE(PG8_SB(1, 0), b3, voffB); PG8_STAGE(PG8_SB(1, 1), b3 + hstepB, voffB); PG8_STAGE(PG8_SA(1, 0), a3, voffA);
            PG8_WAIT_V(8); PG8_WAIT_L(0); PG8_BAR; PG8_MMA(1, 0, At, B0); PG8_MMA(1, 1, At, B1); PG8_BAR; PG8_SCHED;
        }
        if (wr == 0) PG8_BAR;
        { int fr2 = fr, fq2 = fq; asm volatile("" : "+v"(fr2), "+v"(fq2)); E(acc, cur, wr, wc, fr2, fq2); }
        if (!has_next) break;
#pragma unroll
        for (int a = 0; a < 2; ++a)
#pragma unroll
            for (int b = 0; b < 2; ++b)
#pragma unroll
                for (int m = 0; m < 4; ++m)
#pragma unroll
                    for (int n = 0; n < 2; ++n) acc[a][b][m][n] = (f32x4){0.f, 0.f, 0.f, 0.f};
        cur = nxt; cA = nA; cB = nB; ++ui;
        if (wr == 1) PG8_BAR;
    }
    PG8_WAIT_V(0);
    PG8_BAR;
#undef PG8_SA
#undef PG8_SB
#undef PG8_STAGE
#undef PG8_LDA
#undef PG8_LDB
#undef PG8_MMA
#undef PG8_WAIT_V
#undef PG8_WAIT_L
#undef PG8_BAR
#undef PG8_SCHED
#undef PG8_AOFF
}

typedef f32x4 Acc[2][2][4][2];

struct EpiBf16 {
    static constexpr bool PERM = true;
    bf16_t* O; int ldc;
    __device__ __forceinline__ void operator()(const Acc& acc, const Unit& u, int wr, int wc, int fr, int fq) const {
        const int row0 = u.pm * BM + wr * 64 + fr, col0 = u.pn * BM + wc * 32 + 8 * fq;
#pragma unroll
        for (int ai = 0; ai < 2; ++ai)
#pragma unroll
            for (int m = 0; m < 4; ++m) { bf16_t* rowp = O + (size_t)(row0 + ai * HALF + m * 16) * ldc + col0;
#pragma unroll
                for (int bj = 0; bj < 2; ++bj) { const f32x4 v0 = acc[ai][bj][m][0], v1 = acc[ai][bj][m][1];
                    u32x4 w; w.x = cvt_pk_bf16(v0[0], v0[1]); w.y = cvt_pk_bf16(v0[2], v0[3]); w.z = cvt_pk_bf16(v1[0], v1[1]); w.w = cvt_pk_bf16(v1[2], v1[3]);
                    *(u32x4*)(rowp + bj * HALF) = w; } asm volatile("" ::: "memory"); }
    }
};
struct EpiSwiglu {
    static constexpr bool PERM = true;
    bf16_t* O; int ldc;
    __device__ __forceinline__ void operator()(const Acc& acc, const Unit& u, int wr, int wc, int fr, int fq) const {
        const int row0 = u.pm * BM + wr * 64 + fr, col0 = u.pn * HALF + wc * 32 + 8 * fq;
#pragma unroll
        for (int ai = 0; ai < 2; ++ai)
#pragma unroll
            for (int m = 0; m < 4; ++m) { bf16_t* rowp = O + (size_t)(row0 + ai * HALF + m * 16) * ldc + col0;
                float r[8];
#pragma unroll
                for (int n = 0; n < 2; ++n)
#pragma unroll
                    for (int j = 0; j < 4; ++j) { const float gv = acc[ai][0][m][n][j], uv = acc[ai][1][m][n][j]; r[n * 4 + j] = gv * fsigmoid(gv) * uv; }
                u32x4 w; w.x = cvt_pk_bf16(r[0], r[1]); w.y = cvt_pk_bf16(r[2], r[3]); w.z = cvt_pk_bf16(r[4], r[5]); w.w = cvt_pk_bf16(r[6], r[7]);
                *(u32x4*)rowp = w; asm volatile("" ::: "memory"); }
    }
};
struct EpiResid {
    static constexpr bool PERM = false;
    const float* res0; const float* res1; int split; float* out; float alpha; int row_base;
    __device__ __forceinline__ void operator()(const Acc& acc, const Unit& u, int wr, int wc, int fr, int fq) const {
        const int grow0 = row_base + u.pm * BM; const float* rb = grow0 < split ? res0 + (size_t)grow0 * DM : res1 + (size_t)(grow0 - split) * DM;
        float* ob = out + (size_t)grow0 * DM; const int col0 = u.pn * BM + wc * 32 + 4 * fq;
#pragma unroll
        for (int ai = 0; ai < 2; ++ai)
#pragma unroll
            for (int mp = 0; mp < 2; ++mp) {
                f32x4 bs[2][2][2];
#pragma unroll
                for (int mm = 0; mm < 2; ++mm) { const size_t off = (size_t)(ai * HALF + wr * 64 + (2 * mp + mm) * 16 + fr) * DM + col0;
#pragma unroll
                    for (int bj = 0; bj < 2; ++bj)
#pragma unroll
                        for (int n = 0; n < 2; ++n) bs[mm][bj][n] = *(const f32x4*)(rb + off + bj * HALF + n * 16); }
#pragma unroll
                for (int mm = 0; mm < 2; ++mm) { const int m = 2 * mp + mm; const size_t off = (size_t)(ai * HALF + wr * 64 + m * 16 + fr) * DM + col0;
#pragma unroll
                    for (int bj = 0; bj < 2; ++bj)
#pragma unroll
                        for (int n = 0; n < 2; ++n) *(f32x4*)(ob + off + bj * HALF + n * 16) = bs[mm][bj][n] + acc[ai][bj][m][n] * alpha; }
                asm volatile("" ::: "memory"); }
    }
};
struct EpiQ {
    static constexpr bool PERM = true;
    bf16_t* O; const float* cosT; const float* sinT;
    __device__ __forceinline__ void operator()(const Acc& acc, const Unit& u, int wr, int wc, int fr, int fq) const {
        const int row0 = u.pm * BM + wr * 64 + fr;
#pragma unroll
        for (int bj = 0; bj < 2; ++bj) { const int col0 = u.pn * BM + bj * HALF + wc * 32 + 8 * fq; const int d = col0 % 192; const bool rope = d >= 128; const int jp0 = (d - 128) >> 1;
#pragma unroll
            for (int ai = 0; ai < 2; ++ai)
#pragma unroll
                for (int m = 0; m < 4; ++m) { const int row = row0 + ai * HALF + m * 16; f32x4 v0 = acc[ai][bj][m][0], v1 = acc[ai][bj][m][1];
                    if (rope) { const f32x4 c = *(const f32x4*)(cosT + (size_t)row * 32 + jp0), s = *(const f32x4*)(sinT + (size_t)row * 32 + jp0);
                        const f32x4 a0 = v0, a1 = v1;
                        v0[0] = a0[0] * c[0] - a0[1] * s[0]; v0[1] = a0[1] * c[0] + a0[0] * s[0]; v0[2] = a0[2] * c[1] - a0[3] * s[1]; v0[3] = a0[3] * c[1] + a0[2] * s[1];
                        v1[0] = a1[0] * c[2] - a1[1] * s[2]; v1[1] = a1[1] * c[2] + a1[0] * s[2]; v1[2] = a1[2] * c[3] - a1[3] * s[3]; v1[3] = a1[3] * c[3] + a1[2] * s[3]; }
                    v0 = v0 * QSCALE; v1 = v1 * QSCALE;
                    u32x4 w; w.x = cvt_pk_bf16(v0[0], v0[1]); w.y = cvt_pk_bf16(v0[2], v0[3]); w.z = cvt_pk_bf16(v1[0], v1[1]); w.w = cvt_pk_bf16(v1[2], v1[3]);
                    *(u32x4*)(O + (size_t)row * NQ + col0) = w; asm volatile("" ::: "memory"); } }
    }
};
struct EpiGates {
    static constexpr bool PERM = true;
    const bf16_t* xc; const float* b_a; const float* b_i; const float* c8; bf16_t* Aout; bf16_t* Uout; size_t dir_stride;
    __device__ __forceinline__ void operator()(const Acc& acc, const Unit& u, int wr, int wc, int fr, int fq) const {
        const int dir = u.pn >> 4, blk = u.pn & 15; const int row0 = u.pm * BM + wr * 64 + fr; const int ch0 = blk * HALF + wc * 32 + 8 * fq;
        bf16_t* Ao = Aout + (size_t)dir * dir_stride; bf16_t* Uo = Uout + (size_t)dir * dir_stride;
        f32x4 ba[2], bi[2], cc[2];
#pragma unroll
        for (int n = 0; n < 2; ++n) { ba[n] = *(const f32x4*)(b_a + dir * DM + ch0 + 4 * n); bi[n] = *(const f32x4*)(b_i + dir * DM + ch0 + 4 * n); cc[n] = *(const f32x4*)(c8 + dir * DM + ch0 + 4 * n); }
#pragma unroll
        for (int ai = 0; ai < 2; ++ai)
#pragma unroll
            for (int m = 0; m < 4; ++m) { const int row = row0 + ai * HALF + m * 16; const size_t off = (size_t)row * DM + ch0;
                const u32x4 xw = *(const u32x4*)(xc + off);
                const float xv[8] = {bf2f(xw.x & 0xffffu), bf2f(xw.x >> 16), bf2f(xw.y & 0xffffu), bf2f(xw.y >> 16), bf2f(xw.z & 0xffffu), bf2f(xw.z >> 16), bf2f(xw.w & 0xffffu), bf2f(xw.w >> 16)};
                float om[8], uv[8];
#pragma unroll
                for (int n = 0; n < 2; ++n)
#pragma unroll
                    for (int j = 0; j < 4; ++j) { const float r = fsigmoid(acc[ai][0][m][n][j] + ba[n][j]), ig = fsigmoid(acc[ai][1][m][n][j] + bi[n][j]);
                        const float y = r * cc[n][j];
                        float o1 = y * (1.0f - y * (0.5f - y * (0.16666667f - y * (0.041666668f - y * 0.008333334f))));
                        if (__builtin_expect(__any(y >= 0.125f), 0)) { const float ome = 1.0f - __expf(-y); o1 = y < 0.125f ? o1 : ome; }
                        om[n * 4 + j] = o1; uv[n * 4 + j] = sqrtf(o1 * (2.0f - o1)) * (ig * xv[n * 4 + j]); }
                u32x4 wa, wu; wa.x = cvt_pk_bf16(om[0], om[1]); wa.y = cvt_pk_bf16(om[2], om[3]); wa.z = cvt_pk_bf16(om[4], om[5]); wa.w = cvt_pk_bf16(om[6], om[7]);
                wu.x = cvt_pk_bf16(uv[0], uv[1]); wu.y = cvt_pk_bf16(uv[2], uv[3]); wu.z = cvt_pk_bf16(uv[4], uv[5]); wu.w = cvt_pk_bf16(uv[6], uv[7]);
                *(u32x4*)(Ao + off) = wa; *(u32x4*)(Uo + off) = wu; asm volatile("" ::: "memory"); }
    }
};
struct EpiT1 {
    static constexpr bool PERM = true;
    const bf16_t* gate; int ldg; bf16_t* O;
    __device__ __forceinline__ void operator()(const Acc& acc, const Unit& u, int wr, int wc, int fr, int fq) const {
        const int row0 = u.pm * BM + wr * 64 + fr;
#pragma unroll
        for (int ai = 0; ai < 2; ++ai)
#pragma unroll
            for (int m = 0; m < 4; ++m) { const int row = row0 + ai * HALF + m * 16;
#pragma unroll
                for (int bj = 0; bj < 2; ++bj) { const int col0 = u.pn * BM + bj * HALF + wc * 32 + 8 * fq;
                    const u32x4 gw = *(const u32x4*)(gate + (size_t)row * ldg + col0); f32x4 v0 = acc[ai][bj][m][0], v1 = acc[ai][bj][m][1];
                    v0[0] *= fsigmoid(bf2f(gw.x & 0xffffu)); v0[1] *= fsigmoid(bf2f(gw.x >> 16)); v0[2] *= fsigmoid(bf2f(gw.y & 0xffffu)); v0[3] *= fsigmoid(bf2f(gw.y >> 16));
                    v1[0] *= fsigmoid(bf2f(gw.z & 0xffffu)); v1[1] *= fsigmoid(bf2f(gw.z >> 16)); v1[2] *= fsigmoid(bf2f(gw.w & 0xffffu)); v1[3] *= fsigmoid(bf2f(gw.w >> 16));
                    u32x4 w; w.x = cvt_pk_bf16(v0[0], v0[1]); w.y = cvt_pk_bf16(v0[2], v0[3]); w.z = cvt_pk_bf16(v1[0], v1[1]); w.w = cvt_pk_bf16(v1[2], v1[3]);
                    *(u32x4*)(O + (size_t)row * DM + col0) = w; } asm volatile("" ::: "memory"); }
    }
};
struct EpiMerge {
    static constexpr bool PERM = true;
    const bf16_t* gate; int ldg; const bf16_t* T1; bf16_t* O;
    __device__ __forceinline__ void operator()(const Acc& acc, const Unit& u, int wr, int wc, int fr, int fq) const {
        const int row0 = u.pm * BM + wr * 64 + fr;
#pragma unroll
        for (int ai = 0; ai < 2; ++ai)
#pragma unroll
            for (int m = 0; m < 4; ++m) { const int row = row0 + ai * HALF + m * 16;
#pragma unroll
                for (int bj = 0; bj < 2; ++bj) { const int col0 = u.pn * BM + bj * HALF + wc * 32 + 8 * fq;
                    const u32x4 gw = *(const u32x4*)(gate + (size_t)row * ldg + col0); const u32x4 tw = *(const u32x4*)(T1 + (size_t)row * DM + col0);
                    f32x4 v0 = acc[ai][bj][m][0], v1 = acc[ai][bj][m][1];
                    const f32x4 t0 = {bf2f(tw.x & 0xffffu), bf2f(tw.x >> 16), bf2f(tw.y & 0xffffu), bf2f(tw.y >> 16)}, t1 = {bf2f(tw.z & 0xffffu), bf2f(tw.z >> 16), bf2f(tw.w & 0xffffu), bf2f(tw.w >> 16)};
                    v0[0] = t0[0] + v0[0] * fsigmoid(bf2f(gw.x & 0xffffu)); v0[1] = t0[1] + v0[1] * fsigmoid(bf2f(gw.x >> 16)); v0[2] = t0[2] + v0[2] * fsigmoid(bf2f(gw.y & 0xffffu)); v0[3] = t0[3] + v0[3] * fsigmoid(bf2f(gw.y >> 16));
                    v1[0] = t1[0] + v1[0] * fsigmoid(bf2f(gw.z & 0xffffu)); v1[1] = t1[1] + v1[1] * fsigmoid(bf2f(gw.z >> 16)); v1[2] = t1[2] + v1[2] * fsigmoid(bf2f(gw.w & 0xffffu)); v1[3] = t1[3] + v1[3] * fsigmoid(bf2f(gw.w >> 16));
                    u32x4 w; w.x = cvt_pk_bf16(v0[0], v0[1]); w.y = cvt_pk_bf16(v0[2], v0[3]); w.z = cvt_pk_bf16(v1[0], v1[1]); w.w = cvt_pk_bf16(v1[2], v1[3]);
                    *(u32x4*)(O + (size_t)row * DM + col0) = w; } asm volatile("" ::: "memory"); }
    }
};
}

namespace att {
constexpr int NW = 8, QBLK = 32, KVBLK = 64;
constexpr int LDQ = NQ, LDKV = NKV, LDO = DM;
constexpr int SLOT_K = 24576, SLOT_V = 16384, KR_OFF = 16384;
constexpr int OFF_K = 0, OFF_V = 3 * SLOT_K, OFF_WS = OFF_V + 3 * SLOT_V;
constexpr float THRL = 11.0f;
#define KNSWZ(row, colB) ((row) * 256 + ((colB) ^ (((row) & 15) << 4)))
#define KRSWZ(row, colB) ((row) * 128 + ((colB) ^ ((((row) >> 1) & 7) << 4)))
#define SBAR() __builtin_amdgcn_sched_barrier(0)
__device__ __forceinline__ int crow(int r, int hi) { return (r & 3) + 8 * (r >> 2) + 4 * hi; }

template <bool FIRST>
__device__ __forceinline__ void partialSM(f32x16& p0, f32x16& p1, float& m_reg, float& mn, float& alpha) {
    float pmax = p0[0];
#pragma unroll
    for (int r = 1; r < 16; ++r) pmax = fmaxf(pmax, p0[r]);
#pragma unroll
    for (int r = 0; r < 16; ++r) pmax = fmaxf(pmax, p1[r]);
    { auto rr = __builtin_amdgcn_permlane32_swap(__float_as_uint(pmax), __float_as_uint(pmax), false, false);
      pmax = fmaxf(__uint_as_float(rr[0]), __uint_as_float(rr[1])); }
    if (FIRST) { mn = (fabsf(pmax) <= THRL) ? 0.f : pmax; m_reg = mn; alpha = 1.f; }
    else if (__builtin_expect(__all(pmax - m_reg <= THRL), 1)) { mn = m_reg; alpha = 1.f; }
    else { mn = fmaxf(m_reg, pmax); alpha = __builtin_amdgcn_exp2f(m_reg - mn); m_reg = mn; }
    if (!__builtin_expect(__all(mn == 0.f), 1)) {
#pragma unroll
        for (int r = 0; r < 16; ++r) p0[r] = p0[r] - mn;
#pragma unroll
        for (int r = 0; r < 16; ++r) p1[r] = p1[r] - mn; }
#pragma unroll
    for (int r = 0; r < 16; ++r) p0[r] = __builtin_amdgcn_exp2f(p0[r]);
}
__device__ __forceinline__ void finishSM(f32x16& p0, f32x16& p1, float alpha, float& l_reg, bf16x8& pa0, bf16x8& pa1, bf16x8& pa2, bf16x8& pa3) {
#pragma unroll
    for (int r = 0; r < 16; ++r) p1[r] = __builtin_amdgcn_exp2f(p1[r]);
    float ps = 0;
#pragma unroll
    for (int r = 0; r < 16; ++r) ps += p0[r];
#pragma unroll
    for (int r = 0; r < 16; ++r) ps += p1[r];
    { auto rr = __builtin_amdgcn_permlane32_swap(__float_as_uint(ps), __float_as_uint(ps), false, false);
      ps = __uint_as_float(rr[0]) + __uint_as_float(rr[1]); }
    l_reg = l_reg * alpha + ps;
#define PK4(P, BASE, OUT) do { unsigned a0 = cvt_pk_bf16(P[BASE + 0], P[BASE + 1]), a1 = cvt_pk_bf16(P[BASE + 2], P[BASE + 3]);   \
    unsigned b0 = cvt_pk_bf16(P[BASE + 4], P[BASE + 5]), b1 = cvt_pk_bf16(P[BASE + 6], P[BASE + 7]);                              \
    auto r0 = __builtin_amdgcn_permlane32_swap(a0, b0, false, false); auto r1 = __builtin_amdgcn_permlane32_swap(a1, b1, false, false); \
    u32x4 w = {r0[0], r1[0], r0[1], r1[1]}; OUT = *reinterpret_cast<bf16x8*>(&w); } while (0)
    PK4(p0, 0, pa0); PK4(p0, 8, pa1); PK4(p1, 0, pa2); PK4(p1, 8, pa3);
#undef PK4
}
__device__ __forceinline__ void qkt(f32x16& p0, f32x16& p1, const char* Kn, const bf16x8* qr, int r32, int hi) {
    const char* Kr = Kn + KR_OFF;
    p0 = f32x16{}; p1 = f32x16{};
    __builtin_amdgcn_s_setprio(1);
#pragma unroll
    for (int d0 = 0; d0 < 8; ++d0) { const int cb = (d0 * 16 + hi * 8) * 2;
        const bf16x8 b0 = *reinterpret_cast<const bf16x8*>(Kn + KNSWZ(r32, cb));
        const bf16x8 b1 = *reinterpret_cast<const bf16x8*>(Kn + KNSWZ(32 + r32, cb));
        p0 = __builtin_amdgcn_mfma_f32_32x32x16_bf16(b0, qr[d0], p0, 0, 0, 0);
        p1 = __builtin_amdgcn_mfma_f32_32x32x16_bf16(b1, qr[d0], p1, 0, 0, 0); }
#pragma unroll
    for (int d0 = 0; d0 < 4; ++d0) { const int cb = (d0 * 16 + hi * 8) * 2;
        const bf16x8 b0 = *reinterpret_cast<const bf16x8*>(Kr + KRSWZ(r32, cb));
        const bf16x8 b1 = *reinterpret_cast<const bf16x8*>(Kr + KRSWZ(32 + r32, cb));
        p0 = __builtin_amdgcn_mfma_f32_32x32x16_bf16(b0, qr[8 + d0], p0, 0, 0, 0);
        p1 = __builtin_amdgcn_mfma_f32_32x32x16_bf16(b1, qr[8 + d0], p1, 0, 0, 0); }
}
__device__ __forceinline__ int v_st(int k, int c) { const int kk = (k & ~0xC) | ((k & 4) << 1) | ((k & 8) >> 1); return ((kk >> 3) * 4 + (c >> 5)) * 512 + ((kk & 7) * 32 + (c & 31)) * 2; }
__device__ __forceinline__ int v_rd_base(int lane) { return ((lane & 3) << 3) | (((lane >> 2) & 3) << 6) | (((lane >> 4) & 1) << 5) | (((lane >> 5) & 1) << 8); }
constexpr int v_rd_off(int d0, int ks, int half) { return d0 * 512 + ks * 4096 + half * 2048; }
template <int OFF> __device__ __forceinline__ s16x4 tr_read(int vb) {
    s16x4 r; asm volatile("ds_read_b64_tr_b16 %0, %1 offset:%2" : "=&v"(r) : "v"(vb), "i"(OFF) : "memory"); return r;
}
template <int D0> __device__ __forceinline__ void pv_one(f32x16& od, int vb, bf16x8 pa0, bf16x8 pa1, bf16x8 pa2, bf16x8 pa3) {
    const s16x4 l0 = tr_read<v_rd_off(D0, 0, 0)>(vb), h0 = tr_read<v_rd_off(D0, 0, 1)>(vb), l1 = tr_read<v_rd_off(D0, 1, 0)>(vb), h1 = tr_read<v_rd_off(D0, 1, 1)>(vb);
    const s16x4 l2 = tr_read<v_rd_off(D0, 2, 0)>(vb), h2 = tr_read<v_rd_off(D0, 2, 1)>(vb), l3 = tr_read<v_rd_off(D0, 3, 0)>(vb), h3 = tr_read<v_rd_off(D0, 3, 1)>(vb);
    asm volatile("s_waitcnt lgkmcnt(0)" ::: "memory"); SBAR();
#define PK(L, H) (bf16x8){L[0], L[1], L[2], L[3], H[0], H[1], H[2], H[3]}
    od = __builtin_amdgcn_mfma_f32_32x32x16_bf16(pa0, PK(l0, h0), od, 0, 0, 0);
    od = __builtin_amdgcn_mfma_f32_32x32x16_bf16(pa1, PK(l1, h1), od, 0, 0, 0);
    od = __builtin_amdgcn_mfma_f32_32x32x16_bf16(pa2, PK(l2, h2), od, 0, 0, 0);
    od = __builtin_amdgcn_mfma_f32_32x32x16_bf16(pa3, PK(l3, h3), od, 0, 0, 0);
#undef PK
}
__device__ __forceinline__ void pv_d0(f32x16* o, int vb, bf16x8 pa0, bf16x8 pa1, bf16x8 pa2, bf16x8 pa3) {
    pv_one<0>(o[0], vb, pa0, pa1, pa2, pa3); pv_one<1>(o[1], vb, pa0, pa1, pa2, pa3); pv_one<2>(o[2], vb, pa0, pa1, pa2, pa3); pv_one<3>(o[3], vb, pa0, pa1, pa2, pa3);
}

__device__ __forceinline__ void attn_unit(const bf16_t* __restrict__ Qb, const bf16_t* __restrict__ Kn, const bf16_t* __restrict__ Vh, const bf16_t* __restrict__ Kr,
                                          bf16_t* __restrict__ Ob, int seq, char* lds, int wv_) { LAUNDER_IDS;
    const int tid = tidx_, wid = __builtin_amdgcn_readfirstlane(tid >> 6), lane = tid & 63, r32 = lane & 31, hi = lane >> 5;
    LAS unsigned char* lds3 = (LAS unsigned char*)lds;
    float* ws = (float*)(lds + OFF_WS) + wid * 64; float* li_l = ws; float* al_l = ws + 32;
    float m_reg = 0.f, l_reg = 0; f32x16 o[4] = {}; bf16x8 qr[12];
    const bf16_t* Qw = Qb + (long)(wid * QBLK + r32) * LDQ + hi * 8;
#pragma unroll
    for (int d0 = 0; d0 < 12; ++d0) qr[d0] = *reinterpret_cast<const bf16x8*>(Qw + d0 * 16);
    unsigned gkn[2], gv[2], gkr;
#pragma unroll
    for (int i = 0; i < 2; ++i) { const int c = wid * 2 + i; const int row = c * 4 + (lane >> 4), slot = lane & 15; gkn[i] = (unsigned)(row * (LDKV * 2) + ((slot ^ (row & 15)) << 4));
        const int st = c * 2 + (lane >> 5), kk = (st >> 2) * 8 + ((lane & 31) >> 2), k = (kk & ~0xC) | ((kk & 4) << 1) | ((kk & 8) >> 1), col = (st & 3) * 32 + (lane & 3) * 8; gv[i] = (unsigned)(k * (LDKV * 2) + col * 2); }
    { const int row = wid * 8 + (lane >> 3), slot = lane & 7; gkr = (unsigned)(row * 128 + ((slot ^ ((row >> 1) & 7)) << 4)); }
    const int vb0 = (int)(uintptr_t)(lds + OFF_V) + v_rd_base(lane);
#define DMA(t, slot) do { const char* kt_ = (const char*)Kn + (size_t)(t) * (KVBLK * LDKV * 2); const char* vt_ = (const char*)Vh + (size_t)(t) * (KVBLK * LDKV * 2); const char* rt_ = (const char*)Kr + (size_t)(t) * (KVBLK * 128); \
    _Pragma("unroll") for (int i_ = 0; i_ < 2; ++i_) { \
      __builtin_amdgcn_global_load_lds((const unsigned*)(kt_ + gkn[i_]), (LAS unsigned*)(lds3 + OFF_K + (slot) * SLOT_K + (wid * 2 + i_) * 1024), 16, 0, 0); \
      __builtin_amdgcn_global_load_lds((const unsigned*)(vt_ + gv[i_]), (LAS unsigned*)(lds3 + OFF_V + (slot) * SLOT_V + (wid * 2 + i_) * 1024), 16, 0, 0); } \
    __builtin_amdgcn_global_load_lds((const unsigned*)(rt_ + gkr), (LAS unsigned*)(lds3 + OFF_K + (slot) * SLOT_K + KR_OFF + wid * 1024), 16, 0, 0); } while (0)
#define WAIT_BAR() asm volatile("s_waitcnt vmcnt(0) lgkmcnt(0)\n\ts_barrier" ::: "memory")
#define RESC(a) do { if (__any((a) < 1.f)) { if (hi == 0) al_l[r32] = (a); asm volatile("s_waitcnt lgkmcnt(0)" ::: "memory"); \
    _Pragma("unroll") for (int d = 0; d < 4; ++d) _Pragma("unroll") for (int r = 0; r < 16; ++r) o[d][r] *= al_l[crow(r, hi)]; } } while (0)
    f32x16 pA0, pA1, pB0, pB1; float mnA, mnB, alA, alB; bf16x8 pa0, pa1, pa2, pa3; const int NT = seq / KVBLK;
    DMA(0, 0); DMA(1, 1); WAIT_BAR();
    qkt(pA0, pA1, lds + OFF_K, qr, r32, hi); __builtin_amdgcn_s_setprio(0); partialSM<true>(pA0, pA1, m_reg, mnA, alA);
    int s_prev = 0, s_cur = 1, s_next = 2;
#define ROT() do { const int t_ = s_prev; s_prev = s_cur; s_cur = s_next; s_next = t_; } while (0)
    for (int j = 1; j + 1 < NT; j += 2) {
        DMA(j + 1, s_next); SBAR();
        qkt(pB0, pB1, lds + OFF_K + s_cur * SLOT_K, qr, r32, hi);
        finishSM(pA0, pA1, alA, l_reg, pa0, pa1, pa2, pa3); __builtin_amdgcn_s_setprio(0); SBAR();
        pv_d0(o, vb0 + s_prev * SLOT_V, pa0, pa1, pa2, pa3); partialSM<false>(pB0, pB1, m_reg, mnB, alB);
        RESC(alB); WAIT_BAR(); ROT();
        DMA(j + 2, s_next); SBAR();
        qkt(pA0, pA1, lds + OFF_K + s_cur * SLOT_K, qr, r32, hi);
        finishSM(pB0, pB1, alB, l_reg, pa0, pa1, pa2, pa3); __builtin_amdgcn_s_setprio(0); SBAR();
        pv_d0(o, vb0 + s_prev * SLOT_V, pa0, pa1, pa2, pa3); partialSM<false>(pA0, pA1, m_reg, mnA, alA);
        RESC(alA); WAIT_BAR(); ROT();
    }
    SBAR(); qkt(pB0, pB1, lds + OFF_K + s_cur * SLOT_K, qr, r32, hi);
    finishSM(pA0, pA1, alA, l_reg, pa0, pa1, pa2, pa3); __builtin_amdgcn_s_setprio(0); SBAR();
    pv_d0(o, vb0 + s_prev * SLOT_V, pa0, pa1, pa2, pa3); partialSM<false>(pB0, pB1, m_reg, mnB, alB);
    RESC(alB);
    finishSM(pB0, pB1, alB, l_reg, pa0, pa1, pa2, pa3); __builtin_amdgcn_s_setprio(0); SBAR();
    pv_d0(o, vb0 + s_cur * SLOT_V, pa0, pa1, pa2, pa3);
    if (hi == 0) li_l[r32] = l_reg; asm volatile("s_waitcnt lgkmcnt(0)" ::: "memory");
    float rli[16];
#pragma unroll
    for (int r = 0; r < 16; ++r) rli[r] = __builtin_amdgcn_rcpf(li_l[crow(r, hi)]);
    bf16_t* Ow = Ob + (long)(wid * QBLK) * LDO;
#pragma unroll
    for (int r = 0; r < 16; ++r) { const int orow = crow(r, hi);
#pragma unroll
        for (int d0 = 0; d0 < 4; ++d0) Ow[(long)orow * LDO + d0 * 32 + r32] = (bf16_t)(cvt_pk_bf16(o[d0][r] * rli[r], 0.f) & 0xffffu); }
    WAIT_BAR();
#undef DMA
#undef WAIT_BAR
#undef RESC
#undef ROT
}
}


#define XB_TMO      128
#define XB_XCNT(j)  (256  + 64 * (j))
#define XB_XSUB(j)  (1280 + 64 * (j))
#define XB_XGEN(j)  (2304 + 64 * (j))
#define XB_TOP      3328
#define XB_TOPGEN   3392
#define XCD_BAR_WORDS 3456
#define XB_SPIN_CAP (1u << 22)
__device__ __forceinline__ unsigned xb_ld(unsigned* p)              { return __hip_atomic_load(p, __ATOMIC_RELAXED, __HIP_MEMORY_SCOPE_AGENT); }
__device__ __forceinline__ unsigned xb_add(unsigned* p, unsigned v) { return __hip_atomic_fetch_add(p, v, __ATOMIC_RELAXED, __HIP_MEMORY_SCOPE_AGENT); }
__device__ __forceinline__ unsigned xb_xcc_id() { return (unsigned)__builtin_amdgcn_s_getreg((3 << 11) | 20) & 0xFu; }
#define XB_SPIN(cond, bar) do { unsigned _sp = 0; while (cond) { __builtin_amdgcn_s_sleep(1); \
    if ((++_sp & 255u) == 0u) { if (xb_ld(&(bar)[XB_TMO])) break; if (_sp > XB_SPIN_CAP) { atomicAdd(&(bar)[XB_TMO], 1u); break; } } } } while (0)
struct XcdBarrier { unsigned* bar; unsigned x; volatile LAS unsigned* st; };
__device__ __forceinline__ XcdBarrier xcd_barrier_post(unsigned* bar, volatile LAS unsigned* st) {
    XcdBarrier b; b.bar = bar; b.x = xb_xcc_id(); b.st = st;
    if (threadIdx.x == 0) (void)xb_add(&bar[XB_XCNT(b.x)], 1u);
    return b;
}
__device__ __forceinline__ void xcd_barrier_complete(unsigned* bar, unsigned x, unsigned& nloc, unsigned& nx) {
    const unsigned G = gridDim.x * gridDim.y * gridDim.z;
    unsigned sum, cnt, mine, sp = 0u;
    for (;;) {
        sum = 0u; cnt = 0u; mine = 0u;
#pragma unroll
        for (unsigned j = 0; j < 16; ++j) { const unsigned c = xb_ld(&bar[XB_XCNT(j)]); sum += c; cnt += (c > 0u) ? 1u : 0u; mine = (j == x) ? c : mine; }
        if (sum == G) break;
        __builtin_amdgcn_s_sleep(1);
        if ((++sp & 255u) == 0u) { if (xb_ld(&bar[XB_TMO])) break; if (sp > XB_SPIN_CAP) { atomicAdd(&bar[XB_TMO], 1u); break; } }
    }
    nloc = mine > 0u ? mine : 1u; nx = cnt > 0u ? cnt : 1u;
}
__device__ __forceinline__ void xcd_barrier(const XcdBarrier& b) {
    asm volatile("s_waitcnt vmcnt(0)" ::: "memory");
    __syncthreads();
    if (threadIdx.x == 0) {
        unsigned* bar = b.bar;
        __builtin_amdgcn_s_waitcnt(0);
        unsigned nloc = b.st[0], nx = b.st[1];
        if (nloc == 0u) { xcd_barrier_complete(bar, b.x, nloc, nx); b.st[0] = nloc; b.st[1] = nx; }
        const unsigned old = xb_add(&bar[XB_XSUB(b.x)], 1u);
        const unsigned gen = old / nloc;
        if (old + 1u == (gen + 1u) * nloc) {
            __builtin_amdgcn_fence(__ATOMIC_RELEASE, "agent");
            asm volatile("s_waitcnt vmcnt(0)" ::: "memory");
            const unsigned og = xb_add(&bar[XB_TOP], 1u);
            const unsigned tg = og / nx;
            if (og + 1u == (tg + 1u) * nx) xb_add(&bar[XB_TOPGEN], 1u);
            else XB_SPIN(xb_ld(&bar[XB_TOPGEN]) == tg, bar);
            __builtin_amdgcn_fence(__ATOMIC_ACQUIRE, "agent");
            xb_add(&bar[XB_XGEN(b.x)], 1u);
            asm volatile("s_waitcnt vmcnt(0)" ::: "memory");
        } else {
            XB_SPIN(xb_ld(&bar[XB_XGEN(b.x)]) == gen, bar);
            __builtin_amdgcn_fence(__ATOMIC_ACQUIRE, "agent");
            asm volatile("s_waitcnt vmcnt(0)" ::: "memory");
        }
    }
    __syncthreads();
}

struct Args { const float* in[27]; float* out; unsigned char* ws; int ph_lo, ph_hi; };

__device__ __forceinline__ int map_row(int mode, int row_off, int n) {
    if (mode == 0) return row_off + n;
    if (mode == 1) return (n >> 7) * 256 + row_off + (n & 127);
    if (mode == 2) { if (n >= C_KPE && n < C_KPE + 64) { const int j = n - C_KPE; return C_KPE + (j < 32 ? 2 * j : 2 * (j - 32) + 1); } return n; }
    { const int h = n / 192, d = n % 192; if (d < 128) return n; const int j = d - 128; return h * 192 + 128 + (j < 32 ? 2 * j : 2 * (j - 32) + 1); }
}
__device__ __forceinline__ void transpose_item(const float* W, int K, int N, bf16_t* WT, int mode, int row_off, LAS float* scr, int item, int lane) {
    const int nblk = N / 32, kb = item / nblk, nb = item % nblk, k0 = 64 * kb, n0 = 32 * nb;
    float wv[32];
#pragma unroll
    for (int i = 0; i < 32; ++i) { const int kk = 2 * i + (lane >> 5); wv[i] = W[(size_t)(k0 + kk) * N + n0 + (lane & 31)]; }
#pragma unroll
    for (int i = 0; i < 32; ++i) { const int kk = 2 * i + (lane >> 5); scr[kk * 33 + (lane & 31)] = wv[i]; }
    asm volatile("s_waitcnt lgkmcnt(0)" ::: "memory");
    const int c = lane & 7;
#pragma unroll
    for (int j = 0; j < 4; ++j) { const int n = (lane >> 3) + 8 * j; const LAS float* s = scr + (8 * c) * 33 + n;
        u32x4 o; o.x = cvt_pk_bf16(s[0 * 33], s[1 * 33]); o.y = cvt_pk_bf16(s[2 * 33], s[3 * 33]); o.z = cvt_pk_bf16(s[4 * 33], s[5 * 33]); o.w = cvt_pk_bf16(s[6 * 33], s[7 * 33]);
        *(u32x4*)(WT + (size_t)map_row(mode, row_off, n0 + n) * K + k0 + 8 * c) = o; }
    asm volatile("s_waitcnt lgkmcnt(0)" ::: "memory");
}

__device__ __forceinline__ void rms_row2_bf16(const float* xrow0, const float* xrow1, const float* g, bf16_t* orow0, bf16_t* orow1, int lane) {
    const f32x4* xr0 = (const f32x4*)xrow0 + lane; const f32x4* xr1 = (const f32x4*)xrow1 + lane; const f32x4* gr = (const f32x4*)g + lane;
    f32x4 v0[8], v1[8]; float s0 = 0.f, s1 = 0.f;
#pragma unroll
    for (int j = 0; j < 8; ++j) { v0[j] = xr0[64 * j]; v1[j] = xr1[64 * j]; }
#pragma unroll
    for (int j = 0; j < 8; ++j) { s0 += (v0[j].x * v0[j].x + v0[j].y * v0[j].y) + (v0[j].z * v0[j].z + v0[j].w * v0[j].w); s1 += (v1[j].x * v1[j].x + v1[j].y * v1[j].y) + (v1[j].z * v1[j].z + v1[j].w * v1[j].w); }
    const float r0 = rsqrtf(wave_sum(s0) * (1.f / DM) + RMS_EPS), r1 = rsqrtf(wave_sum(s1) * (1.f / DM) + RMS_EPS);
    u32x2* o0 = (u32x2*)orow0 + lane; u32x2* o1 = (u32x2*)orow1 + lane;
#pragma unroll
    for (int j = 0; j < 8; ++j) { const f32x4 gg = gr[64 * j]; u32x2 w;
        w.x = cvt_pk_bf16(v0[j].x * r0 * gg.x, v0[j].y * r0 * gg.y); w.y = cvt_pk_bf16(v0[j].z * r0 * gg.z, v0[j].w * r0 * gg.w); o0[64 * j] = w;
        w.x = cvt_pk_bf16(v1[j].x * r1 * gg.x, v1[j].y * r1 * gg.y); w.y = cvt_pk_bf16(v1[j].z * r1 * gg.z, v1[j].w * r1 * gg.w); o1[64 * j] = w; }
}
__device__ __forceinline__ void rms_row2_f32_inplace(float* xrow0, float* xrow1, const float* g, int lane) {
    f32x4* xr0 = (f32x4*)xrow0 + lane; f32x4* xr1 = (f32x4*)xrow1 + lane; const f32x4* gr = (const f32x4*)g + lane;
    f32x4 v0[8], v1[8]; float s0 = 0.f, s1 = 0.f;
#pragma unroll
    for (int j = 0; j < 8; ++j) { v0[j] = xr0[64 * j]; v1[j] = xr1[64 * j]; }
#pragma unroll
    for (int j = 0; j < 8; ++j) { s0 += (v0[j].x * v0[j].x + v0[j].y * v0[j].y) + (v0[j].z * v0[j].z + v0[j].w * v0[j].w); s1 += (v1[j].x * v1[j].x + v1[j].y * v1[j].y) + (v1[j].z * v1[j].z + v1[j].w * v1[j].w); }
    const float r0 = rsqrtf(wave_sum(s0) * (1.f / DM) + RMS_EPS), r1 = rsqrtf(wave_sum(s1) * (1.f / DM) + RMS_EPS);
#pragma unroll
    for (int j = 0; j < 8; ++j) { const f32x4 gg = gr[64 * j]; xr0[64 * j] = v0[j] * r0 * gg; xr1[64 * j] = v1[j] * r1 * gg; }
}

__device__ __forceinline__ void phase_prologue(const Args& a, LAS unsigned char* lds, int wv_) { LAUNDER_IDS;
    const int tid = tidx_, lane = tid & 63, wave = tid >> 6;
    unsigned char* ws = a.ws;
    LAS float* scr = (LAS float*)(lds + wave * 16384);
    const int gw = bidx_ * 8 + wave, NGW = gridDim.x * 8;
    constexpr int I_GU = (DM / 64) * (DFF / 32), I_D = (DFF / 64) * (DM / 32), I_IN = (DM / 64) * (NIN / 32), I_UQ = (512 / 64) * (NQ / 32), I_UKV = (512 / 64) * (NKV / 32),
                  I_SQ = (DM / 64) * (DM / 32), I_G = 64 * 8;
    constexpr int NITEMS = 4 * I_GU + 2 * I_D + I_IN + I_UQ + I_UKV + 3 * I_SQ + I_G;
    for (int it = gw; it < NITEMS; it += NGW) {
        int r = it;
        if (r < I_GU) { transpose_item(a.in[3], DM, DFF, (bf16_t*)(ws + WS_W1GU), 1, 0, scr, r, lane); continue; } r -= I_GU;
        if (r < I_GU) { transpose_item(a.in[4], DM, DFF, (bf16_t*)(ws + WS_W1GU), 1, 128, scr, r, lane); continue; } r -= I_GU;
        if (r < I_GU) { transpose_item(a.in[23], DM, DFF, (bf16_t*)(ws + WS_W2GU), 1, 0, scr, r, lane); continue; } r -= I_GU;
        if (r < I_GU) { transpose_item(a.in[24], DM, DFF, (bf16_t*)(ws + WS_W2GU), 1, 128, scr, r, lane); continue; } r -= I_GU;
        if (r < I_D) { transpose_item(a.in[5], DFF, DM, (bf16_t*)(ws + WS_W1D), 0, 0, scr, r, lane); continue; } r -= I_D;
        if (r < I_D) { transpose_item(a.in[25], DFF, DM, (bf16_t*)(ws + WS_W2D), 0, 0, scr, r, lane); continue; } r -= I_D;
        if (r < I_IN) { transpose_item(a.in[7], DM, NIN, (bf16_t*)(ws + WS_WIN), 2, 0, scr, r, lane); continue; } r -= I_IN;
        if (r < I_UQ) { transpose_item(a.in[9], 512, NQ, (bf16_t*)(ws + WS_WUQ), 3, 0, scr, r, lane); continue; } r -= I_UQ;
        if (r < I_UKV) { transpose_item(a.in[11], 512, NKV, (bf16_t*)(ws + WS_WUKV), 0, 0, scr, r, lane); continue; } r -= I_UKV;
        if (r < I_SQ) { transpose_item(a.in[12], DM, DM, (bf16_t*)(ws + WS_WOA), 0, 0, scr, r, lane); continue; } r -= I_SQ;
        if (r < I_SQ) { transpose_item(a.in[20], DM, DM, (bf16_t*)(ws + WS_WOR), 0, 0, scr, r, lane); continue; } r -= I_SQ;
        if (r < I_SQ) { transpose_item(a.in[21], DM, DM, (bf16_t*)(ws + WS_WOUT), 0, 0, scr, r, lane); continue; } r -= I_SQ;
        { const int mat = r >> 3, sub = r & 7, type = mat & 1, db = mat >> 1;
          transpose_item((type ? a.in[17] : a.in[15]) + (size_t)db * 128 * 128, 128, 128, (bf16_t*)(ws + WS_WG), 0, mat * 128, scr, sub, lane); }
    }
    { const int gt = bidx_ * 512 + tid, NT = gridDim.x * 512; u32x4* p = (u32x4*)((bf16_t*)(ws + WS_WIN) + (size_t)NIN * DM);
      unsigned z = 0u; asm volatile("" : "+v"(z));
      for (int i = gt; i < (NINP - NIN) * DM / 8; i += NT) p[i] = (u32x4){z, z, z, z}; }
    { const int gt = bidx_ * 512 + tid, NT = gridDim.x * 512; float* cosT = (float*)(ws + WS_COS); float* sinT = (float*)(ws + WS_SIN); float* c8 = (float*)(ws + WS_C8);
      for (int i = gt; i < SEQ * 32; i += NT) { const int pos = i >> 5, j = i & 31;
          const float inv = __builtin_amdgcn_exp2f(-(float)j * 0.41524101186092029f);
          const float ang = (float)pos * inv;
          const double t = (double)ang * 0.15915494309189535; const float fr = (float)(t - __builtin_floor(t));
          cosT[i] = __builtin_amdgcn_cosf(fr); sinT[i] = __builtin_amdgcn_sinf(fr); }
      for (int i = gt; i < 2 * DM; i += NT) { const float l = a.in[19][i]; const float x = __expf(-l);
          const float ser = x * (1.0f - x * (0.5f - x * (0.33333334f - x * (0.25f - x * 0.2f))));
          const float sp = (-l > 20.f) ? -l : (x < 0.05f ? ser : __logf(1.0f + x)); c8[i] = 8.0f * sp; } }
    for (int m = 2 * gw; m < MTOT; m += 2 * NGW) { const float* xr = m < SEQ ? a.in[0] + (size_t)m * DM : a.in[1] + (size_t)(m - SEQ) * DM;
        rms_row2_bf16(xr, xr + DM, a.in[2], (bf16_t*)(ws + WS_H) + (size_t)m * DM, (bf16_t*)(ws + WS_H) + (size_t)(m + 1) * DM, lane); }
}

__device__ __forceinline__ void phase_norm(const Args& a, const float* g, int wv_) { LAUNDER_IDS;
    const int lane = tidx_ & 63, gw = bidx_ * 8 + (tidx_ >> 6), NGW = gridDim.x * 8;
    for (int m = 2 * gw; m < MTOT; m += 2 * NGW) rms_row2_bf16(a.out + (size_t)m * DM, a.out + (size_t)(m + 1) * DM, g, (bf16_t*)(a.ws + WS_H) + (size_t)m * DM, (bf16_t*)(a.ws + WS_H) + (size_t)(m + 1) * DM, lane);
}
__device__ __forceinline__ void phase_final_norm(const Args& a, int wv_) { LAUNDER_IDS;
    const int lane = tidx_ & 63, gw = bidx_ * 8 + (tidx_ >> 6), NGW = gridDim.x * 8;
    for (int m = 2 * gw; m < MTOT; m += 2 * NGW) rms_row2_f32_inplace(a.out + (size_t)m * DM, a.out + (size_t)(m + 1) * DM, a.in[26], lane);
}

__device__ __forceinline__ void phase_small(const Args& a, int wv_) { LAUNDER_IDS;
    unsigned char* ws = a.ws; const int tid = tidx_, lane = tid & 63, gw = bidx_ * 8 + (tid >> 6), NGW = gridDim.x * 8;
    const bf16_t* proj = (const bf16_t*)(ws + WS_PROJ);
    for (int row = gw; row < SEQ; row += NGW) {
        const u32x4 wq = *(const u32x4*)(proj + (size_t)row * NINP + C_CQ + lane * 8), wk = *(const u32x4*)(proj + (size_t)row * NINP + C_CKV + lane * 8);
        const unsigned pw = *(const unsigned*)(proj + (size_t)row * NINP + C_KPE + 2 * (lane & 31));
        const f32x4 gq0 = *(const f32x4*)(a.in[8] + lane * 8), gq1 = *(const f32x4*)(a.in[8] + lane * 8 + 4), gk0 = *(const f32x4*)(a.in[10] + lane * 8), gk1 = *(const f32x4*)(a.in[10] + lane * 8 + 4);
        const float c = ((const float*)(ws + WS_COS))[row * 32 + (lane & 31)], sn = ((const float*)(ws + WS_SIN))[row * 32 + (lane & 31)];
        float vq[8] = {bf2f(wq.x & 0xffffu), bf2f(wq.x >> 16), bf2f(wq.y & 0xffffu), bf2f(wq.y >> 16), bf2f(wq.z & 0xffffu), bf2f(wq.z >> 16), bf2f(wq.w & 0xffffu), bf2f(wq.w >> 16)};
        float vk[8] = {bf2f(wk.x & 0xffffu), bf2f(wk.x >> 16), bf2f(wk.y & 0xffffu), bf2f(wk.y >> 16), bf2f(wk.z & 0xffffu), bf2f(wk.z >> 16), bf2f(wk.w & 0xffffu), bf2f(wk.w >> 16)};
        float sq = 0.f, sk = 0.f;
#pragma unroll
        for (int j = 0; j < 8; ++j) { sq += vq[j] * vq[j]; sk += vk[j] * vk[j]; }
        const float rq = rsqrtf(wave_sum(sq) * (1.f / 512.f) + RMS_EPS), rk = rsqrtf(wave_sum(sk) * (1.f / 512.f) + RMS_EPS);
        u32x4 oq, ok;
        oq.x = cvt_pk_bf16(vq[0] * rq * gq0.x, vq[1] * rq * gq0.y); oq.y = cvt_pk_bf16(vq[2] * rq * gq0.z, vq[3] * rq * gq0.w); oq.z = cvt_pk_bf16(vq[4] * rq * gq1.x, vq[5] * rq * gq1.y); oq.w = cvt_pk_bf16(vq[6] * rq * gq1.z, vq[7] * rq * gq1.w);
        ok.x = cvt_pk_bf16(vk[0] * rk * gk0.x, vk[1] * rk * gk0.y); ok.y = cvt_pk_bf16(vk[2] * rk * gk0.z, vk[3] * rk * gk0.w); ok.z = cvt_pk_bf16(vk[4] * rk * gk1.x, vk[5] * rk * gk1.y); ok.w = cvt_pk_bf16(vk[6] * rk * gk1.z, vk[7] * rk * gk1.w);
        *(u32x4*)((bf16_t*)(ws + WS_CQN) + (size_t)row * 512 + lane * 8) = oq; *(u32x4*)((bf16_t*)(ws + WS_CKVN) + (size_t)row * 512 + lane * 8) = ok;
        if (lane < 32) { const float x1 = bf2f(pw & 0xffffu), x2 = bf2f(pw >> 16); *(unsigned*)((bf16_t*)(ws + WS_KPE) + (size_t)row * 64 + 2 * lane) = cvt_pk_bf16(x1 * c - x2 * sn, x2 * c + x1 * sn); }
    }
    const int gt = bidx_ * 512 + tid, NT = gridDim.x * 512; bf16_t* xc = (bf16_t*)(ws + WS_XC);
    for (int i = gt; i < (SEQ / 4) * (DM / 8); i += NT) {
        const int r0 = (i >> 8) * 4, c0 = (i & 255) * 8;
        u32x4 xr[7]; unsigned z = 0u; asm volatile("" : "+v"(z));
#pragma unroll
        for (int k = 0; k < 7; ++k) { const int t = r0 + k - 2; xr[k] = (t >= 0 && t < SEQ) ? *(const u32x4*)(proj + (size_t)t * NINP + C_XREC + c0) : (u32x4){z, z, z, z}; }
        f32x4 wlo[4], whi[4];
#pragma unroll
        for (int k = 0; k < 4; ++k) { wlo[k] = *(const f32x4*)(a.in[13] + k * DM + c0); whi[k] = *(const f32x4*)(a.in[13] + k * DM + c0 + 4); }
        const f32x4 b0 = *(const f32x4*)(a.in[14] + c0), b1 = *(const f32x4*)(a.in[14] + c0 + 4);
#pragma unroll
        for (int r = 0; r < 4; ++r) { f32x4 lo = b0, hi = b1;
#pragma unroll
            for (int k = 0; k < 4; ++k) { const u32x4 w = xr[r + k];
                lo += (f32x4){bf2f(w.x & 0xffffu), bf2f(w.x >> 16), bf2f(w.y & 0xffffu), bf2f(w.y >> 16)} * wlo[k]; hi += (f32x4){bf2f(w.z & 0xffffu), bf2f(w.z >> 16), bf2f(w.w & 0xffffu), bf2f(w.w >> 16)} * whi[k]; }
            u32x4 o; o.x = cvt_pk_bf16(lo[0], lo[1]); o.y = cvt_pk_bf16(lo[2], lo[3]); o.z = cvt_pk_bf16(hi[0], hi[1]); o.w = cvt_pk_bf16(hi[2], hi[3]);
            *(u32x4*)(xc + (size_t)(r0 + r) * DM + c0) = o; }
    }
}

__device__ __forceinline__ void phase_scan1(const Args& a, int wv_) { LAUNDER_IDS;
    unsigned char* ws = a.ws; const int tid = tidx_;
    for (int it = bidx_; it < 1024; it += gridDim.x) {
        const int half = it & 1, dir = (it >> 1) & 1, c = it >> 2, ch = half * 1024 + tid * 2;
        const bf16_t* A = (const bf16_t*)(ws + (dir ? WS_AB : WS_AF)) + ch; const bf16_t* U = (const bf16_t*)(ws + (dir ? WS_UB : WS_UF)) + ch;
        f32x2 P = {1.f, 1.f}, Hh = {0.f, 0.f};
        unsigned awv[32], uwv[32];
#pragma unroll
        for (int i = 0; i < 32; ++i) { const int t = dir ? (c * 32 + 31 - i) : (c * 32 + i); awv[i] = *(const unsigned*)(A + (size_t)t * DM); uwv[i] = *(const unsigned*)(U + (size_t)t * DM); }
#pragma unroll
        for (int i = 0; i < 32; ++i) { const unsigned aw = awv[i], uw = uwv[i];
            const f32x2 av = {1.0f - bf2f(aw & 0xffffu), 1.0f - bf2f(aw >> 16)}, uv = {bf2f(uw & 0xffffu), bf2f(uw >> 16)}; Hh = av * Hh + uv; P = P * av; }
        *(f32x2*)((float*)(ws + WS_AGGA) + (size_t)(dir * 256 + c) * DM + ch) = P; *(f32x2*)((float*)(ws + WS_AGGB) + (size_t)(dir * 256 + c) * DM + ch) = Hh;
    }
}
__device__ __forceinline__ void phase_scan15(const Args& a, LAS unsigned char* lds, int wv_) { LAUNDER_IDS;
    if (bidx_ >= 32) return;
    unsigned char* ws = a.ws; const int tid = tidx_, seg = tid >> 6, cpl = tid & 63, idx = bidx_ * 64 + cpl, dir = idx >> 10, ch = (idx & 1023) * 2;
    const float* GA = (const float*)(ws + WS_AGGA) + (size_t)dir * 256 * DM + ch; const float* GB = (const float*)(ws + WS_AGGB) + (size_t)dir * 256 * DM + ch; float* CR = (float*)(ws + WS_CARRY) + (size_t)dir * 256 * DM + ch;
    LAS f32x4* seg_agg = (LAS f32x4*)lds;
    f32x2 A = {1.f, 1.f}, B = {0.f, 0.f};
#pragma unroll 8
    for (int i = 0; i < 32; ++i) { const int c = dir ? 255 - (seg * 32 + i) : seg * 32 + i; const f32x2 av = *(const f32x2*)(GA + (size_t)c * DM), bv = *(const f32x2*)(GB + (size_t)c * DM); B = av * B + bv; A = A * av; }
    seg_agg[seg * 64 + cpl] = (f32x4){A.x, A.y, B.x, B.y};
    __syncthreads();
    f32x2 carry = {0.f, 0.f};
    for (int k = 0; k < seg; ++k) { const f32x4 g = seg_agg[k * 64 + cpl]; carry = (f32x2){g.x, g.y} * carry + (f32x2){g.z, g.w}; }
    __syncthreads();
#pragma unroll 8
    for (int i = 0; i < 32; ++i) { const int c = dir ? 255 - (seg * 32 + i) : seg * 32 + i; *(f32x2*)(CR + (size_t)c * DM) = carry; const f32x2 av = *(const f32x2*)(GA + (size_t)c * DM), bv = *(const f32x2*)(GB + (size_t)c * DM); carry = av * carry + bv; }
}
__device__ __forceinline__ void phase_scan2(const Args& a, int wv_) { LAUNDER_IDS;
    unsigned char* ws = a.ws; const int tid = tidx_;
    const bf16_t* proj = (const bf16_t*)(ws + WS_PROJ); bf16_t* yg = (bf16_t*)(ws + WS_YG);
    for (int it = bidx_; it < 512; it += gridDim.x) {
        const int half = it & 1, c = it >> 1, ch = half * 1024 + tid * 2;
        const bf16_t* AF = (const bf16_t*)(ws + WS_AF) + ch; const bf16_t* UF = (const bf16_t*)(ws + WS_UF) + ch; const bf16_t* AB = (const bf16_t*)(ws + WS_AB) + ch; const bf16_t* UB = (const bf16_t*)(ws + WS_UB) + ch;
        f32x2 hf[32]; f32x2 h = *(const f32x2*)((const float*)(ws + WS_CARRY) + (size_t)c * DM + ch);
        { unsigned awv[32], uwv[32];
#pragma unroll
          for (int i = 0; i < 32; ++i) { const int t = c * 32 + i; awv[i] = *(const unsigned*)(AF + (size_t)t * DM); uwv[i] = *(const unsigned*)(UF + (size_t)t * DM); }
#pragma unroll
          for (int i = 0; i < 32; ++i) { const unsigned aw = awv[i], uw = uwv[i];
            const f32x2 av = {1.0f - bf2f(aw & 0xffffu), 1.0f - bf2f(aw >> 16)}, uv = {bf2f(uw & 0xffffu), bf2f(uw >> 16)}; h = av * h + uv; hf[i] = h; } }
        h = *(const f32x2*)((const float*)(ws + WS_CARRY) + (size_t)(256 + c) * DM + ch);
        { unsigned awv[32], uwv[32], gwv[32];
#pragma unroll
          for (int i = 0; i < 32; ++i) { const int t = c * 32 + i; awv[i] = *(const unsigned*)(AB + (size_t)t * DM); uwv[i] = *(const unsigned*)(UB + (size_t)t * DM); gwv[i] = *(const unsigned*)(proj + (size_t)t * NINP + C_GREC + ch); }
#pragma unroll
          for (int i = 31; i >= 0; --i) { const int t = c * 32 + i; const unsigned aw = awv[i], uw = uwv[i], gw = gwv[i];
            const f32x2 av = {1.0f - bf2f(aw & 0xffffu), 1.0f - bf2f(aw >> 16)}, uv = {bf2f(uw & 0xffffu), bf2f(uw >> 16)}; h = av * h + uv;
            const f32x2 hs = hf[i] + h;
            *(unsigned*)(yg + (size_t)t * DM + ch) = cvt_pk_bf16(gelu_tanh(bf2f(gw & 0xffffu)) * hs.x, gelu_tanh(bf2f(gw >> 16)) * hs.y); } }
    }
}

__device__ __forceinline__ void phase_attention(const Args& a, char* lds, int wv_) { LAUNDER_IDS;
    unsigned char* ws = a.ws; const int G = gridDim.x, bx = bidx_; const int vcu = (G % 8 == 0) ? (bx % 8) * (G / 8) + bx / 8 : bx;
    const bf16_t* Q = (const bf16_t*)(ws + WS_Q); const bf16_t* KV = (const bf16_t*)(ws + WS_KV); const bf16_t* KPE = (const bf16_t*)(ws + WS_KPE); bf16_t* O = (bf16_t*)(ws + WS_ATTO);
    for (int u = vcu; u < 512; u += G) { const int h = u >> 5, qb = u & 31;
        att::attn_unit(Q + (size_t)qb * 256 * NQ + h * 192, KV + h * 256, KV + h * 256 + 128, KPE, O + (size_t)qb * 256 * DM + h * 128, SEQ, lds, wv_); }
}

__device__ __forceinline__ void phase_ffn_up(const Args& a, LAS unsigned char* lds, int which, int wv_) {
    pg8::Gemm g{(const bf16_t*)(a.ws + WS_H), (const bf16_t*)(a.ws + (which ? WS_W2GU : WS_W1GU))};
    pg8::EpiSwiglu E{(bf16_t*)(a.ws + WS_ACT), DFF};
    pg8::gemm_phase<pg8::EpiSwiglu, MTOT, 2 * DFF, DM, DM, 0, 0, FFN_UP_WG>(lds, g, E, wv_);
}
__device__ __forceinline__ void phase_ffn_down(const Args& a, LAS unsigned char* lds, int which, int wv_) {
    pg8::Gemm g{(const bf16_t*)(a.ws + WS_ACT), (const bf16_t*)(a.ws + (which ? WS_W2D : WS_W1D))};
    pg8::EpiResid E{which ? a.out : a.in[0], which ? a.out : a.in[1], which ? MTOT : SEQ, a.out, 0.5f, 0};
    pg8::gemm_phase<pg8::EpiResid, MTOT, DM, DFF, DFF, 0, 0>(lds, g, E, wv_);
}
__device__ __forceinline__ void phase_wout(const Args& a, LAS unsigned char* lds, int s, int wv_) {
    pg8::Gemm g{(const bf16_t*)(a.ws + WS_H), (const bf16_t*)(a.ws + WS_WOUT)};
    pg8::EpiResid E{a.out, a.out, MTOT, a.out, 1.0f, 0};
    pg8::gemm_phase<pg8::EpiResid, MTOT, DM, DM, DM, 0, 0>(lds, g, E, wv_);
}
__device__ __forceinline__ void phase_win(const Args& a, LAS unsigned char* lds, int s, int wv_) {
    pg8::Gemm g{(const bf16_t*)(a.ws + WS_H) + (size_t)s * SEQ * DM, (const bf16_t*)(a.ws + WS_WIN)}; pg8::EpiBf16 E{(bf16_t*)(a.ws + WS_PROJ), NINP};
    pg8::gemm_phase<pg8::EpiBf16, SEQ, NINP, DM, DM, 0, 0>(lds, g, E, wv_);
}
__device__ __forceinline__ void phase_kv(const Args& a, LAS unsigned char* lds, int wv_) {
    pg8::Gemm g{(const bf16_t*)(a.ws + WS_CKVN), (const bf16_t*)(a.ws + WS_WUKV)}; pg8::EpiBf16 E{(bf16_t*)(a.ws + WS_KV), NKV};
    pg8::gemm_phase<pg8::EpiBf16, SEQ, NKV, 512, 512, 0, 0>(lds, g, E, wv_);
}

__device__ __forceinline__ void run_phase(const Args& a, int ph, unsigned char* lds_g, int wv_) {
    LAS unsigned char* lds = (LAS unsigned char*)lds_g; unsigned char* ws = a.ws;
    if (ph == 0) { if (PHM(0)) phase_prologue(a, lds, wv_); return; }
    if (ph == 1 || ph == 41) { if (PHM(1)) phase_ffn_up(a, lds, ph == 41, wv_); return; }
    if (ph == 2 || ph == 42) { if (PHM(2)) phase_ffn_down(a, lds, ph == 42, wv_); return; }
    if (ph == 3) { if (PHM(3)) phase_norm(a, a.in[6], wv_); return; }
    if (ph == 40) { if (PHM(3)) phase_norm(a, a.in[22], wv_); return; }
    if (ph == 39) { if (PHM(16)) phase_wout(a, lds, 0, wv_); return; }
    if (ph == 43) { if (PHM(4)) phase_final_norm(a, wv_); return; }
    const int s = (ph - 4) / 7, sub = (ph - 4) % 7;
    switch (sub) {
    case 0: if (PHM(5)) phase_win(a, lds, s, wv_); break;
    case 1: if (PHM(6)) phase_small(a, wv_); break;
    case 2: {
        if (PHM(7)) { pg8::Gemm g{(const bf16_t*)(ws + WS_CQN), (const bf16_t*)(ws + WS_WUQ)}; pg8::EpiQ E{(bf16_t*)(ws + WS_Q), (const float*)(ws + WS_COS), (const float*)(ws + WS_SIN)};
          pg8::gemm_phase<pg8::EpiQ, SEQ, NQ, 512, 512, 0, 0>(lds, g, E, wv_); }
        if (PHM(15)) phase_kv(a, lds, wv_);
        if (PHM(8)) { pg8::Gemm g{(const bf16_t*)(ws + WS_XC), (const bf16_t*)(ws + WS_WG)};
          pg8::EpiGates E{(const bf16_t*)(ws + WS_XC), a.in[16], a.in[18], (const float*)(ws + WS_C8), (bf16_t*)(ws + WS_AF), (bf16_t*)(ws + WS_UF), (size_t)(WS_AB - WS_AF) / 2};
          pg8::gemm_phase<pg8::EpiGates, SEQ, 8192, 128, DM, 16, 128>(lds, g, E, wv_); }
        break; }
    case 3: if (PHM(9)) phase_attention(a, (char*)lds_g, wv_); if (PHM(10)) phase_scan1(a, wv_); break;
    case 4: {
        if (PHM(11)) phase_scan15(a, lds, wv_);
        if (PHM(12)) { pg8::Gemm g{(const bf16_t*)(ws + WS_ATTO), (const bf16_t*)(ws + WS_WOA)}; pg8::EpiT1 E{(const bf16_t*)(ws + WS_PROJ) + C_GA, NINP, (bf16_t*)(ws + WS_T1)};
        pg8::gemm_phase<pg8::EpiT1, SEQ, DM, DM, DM, 0, 0>(lds, g, E, wv_); } break; }
    case 5: if (PHM(13)) phase_scan2(a, wv_); break;
    case 6: {
        if (PHM(14)) { pg8::Gemm g{(const bf16_t*)(ws + WS_YG), (const bf16_t*)(ws + WS_WOR)}; pg8::EpiMerge E{(const bf16_t*)(ws + WS_PROJ) + C_GR, NINP, (const bf16_t*)(ws + WS_T1), (bf16_t*)(ws + WS_H) + (size_t)s * SEQ * DM};
        pg8::gemm_phase<pg8::EpiMerge, SEQ, DM, DM, DM, 0, 0>(lds, g, E, wv_); } break; }
    default: break;
    }
}

__global__ void __launch_bounds__(512, 2) mega(Args a) {
    extern __shared__ __attribute__((aligned(16))) unsigned char lds[];
    cg::grid_group grid = cg::this_grid();
    const int wv_ = __builtin_amdgcn_readfirstlane(threadIdx.x >> 6);
    volatile LAS unsigned* misc = (volatile LAS unsigned*)((LAS unsigned char*)lds + (LDS_BYTES - 64));
    if (threadIdx.x < 2) misc[threadIdx.x] = 0u;
    __syncthreads();
    XcdBarrier bar = xcd_barrier_post((unsigned*)(a.ws + WS_CTL), misc);
    for (int ph = a.ph_lo; ph < a.ph_hi; ++ph) {
#ifdef PROBE_REPEAT
        if (PROBE_REPEAT(ph)) { run_phase(a, ph, lds, wv_); xcd_barrier(bar); }
#endif
        run_phase(a, ph, lds, wv_);
        if (ph + 1 < a.ph_hi) { if (ph == a.ph_lo) grid.sync(); else xcd_barrier(bar); }
    }
}

extern "C" void kernel_launch(void* const* d_in, const int* in_sizes, int n_in, void* d_out, int out_size, void* d_ws, size_t ws_size, hipStream_t stream) {
    static int grid = 0;
    if (grid == 0) {
        if (n_in != 27 || out_size != MTOT * DM || ws_size < WS_END) { fprintf(stderr, "kernel_launch: unexpected shapes: n_in %d out %d ws %zu (need %zu)\n", n_in, out_size, ws_size, (size_t)WS_END); grid = -1; return; }
        int dev = 0, cus = 0, per_cu = 0;
        (void)hipGetDevice(&dev); (void)hipDeviceGetAttribute(&cus, hipDeviceAttributeMultiprocessorCount, dev);
        if (hipFuncSetAttribute((const void*)mega, hipFuncAttributeMaxDynamicSharedMemorySize, LDS_BYTES) != hipSuccess) { fprintf(stderr, "kernel_launch: hipFuncSetAttribute failed\n"); grid = -1; return; }
        (void)hipOccupancyMaxActiveBlocksPerMultiprocessor(&per_cu, (const void*)mega, 512, LDS_BYTES);
        if (per_cu < 1) { fprintf(stderr, "kernel_launch: occupancy query says %d blocks/CU\n", per_cu); per_cu = 1; }
        (void)hipGetLastError();
        grid = cus;
    }
    if (grid < 0) return;
    if (hipMemsetAsync((char*)d_ws + WS_CTL, 0, CTL_BYTES, stream) != hipSuccess) { fprintf(stderr, "kernel_launch: hipMemsetAsync failed\n"); return; }
    Args a{};
    for (int i = 0; i < 27; ++i) a.in[i] = (const float*)d_in[i];
    a.out = (float*)d_out; a.ws = (unsigned char*)d_ws;
#if MK_ONE_LAUNCH
    a.ph_lo = 0; a.ph_hi = NPH;
    { void* args[] = {&a}; hipError_t e = hipLaunchCooperativeKernel((const void*)mega, dim3(grid), dim3(512), args, LDS_BYTES, stream);
      if (e != hipSuccess) fprintf(stderr, "cooperative launch failed: %s (grid %d)\n", hipGetErrorString(e), grid); }
#else
    for (int ph = 0; ph < NPH; ++ph) {
        a.ph_lo = ph; a.ph_hi = ph + 1;
        void* args[] = {&a}; hipError_t e = hipLaunchCooperativeKernel((const void*)mega, dim3(grid), dim3(512), args, LDS_BYTES, stream);
        if (e != hipSuccess) { fprintf(stderr, "cooperative launch %d failed: %s (grid %d)\n", ph, hipGetErrorString(e), grid); break; }
    }
#endif
}
```

```cpp
#include <hip/hip_runtime.h>
#include <hip/hip_cooperative_groups.h>
#include <cstdio>
#include <cstdint>
namespace cg = cooperative_groups;

#ifndef MK_ONE_LAUNCH
#define MK_ONE_LAUNCH 1
#endif
#ifndef PH_MASK
#define PH_MASK 0xffffffffu
#endif
#define PHM(k) (((PH_MASK) >> (k)) & 1u)
#define LANE_ID_ASM(l) asm volatile("v_mbcnt_lo_u32_b32 %0, -1, 0\n\tv_mbcnt_hi_u32_b32 %0, -1, %0" : "=v"(l))
#define LAUNDER_IDS int tidx_; LANE_ID_ASM(tidx_); tidx_ += wv_ * 64; int bidx_ = blockIdx.x; asm volatile("" : "+s"(bidx_))

#define LAS __attribute__((address_space(3)))
typedef unsigned short bf16_t;
typedef short bf16x8 __attribute__((ext_vector_type(8)));
typedef short s16x4 __attribute__((ext_vector_type(4)));
typedef float f32x4 __attribute__((ext_vector_type(4)));
typedef float f32x2 __attribute__((ext_vector_type(2)));
typedef float f32x16 __attribute__((ext_vector_type(16)));
typedef unsigned u32x4 __attribute__((ext_vector_type(4)));
typedef unsigned u32x2 __attribute__((ext_vector_type(2)));

constexpr int DM = 2048, SEQ = 8192, NSEQ = 5, MTOT = NSEQ * SEQ, DFF = 5632;
constexpr int NIN = 9280, NINP = 9472;
constexpr int NQ = 3072, NKV = 4096;
constexpr int C_CQ = 0, C_CKV = 512, C_KPE = 1024, C_XREC = 1088, C_GREC = 3136, C_GA = 5184, C_GR = 7232;
constexpr float RMS_EPS = 1e-6f;
constexpr float QSCALE = 0.07216878364870322f * 1.4426950408889634f;

constexpr size_t MiB = 1u << 20;
constexpr size_t WS_COS = 0, WS_SIN = 1 * MiB, WS_C8 = 2 * MiB, WS_CTL = 3 * MiB, CTL_BYTES = 16384;
constexpr size_t WS_W1GU = 4 * MiB, WS_W1D = 48 * MiB, WS_W2GU = 70 * MiB, WS_W2D = 114 * MiB, WS_WIN = 136 * MiB, WS_WUQ = 173 * MiB,
                 WS_WUKV = 176 * MiB, WS_WOA = 180 * MiB, WS_WOR = 188 * MiB, WS_WOUT = 196 * MiB, WS_WG = 204 * MiB;
constexpr size_t WS_H = 206 * MiB, WS_ACT = 366 * MiB;
constexpr size_t WS_PROJ = 366 * MiB, WS_CQN = 514 * MiB, WS_CKVN = 522 * MiB, WS_KPE = 530 * MiB, WS_XC = 532 * MiB, WS_MERGED = 532 * MiB,
                 WS_Q = 564 * MiB, WS_KV = 612 * MiB, WS_T1 = 564 * MiB, WS_AF = 676 * MiB, WS_UF = 740 * MiB, WS_AB = 804 * MiB, WS_UB = 868 * MiB,
                 WS_ATTO = 932 * MiB, WS_YG = 964 * MiB, WS_AGGA = 996 * MiB, WS_AGGB = 1000 * MiB, WS_CARRY = 1004 * MiB, WS_END = 1008 * MiB;

constexpr int LDS_BYTES = 135168;
constexpr int NPH = 44;
#ifndef FFN_UP_WG
#define FFN_UP_WG 8
#endif

__device__ __forceinline__ float bf2f(unsigned b) { return __uint_as_float(b << 16); }
__device__ __forceinline__ unsigned cvt_pk_bf16(float lo, float hi) { unsigned r; asm volatile("v_cvt_pk_bf16_f32 %0, %1, %2" : "=v"(r) : "v"(lo), "v"(hi)); return r; }
__device__ __forceinline__ float fsigmoid(float x) { return __builtin_amdgcn_rcpf(1.0f + __expf(-x)); }
__device__ __forceinline__ float wave_sum(float v) {
    v += __int_as_float(__builtin_amdgcn_ds_swizzle(__float_as_int(v), 0x041f));
    v += __int_as_float(__builtin_amdgcn_ds_swizzle(__float_as_int(v), 0x081f));
    v += __int_as_float(__builtin_amdgcn_ds_swizzle(__float_as_int(v), 0x101f));
    v += __int_as_float(__builtin_amdgcn_ds_swizzle(__float_as_int(v), 0x201f));
    v += __int_as_float(__builtin_amdgcn_ds_swizzle(__float_as_int(v), 0x401f));
    auto rr = __builtin_amdgcn_permlane32_swap(__float_as_uint(v), __float_as_uint(v), false, false);
    return __uint_as_float(rr[0]) + __uint_as_float(rr[1]);
}
__device__ __forceinline__ float gelu_tanh(float x) {
    const float z = 0.7978845608028654f * (x + 0.044715f * x * x * x);
    const float e = __expf(2.0f * z);
    const float t = 1.0f - 2.0f * __builtin_amdgcn_rcpf(1.0f + e);
    return 0.5f * x * (1.0f + t);
}

namespace pg8 {
constexpr int BM = 256, BK = 64, HALF = 128, HTB = HALF * BK * 2, STAGE_BYTES = 8 * HTB, NXCD = 8, WGM = 4;
__host__ __device__ __forceinline__ int lds_byte(int r, int c) { const int st = (r >> 4) * 2 + (c >> 5), rr = r & 15, cc = c & 31, ob = rr * 64 + cc * 2; return st * 1024 + (ob ^ (((ob >> 9) & 1) << 5)); }
__host__ __device__ __forceinline__ void stage_rc(int b, int& R, int& C) { const int st = b / 1024, sb = b % 1024, swz = sb ^ (((sb >> 9) & 1) << 5); R = (st >> 1) * 16 + swz / 64; C = (st & 1) * 32 + (swz % 64) / 2; }
__host__ __device__ __forceinline__ int perm32(int rho) { const int n = rho >> 4, i = rho & 15; return 8 * (i >> 2) + 4 * n + (i & 3); }

struct Unit { int pm, pn; };
struct Gemm { const bf16_t* A; const bf16_t* Bt; };

struct StaticOrder {
    int nM, nN, nwg, G, c, wgm;
    __device__ void init(int M, int N, int G_, int c_, int wgm_) { nM = M / BM; nN = N / BM; nwg = nM * nN; G = G_; c = c_; wgm = wgm_; }
    __device__ bool next(int i, Unit& u) const {
        const long L = (long)i * G + c; if (L >= nwg) return false;
        int wgid = (int)L; { const int q = nwg / NXCD, r = nwg % NXCD, xcd = wgid % NXCD, off = wgid / NXCD; wgid = (xcd < r ? xcd * (q + 1) : r * (q + 1) + (xcd - r) * q) + off; }
        const int nig = wgm * nN, gid = wgid / nig, fm = gid * wgm, gsz = (nM - fm) < wgm ? (nM - fm) : wgm;
        u.pm = fm + ((wgid % nig) % gsz); u.pn = (wgid % nig) / gsz; return true;
    }
};

template <class Epi, int GM, int GN, int GK, int LDA, int AMOD, int ASTRIDE, int WG = WGM>
__device__ __forceinline__ void gemm_phase(LAS unsigned char* lds, const Gemm g, const Epi& E, int wv_) {
    int tid_; LANE_ID_ASM(tid_); tid_ += wv_ * 64; int bid_ = blockIdx.x; asm volatile("" : "+s"(bid_));
    const int tid = tid_, wid = __builtin_amdgcn_readfirstlane(tid >> 6), lane = tid & 63, wr = wid >> 2, wc = wid & 3, fr = lane & 15, fq = lane >> 4;
    constexpr int K = GK, lda = LDA; int nt = K / BK; asm volatile("" : "+s"(nt));
    StaticOrder S; S.init(GM, GN, (int)gridDim.x, bid_, WG);
    unsigned voffA[2], voffB[2];
#pragma unroll
    for (int i = 0; i < 2; ++i) { int R, C; stage_rc(tid * 16 + i * 8192, R, C); const int Rb = Epi::PERM ? ((R & ~31) + perm32(R & 31)) : R;
        voffA[i] = (unsigned)(R * lda + C) * 2u; voffB[i] = (unsigned)(Rb * K + C) * 2u; }
    const size_t kstep = (size_t)(BK * 2);
    const size_t hstepA = (size_t)HALF * lda * 2, tstepA = 2 * hstepA;
    const size_t hstepB = (size_t)HALF * K * 2, tstepB = 2 * hstepB;
    const unsigned ldsw = (unsigned)wid * 1024u;
    const int aoff = lds_byte(wr * 64 + fr, fq * 8), boff = lds_byte(wc * 32 + fr, fq * 8);
#define PG8_SA(b, h) (((b) * 2 + (h)) * HTB)
#define PG8_SB(b, h) ((4 + (b) * 2 + (h)) * HTB)
#define PG8_STAGE(bufoff, gbase, voff) do { _Pragma("unroll") for (int _i = 0; _i < 2; ++_i) \
        __builtin_amdgcn_global_load_lds((const unsigned*)((const char*)(gbase) + (voff)[_i]), (LAS unsigned*)(lds + (bufoff) + ldsw + _i * 8192), 16, 0, 0); } while (0)
#define PG8_LDA(dst, b, h) do { _Pragma("unroll") for (int m = 0; m < 4; ++m) _Pragma("unroll") for (int k = 0; k < 2; ++k) dst[m][k] = *(const LAS bf16x8*)(lds + PG8_SA(b, h) + aoff + m * 2048 + k * 1024); } while (0)
#define PG8_LDB(dst, b, h) do { _Pragma("unroll") for (int n = 0; n < 2; ++n) _Pragma("unroll") for (int k = 0; k < 2; ++k) dst[n][k] = *(const LAS bf16x8*)(lds + PG8_SB(b, h) + boff + n * 2048 + k * 1024); } while (0)
#define PG8_MMA(ai, bj, At, Bt) do { __builtin_amdgcn_s_setprio(1); _Pragma("unroll") for (int m = 0; m < 4; ++m) _Pragma("unroll") for (int n = 0; n < 2; ++n) _Pragma("unroll") for (int k = 0; k < 2; ++k) \
        acc[ai][bj][m][n] = __builtin_amdgcn_mfma_f32_16x16x32_bf16(Bt[n][k], At[m][k], acc[ai][bj][m][n], 0, 0, 0); __builtin_amdgcn_s_setprio(0); } while (0)
#define PG8_WAIT_V(n) asm volatile("s_waitcnt vmcnt(" #n ")" ::: "memory")
#define PG8_WAIT_L(n) asm volatile("s_waitcnt lgkmcnt(" #n ")" ::: "memory")
#define PG8_BAR __builtin_amdgcn_s_barrier()
#define PG8_SCHED __builtin_amdgcn_sched_barrier(0)
#define PG8_AOFF(pn) (AMOD ? (size_t)((pn) % (AMOD ? AMOD : 1)) * (size_t)ASTRIDE * 2 : (size_t)0)
    Unit cur, nxt; int ui = 0;
    if (!S.next(0, cur)) return;
    f32x4 acc[2][2][4][2];
#pragma unroll
    for (int a = 0; a < 2; ++a)
#pragma unroll
        for (int b = 0; b < 2; ++b)
#pragma unroll
            for (int m = 0; m < 4; ++m)
#pragma unroll
                for (int n = 0; n < 2; ++n) acc[a][b][m][n] = (f32x4){0.f, 0.f, 0.f, 0.f};
    bf16x8 At[4][2], B0[2][2], B1[2][2];
    const char* cA = (const char*)g.A + (size_t)cur.pm * tstepA + PG8_AOFF(cur.pn); const char* cB = (const char*)g.Bt + (size_t)cur.pn * tstepB;
    PG8_STAGE(PG8_SB(0, 0), cB, voffB); PG8_STAGE(PG8_SB(0, 1), cB + hstepB, voffB); PG8_STAGE(PG8_SA(0, 0), cA, voffA); PG8_STAGE(PG8_SA(0, 1), cA + hstepA, voffA);
    if (wr == 1) PG8_BAR;
    PG8_WAIT_V(2); PG8_BAR;
    PG8_STAGE(PG8_SB(1, 0), cB + kstep, voffB); PG8_STAGE(PG8_SA(1, 0), cA + kstep, voffA); PG8_STAGE(PG8_SB(1, 1), cB + hstepB + kstep, voffB);
    PG8_WAIT_V(6); PG8_BAR;
    for (;;) {
        const bool has_next = S.next(ui + 1, nxt);
        const char* nA = has_next ? (const char*)g.A + (size_t)nxt.pm * tstepA + PG8_AOFF(nxt.pn) : cA; const char* nB = has_next ? (const char*)g.Bt + (size_t)nxt.pn * tstepB : cB;
        for (int t = 0; t < nt; t += 2) {
            const bool last = (t == nt - 2);
            const char* a1 = cA + (size_t)(t + 1) * kstep;
            const char* a2 = last ? nA : cA + (size_t)(t + 2) * kstep; const char* b2 = last ? nB : cB + (size_t)(t + 2) * kstep;
            const char* a3 = a2 + kstep; const char* b3 = b2 + kstep;
            PG8_LDB(B0, 0, 0); PG8_LDB(B1, 0, 1); PG8_SCHED; PG8_LDA(At, 0, 0); PG8_STAGE(PG8_SA(1, 1), a1 + hstepA, voffA);
            PG8_WAIT_V(8); PG8_WAIT_L(0); PG8_BAR; PG8_MMA(0, 0, At, B0); PG8_MMA(0, 1, At, B1); PG8_BAR; PG8_SCHED;
            PG8_LDA(At, 0, 1); PG8_STAGE(PG8_SB(0, 0), b2, voffB); PG8_STAGE(PG8_SB(0, 1), b2 + hstepB, voffB); PG8_STAGE(PG8_SA(0, 0), a2, voffA);
            PG8_WAIT_V(8); PG8_WAIT_L(0); PG8_BAR; PG8_MMA(1, 0, At, B0); PG8_MMA(1, 1, At, B1); PG8_BAR; PG8_SCHED;
            PG8_LDB(B0, 1, 0); PG8_LDB(B1, 1, 1); PG8_SCHED; PG8_LDA(At, 1, 0); PG8_STAGE(PG8_SA(0, 1), a2 + hstepA, voffA);
            PG8_WAIT_V(8); PG8_WAIT_L(0); PG8_BAR; PG8_MMA(0, 0, At, B0); PG8_MMA(0, 1, At, B1); PG8_BAR; PG8_SCHED;
            PG8_LDA(At, 1, 1); PG8_STAGE(PG8_SB(1, 0), b3, voffB); PG8_STAGE(PG8_SB(1, 1), b3 + hstepB, voffB); PG8_STAGE(PG8_SA(1, 0), a3, voffA);
            PG8_WAIT_V(8); PG8_WAIT_L(0); PG8_BAR; PG8_MMA(1, 0, At, B0); PG8_MMA(1, 1, At, B1); PG8_BAR; PG8_SCHED;
        }
        if (wr == 0) PG8_BAR;
        { int fr2 = fr, fq2 = fq; asm volatile("" : "+v"(fr2), "+v"(fq2)); E(acc, cur, wr, wc, fr2, fq2); }
        if (!has_next) break;
#pragma unroll
        for (int a = 0; a < 2; ++a)
#pragma unroll
            for (int b = 0; b < 2; ++b)
#pragma unroll
                for (int m = 0; m < 4; ++m)
#pragma unroll
                    for (int n = 0; n < 2; ++n) acc[a][b][m][n] = (f32x4){0.f, 0.f, 0.f, 0.f};
        cur = nxt; cA = nA; cB = nB; ++ui;
        if (wr == 1) PG8_BAR;
    }
    PG8_WAIT_V(0);
    PG8_BAR;
#undef PG8_SA
#undef PG8_SB
#undef PG8_STAGE
#undef PG8_LDA
#undef PG8_LDB
#undef PG8_MMA
#undef PG8_WAIT_V
#undef PG8_WAIT_L
#undef PG8_BAR
#undef PG8_SCHED
#undef PG8_AOFF
}

typedef f32x4 Acc[2][2][4][2];

struct EpiBf16 {
    static constexpr bool PERM = true;
    bf16_t* O; int ldc;
    __device__ __forceinline__ void operator()(const Acc& acc, const Unit& u, int wr, int wc, int fr, int fq) const {
        const int row0 = u.pm * BM + wr * 64 + fr, col0 = u.pn * BM + wc * 32 + 8 * fq;
#pragma unroll
        for (int ai = 0; ai < 2; ++ai)
#pragma unroll
            for (int m = 0; m < 4; ++m) { bf16_t* rowp = O + (size_t)(row0 + ai * HALF + m * 16) * ldc + col0;
#pragma unroll
                for (int bj = 0; bj < 2; ++bj) { const f32x4 v0 = acc[ai][bj][m][0], v1 = acc[ai][bj][m][1];
                    u32x4 w; w.x = cvt_pk_bf16(v0[0], v0[1]); w.y = cvt_pk_bf16(v0[2], v0[3]); w.z = cvt_pk_bf16(v1[0], v1[1]); w.w = cvt_pk_bf16(v1[2], v1[3]);
                    *(u32x4*)(rowp + bj * HALF) = w; } asm volatile("" ::: "memory"); }
    }
};
struct EpiSwiglu {
    static constexpr bool PERM = true;
    bf16_t* O; int ldc;
    __device__ __forceinline__ void operator()(const Acc& acc, const Unit& u, int wr, int wc, int fr, int fq) const {
        const int row0 = u.pm * BM + wr * 64 + fr, col0 = u.pn * HALF + wc * 32 + 8 * fq;
#pragma unroll
        for (int ai = 0; ai < 2; ++ai)
#pragma unroll
            for (int m = 0; m < 4; ++m) { bf16_t* rowp = O + (size_t)(row0 + ai * HALF + m * 16) * ldc + col0;
                float r[8];
#pragma unroll
                for (int n = 0; n < 2; ++n)
#pragma unroll
                    for (int j = 0; j < 4; ++j) { const float gv = acc[ai][0][m][n][j], uv = acc[ai][1][m][n][j]; r[n * 4 + j] = gv * fsigmoid(gv) * uv; }
                u32x4 w; w.x = cvt_pk_bf16(r[0], r[1]); w.y = cvt_pk_bf16(r[2], r[3]); w.z = cvt_pk_bf16(r[4], r[5]); w.w = cvt_pk_bf16(r[6], r[7]);
                *(u32x4*)rowp = w; asm volatile("" ::: "memory"); }
    }
};
struct EpiResid {
    static constexpr bool PERM = false;
    const float* res0; const float* res1; int split; float* out; float alpha; int row_base;
    __device__ __forceinline__ void operator()(const Acc& acc, const Unit& u, int wr, int wc, int fr, int fq) const {
        const int grow0 = row_base + u.pm * BM; const float* rb = grow0 < split ? res0 + (size_t)grow0 * DM : res1 + (size_t)(grow0 - split) * DM;
        float* ob = out + (size_t)grow0 * DM; const int col0 = u.pn * BM + wc * 32 + 4 * fq;
#pragma unroll
        for (int ai = 0; ai < 2; ++ai)
#pragma unroll
            for (int mp = 0; mp < 2; ++mp) {
                f32x4 bs[2][2][2];
#pragma unroll
                for (int mm = 0; mm < 2; ++mm) { const size_t off = (size_t)(ai * HALF + wr * 64 + (2 * mp + mm) * 16 + fr) * DM + col0;
#pragma unroll
                    for (int bj = 0; bj < 2; ++bj)
#pragma unroll
                        for (int n = 0; n < 2; ++n) bs[mm][bj][n] = *(const f32x4*)(rb + off + bj * HALF + n * 16); }
#pragma unroll
                for (int mm = 0; mm < 2; ++mm) { const int m = 2 * mp + mm; const size_t off = (size_t)(ai * HALF + wr * 64 + m * 16 + fr) * DM + col0;
#pragma unroll
                    for (int bj = 0; bj < 2; ++bj)
#pragma unroll
                        for (int n = 0; n < 2; ++n) *(f32x4*)(ob + off + bj * HALF + n * 16) = bs[mm][bj][n] + acc[ai][bj][m][n] * alpha; }
                asm volatile("" ::: "memory"); }
    }
};
struct EpiQ {
    static constexpr bool PERM = true;
    bf16_t* O; const float* cosT; const float* sinT;
    __device__ __forceinline__ void operator()(const Acc& acc, const Unit& u, int wr, int wc, int fr, int fq) const {
        const int row0 = u.pm * BM + wr * 64 + fr;
#pragma unroll
        for (int bj = 0; bj < 2; ++bj) { const int col0 = u.pn * BM + bj * HALF + wc * 32 + 8 * fq; const int d = col0 % 192; const bool rope = d >= 128; const int jp0 = (d - 128) >> 1;
#pragma unroll
            for (int ai = 0; ai < 2; ++ai)
#pragma unroll
                for (int m = 0; m < 4; ++m) { const int row = row0 + ai * HALF + m * 16; f32x4 v0 = acc[ai][bj][m][0], v1 = acc[ai][bj][m][1];
                    if (rope) { const f32x4 c = *(const f32x4*)(cosT + (size_t)row * 32 + jp0), s = *(const f32x4*)(sinT + (size_t)row * 32 + jp0);
                        const f32x4 a0 = v0, a1 = v1;
                        v0[0] = a0[0] * c[0] - a0[1] * s[0]; v0[1] = a0[1] * c[0] + a0[0] * s[0]; v0[2] = a0[2] * c[1] - a0[3] * s[1]; v0[3] = a0[3] * c[1] + a0[2] * s[1];
                        v1[0] = a1[0] * c[2] - a1[1] * s[2]; v1[1] = a1[1] * c[2] + a1[0] * s[2]; v1[2] = a1[2] * c[3] - a1[3] * s[3]; v1[3] = a1[3] * c[3] + a1[2] * s[3]; }
                    v0 = v0 * QSCALE; v1 = v1 * QSCALE;
                    u32x4 w; w.x = cvt_pk_bf16(v0[0], v0[1]); w.y = cvt_pk_bf16(v0[2], v0[3]); w.z = cvt_pk_bf16(v1[0], v1[1]); w.w = cvt_pk_bf16(v1[2], v1[3]);
                    *(u32x4*)(O + (size_t)row * NQ + col0) = w; asm volatile("" ::: "memory"); } }
    }
};
struct EpiGates {
    static constexpr bool PERM = true;
    const bf16_t* xc; const float* b_a; const float* b_i; const float* c8; bf16_t* Aout; bf16_t* Uout; size_t dir_stride;
    __device__ __forceinline__ void operator()(const Acc& acc, const Unit& u, int wr, int wc, int fr, int fq) const {
        const int dir = u.pn >> 4, blk = u.pn & 15; const int row0 = u.pm * BM + wr * 64 + fr; const int ch0 = blk * HALF + wc * 32 + 8 * fq;
        bf16_t* Ao = Aout + (size_t)dir * dir_stride; bf16_t* Uo = Uout + (size_t)dir * dir_stride;
        f32x4 ba[2], bi[2], cc[2];
#pragma unroll
        for (int n = 0; n < 2; ++n) { ba[n] = *(const f32x4*)(b_a + dir * DM + ch0 + 4 * n); bi[n] = *(const f32x4*)(b_i + dir * DM + ch0 + 4 * n); cc[n] = *(const f32x4*)(c8 + dir * DM + ch0 + 4 * n); }
#pragma unroll
        for (int ai = 0; ai < 2; ++ai)
#pragma unroll
            for (int m = 0; m < 4; ++m) { const int row = row0 + ai * HALF + m * 16; const size_t off = (size_t)row * DM + ch0;
                const u32x4 xw = *(const u32x4*)(xc + off);
                const float xv[8] = {bf2f(xw.x & 0xffffu), bf2f(xw.x >> 16), bf2f(xw.y & 0xffffu), bf2f(xw.y >> 16), bf2f(xw.z & 0xffffu), bf2f(xw.z >> 16), bf2f(xw.w & 0xffffu), bf2f(xw.w >> 16)};
                float om[8], uv[8];
#pragma unroll
                for (int n = 0; n < 2; ++n)
#pragma unroll
                    for (int j = 0; j < 4; ++j) { const float r = fsigmoid(acc[ai][0][m][n][j] + ba[n][j]), ig = fsigmoid(acc[ai][1][m][n][j] + bi[n][j]);
                        const float y = r * cc[n][j];
                        float o1 = y * (1.0f - y * (0.5f - y * (0.16666667f - y * (0.041666668f - y * 0.008333334f))));
                        if (__builtin_expect(__any(y >= 0.125f), 0)) { const float ome = 1.0f - __expf(-y); o1 = y < 0.125f ? o1 : ome; }
                        om[n * 4 + j] = o1; uv[n * 4 + j] = sqrtf(o1 * (2.0f - o1)) * (ig * xv[n * 4 + j]); }
                u32x4 wa, wu; wa.x = cvt_pk_bf16(om[0], om[1]); wa.y = cvt_pk_bf16(om[2], om[3]); wa.z = cvt_pk_bf16(om[4], om[5]); wa.w = cvt_pk_bf16(om[6], om[7]);
                wu.x = cvt_pk_bf16(uv[0], uv[1]); wu.y = cvt_pk_bf16(uv[2], uv[3]); wu.z = cvt_pk_bf16(uv[4], uv[5]); wu.w = cvt_pk_bf16(uv[6], uv[7]);
                *(u32x4*)(Ao + off) = wa; *(u32x4*)(Uo + off) = wu; asm volatile("" ::: "memory"); }
    }
};
struct EpiT1 {
    static constexpr bool PERM = true;
    const bf16_t* gate; int ldg; bf16_t* O;
    __device__ __forceinline__ void operator()(const Acc& acc, const Unit& u, int wr, int wc, int fr, int fq) const {
        const int row0 = u.pm * BM + wr * 64 + fr;
#pragma unroll
        for (int ai = 0; ai < 2; ++ai)
#pragma unroll
            for (int m = 0; m < 4; ++m) { const int row = row0 + ai * HALF + m * 16;
#pragma unroll
                for (int bj = 0; bj < 2; ++bj) { const int col0 = u.pn * BM + bj * HALF + wc * 32 + 8 * fq;
                    const u32x4 gw = *(const u32x4*)(gate + (size_t)row * ldg + col0); f32x4 v0 = acc[ai][bj][m][0], v1 = acc[ai][bj][m][1];
                    v0[0] *= fsigmoid(bf2f(gw.x & 0xffffu)); v0[1] *= fsigmoid(bf2f(gw.x >> 16)); v0[2] *= fsigmoid(bf2f(gw.y & 0xffffu)); v0[3] *= fsigmoid(bf2f(gw.y >> 16));
                    v1[0] *= fsigmoid(bf2f(gw.z & 0xffffu)); v1[1] *= fsigmoid(bf2f(gw.z >> 16)); v1[2] *= fsigmoid(bf2f(gw.w & 0xffffu)); v1[3] *= fsigmoid(bf2f(gw.w >> 16));
                    u32x4 w; w.x = cvt_pk_bf16(v0[0], v0[1]); w.y = cvt_pk_bf16(v0[2], v0[3]); w.z = cvt_pk_bf16(v1[0], v1[1]); w.w = cvt_pk_bf16(v1[2], v1[3]);
                    *(u32x4*)(O + (size_t)row * DM + col0) = w; } asm volatile("" ::: "memory"); }
    }
};
struct EpiMerge {
    static constexpr bool PERM = true;
    const bf16_t* gate; int ldg; const bf16_t* T1; bf16_t* O;
    __device__ __forceinline__ void operator()(const Acc& acc, const Unit& u, int wr, int wc, int fr, int fq) const {
        const int row0 = u.pm * BM + wr * 64 + fr;
#pragma unroll
        for (int ai = 0; ai < 2; ++ai)
#pragma unroll
            for (int m = 0; m < 4; ++m) { const int row = row0 + ai * HALF + m * 16;
#pragma unroll
                for (int bj = 0; bj < 2; ++bj) { const int col0 = u.pn * BM + bj * HALF + wc * 32 + 8 * fq;
                    const u32x4 gw = *(const u32x4*)(gate + (size_t)row * ldg + col0); const u32x4 tw = *(const u32x4*)(T1 + (size_t)row * DM + col0);
                    f32x4 v0 = acc[ai][bj][m][0], v1 = acc[ai][bj][m][1];
                    const f32x4 t0 = {bf2f(tw.x & 0xffffu), bf2f(tw.x >> 16), bf2f(tw.y & 0xffffu), bf2f(tw.y >> 16)}, t1 = {bf2f(tw.z & 0xffffu), bf2f(tw.z >> 16), bf2f(tw.w & 0xffffu), bf2f(tw.w >> 16)};
                    v0[0] = t0[0] + v0[0] * fsigmoid(bf2f(gw.x & 0xffffu)); v0[1] = t0[1] + v0[1] * fsigmoid(bf2f(gw.x >> 16)); v0[2] = t0[2] + v0[2] * fsigmoid(bf2f(gw.y & 0xffffu)); v0[3] = t0[3] + v0[3] * fsigmoid(bf2f(gw.y >> 16));
                    v1[0] = t1[0] + v1[0] * fsigmoid(bf2f(gw.z & 0xffffu)); v1[1] = t1[1] + v1[1] * fsigmoid(bf2f(gw.z >> 16)); v1[2] = t1[2] + v1[2] * fsigmoid(bf2f(gw.w & 0xffffu)); v1[3] = t1[3] + v1[3] * fsigmoid(bf2f(gw.w >> 16));
                    u32x4 w; w.x = cvt_pk_bf16(v0[0], v0[1]); w.y = cvt_pk_bf16(v0[2], v0[3]); w.z = cvt_pk_bf16(v1[0], v1[1]); w.w = cvt_pk_bf16(v1[2], v1[3]);
                    *(u32x4*)(O + (size_t)row * DM + col0) = w; } asm volatile("" ::: "memory"); }
    }
};
}

namespace att {
constexpr int NW = 8, QBLK = 32, KVBLK = 64;
constexpr int LDQ = NQ, LDKV = NKV, LDO = DM;
constexpr int SLOT_K = 24576, SLOT_V = 16384, KR_OFF = 16384;
constexpr int OFF_K = 0, OFF_V = 3 * SLOT_K, OFF_WS = OFF_V + 3 * SLOT_V;
constexpr float THRL = 11.0f;
#define KNSWZ(row, colB) ((row) * 256 + ((colB) ^ (((row) & 15) << 4)))
#define KRSWZ(row, colB) ((row) * 128 + ((colB) ^ ((((row) >> 1) & 7) << 4)))
#define SBAR() __builtin_amdgcn_sched_barrier(0)
__device__ __forceinline__ int crow(int r, int hi) { return (r & 3) + 8 * (r >> 2) + 4 * hi; }

template <bool FIRST>
__device__ __forceinline__ void partialSM(f32x16& p0, f32x16& p1, float& m_reg, float& mn, float& alpha) {
    float pmax = p0[0];
#pragma unroll
    for (int r = 1; r < 16; ++r) pmax = fmaxf(pmax, p0[r]);
#pragma unroll
    for (int r = 0; r < 16; ++r) pmax = fmaxf(pmax, p1[r]);
    { auto rr = __builtin_amdgcn_permlane32_swap(__float_as_uint(pmax), __float_as_uint(pmax), false, false);
      pmax = fmaxf(__uint_as_float(rr[0]), __uint_as_float(rr[1])); }
    if (FIRST) { mn = (fabsf(pmax) <= THRL) ? 0.f : pmax; m_reg = mn; alpha = 1.f; }
    else if (__builtin_expect(__all(pmax - m_reg <= THRL), 1)) { mn = m_reg; alpha = 1.f; }
    else { mn = fmaxf(m_reg, pmax); alpha = __builtin_amdgcn_exp2f(m_reg - mn); m_reg = mn; }
    if (!__builtin_expect(__all(mn == 0.f), 1)) {
#pragma unroll
        for (int r = 0; r < 16; ++r) p0[r] = p0[r] - mn;
#pragma unroll
        for (int r = 0; r < 16; ++r) p1[r] = p1[r] - mn; }
#pragma unroll
    for (int r = 0; r < 16; ++r) p0[r] = __builtin_amdgcn_exp2f(p0[r]);
}
__device__ __forceinline__ void finishSM(f32x16& p0, f32x16& p1, float alpha, float& l_reg, bf16x8& pa0, bf16x8& pa1, bf16x8& pa2, bf16x8& pa3) {
#pragma unroll
    for (int r = 0; r < 16; ++r) p1[r] = __builtin_amdgcn_exp2f(p1[r]);
    float ps = 0;
#pragma unroll
    for (int r = 0; r < 16; ++r) ps += p0[r];
#pragma unroll
    for (int r = 0; r < 16; ++r) ps += p1[r];
    { auto rr = __builtin_amdgcn_permlane32_swap(__float_as_uint(ps), __float_as_uint(ps), false, false);
      ps = __uint_as_float(rr[0]) + __uint_as_float(rr[1]); }
    l_reg = l_reg * alpha + ps;
#define PK4(P, BASE, OUT) do { unsigned a0 = cvt_pk_bf16(P[BASE + 0], P[BASE + 1]), a1 = cvt_pk_bf16(P[BASE + 2], P[BASE + 3]);   \
    unsigned b0 = cvt_pk_bf16(P[BASE + 4], P[BASE + 5]), b1 = cvt_pk_bf16(P[BASE + 6], P[BASE + 7]);                              \
    auto r0 = __builtin_amdgcn_permlane32_swap(a0, b0, false, false); auto r1 = __builtin_amdgcn_permlane32_swap(a1, b1, false, false); \
    u32x4 w = {r0[0], r1[0], r0[1], r1[1]}; OUT = *reinterpret_cast<bf16x8*>(&w); } while (0)
    PK4(p0, 0, pa0); PK4(p0, 8, pa1); PK4(p1, 0, pa2); PK4(p1, 8, pa3);
#undef PK4
}
__device__ __forceinline__ void qkt(f32x16& p0, f32x16& p1, const char* Kn, const bf16x8* qr, int r32, int hi) {
    const char* Kr = Kn + KR_OFF;
    p0 = f32x16{}; p1 = f32x16{};
    __builtin_amdgcn_s_setprio(1);
#pragma unroll
    for (int d0 = 0; d0 < 8; ++d0) { const int cb = (d0 * 16 + hi * 8) * 2;
        const bf16x8 b0 = *reinterpret_cast<const bf16x8*>(Kn + KNSWZ(r32, cb));
        const bf16x8 b1 = *reinterpret_cast<const bf16x8*>(Kn + KNSWZ(32 + r32, cb));
        p0 = __builtin_amdgcn_mfma_f32_32x32x16_bf16(b0, qr[d0], p0, 0, 0, 0);
        p1 = __builtin_amdgcn_mfma_f32_32x32x16_bf16(b1, qr[d0], p1, 0, 0, 0); }
#pragma unroll
    for (int d0 = 0; d0 < 4; ++d0) { const int cb = (d0 * 16 + hi * 8) * 2;
        const bf16x8 b0 = *reinterpret_cast<const bf16x8*>(Kr + KRSWZ(r32, cb));
        const bf16x8 b1 = *reinterpret_cast<const bf16x8*>(Kr + KRSWZ(32 + r32, cb));
        p0 = __builtin_amdgcn_mfma_f32_32x32x16_bf16(b0, qr[8 + d0], p0, 0, 0, 0);
        p1 = __builtin_amdgcn_mfma_f32_32x32x16_bf16(b1, qr[8 + d0], p1, 0, 0, 0); }
}
__device__ __forceinline__ int v_st(int k, int c) { const int kk = (k & ~0xC) | ((k & 4) << 1) | ((k & 8) >> 1); return ((kk >> 3) * 4 + (c >> 5)) * 512 + ((kk & 7) * 32 + (c & 31)) * 2; }
__device__ __forceinline__ int v_rd_base(int lane) { return ((lane & 3) << 3) | (((lane >> 2) & 3) << 6) | (((lane >> 4) & 1) << 5) | (((lane >> 5) & 1) << 8); }
constexpr int v_rd_off(int d0, int ks, int half) { return d0 * 512 + ks * 4096 + half * 2048; }
template <int OFF> __device__ __forceinline__ s16x4 tr_read(int vb) {
    s16x4 r; asm volatile("ds_read_b64_tr_b16 %0, %1 offset:%2" : "=&v"(r) : "v"(vb), "i"(OFF) : "memory"); return r;
}
template <int D0> __device__ __forceinline__ void pv_one(f32x16& od, int vb, bf16x8 pa0, bf16x8 pa1, bf16x8 pa2, bf16x8 pa3) {
    const s16x4 l0 = tr_read<v_rd_off(D0, 0, 0)>(vb), h0 = tr_read<v_rd_off(D0, 0, 1)>(vb), l1 = tr_read<v_rd_off(D0, 1, 0)>(vb), h1 = tr_read<v_rd_off(D0, 1, 1)>(vb);
    const s16x4 l2 = tr_read<v_rd_off(D0, 2, 0)>(vb), h2 = tr_read<v_rd_off(D0, 2, 1)>(vb), l3 = tr_read<v_rd_off(D0, 3, 0)>(vb), h3 = tr_read<v_rd_off(D0, 3, 1)>(vb);
    asm volatile("s_waitcnt lgkmcnt(0)" ::: "memory"); SBAR();
#define PK(L, H) (bf16x8){L[0], L[1], L[2], L[3], H[0], H[1], H[2], H[3]}
    od = __builtin_amdgcn_mfma_f32_32x32x16_bf16(pa0, PK(l0, h0), od, 0, 0, 0);
    od = __builtin_amdgcn_mfma_f32_32x32x16_bf16(pa1, PK(l1, h1), od, 0, 0, 0);
    od = __builtin_amdgcn_mfma_f32_32x32x16_bf16(pa2, PK(l2, h2), od, 0, 0, 0);
    od = __builtin_amdgcn_mfma_f32_32x32x16_bf16(pa3, PK(l3, h3), od, 0, 0, 0);
#undef PK
}
__device__ __forceinline__ void pv_d0(f32x16* o, int vb, bf16x8 pa0, bf16x8 pa1, bf16x8 pa2, bf16x8 pa3) {
    pv_one<0>(o[0], vb, pa0, pa1, pa2, pa3); pv_one<1>(o[1], vb, pa0, pa1, pa2, pa3); pv_one<2>(o[2], vb, pa0, pa1, pa2, pa3); pv_one<3>(o[3], vb, pa0, pa1, pa2, pa3);
}

__device__ __forceinline__ void attn_unit(const bf16_t* __restrict__ Qb, const bf16_t* __restrict__ Kn, const bf16_t* __restrict__ Vh, const bf16_t* __restrict__ Kr,
                                          bf16_t* __restrict__ Ob, int seq, char* lds, int wv_) { LAUNDER_IDS;
    const int tid = tidx_, wid = __builtin_amdgcn_readfirstlane(tid >> 6), lane = tid & 63, r32 = lane & 31, hi = lane >> 5;
    LAS unsigned char* lds3 = (LAS unsigned char*)lds;
    float* ws = (float*)(lds + OFF_WS) + wid * 64; float* li_l = ws; float* al_l = ws + 32;
    float m_reg = 0.f, l_reg = 0; f32x16 o[4] = {}; bf16x8 qr[12];
    const bf16_t* Qw = Qb + (long)(wid * QBLK + r32) * LDQ + hi * 8;
#pragma unroll
    for (int d0 = 0; d0 < 12; ++d0) qr[d0] = *reinterpret_cast<const bf16x8*>(Qw + d0 * 16);
    unsigned gkn[2], gv[2], gkr;
#pragma unroll
    for (int i = 0; i < 2; ++i) { const int c = wid * 2 + i; const int row = c * 4 + (lane >> 4), slot = lane & 15; gkn[i] = (unsigned)(row * (LDKV * 2) + ((slot ^ (row & 15)) << 4));
        const int st = c * 2 + (lane >> 5), kk = (st >> 2) * 8 + ((lane & 31) >> 2), k = (kk & ~0xC) | ((kk & 4) << 1) | ((kk & 8) >> 1), col = (st & 3) * 32 + (lane & 3) * 8; gv[i] = (unsigned)(k * (LDKV * 2) + col * 2); }
    { const int row = wid * 8 + (lane >> 3), slot = lane & 7; gkr = (unsigned)(row * 128 + ((slot ^ ((row >> 1) & 7)) << 4)); }
    const int vb0 = (int)(uintptr_t)(lds + OFF_V) + v_rd_base(lane);
#define DMA(t, slot) do { const char* kt_ = (const char*)Kn + (size_t)(t) * (KVBLK * LDKV * 2); const char* vt_ = (const char*)Vh + (size_t)(t) * (KVBLK * LDKV * 2); const char* rt_ = (const char*)Kr + (size_t)(t) * (KVBLK * 128); \
    _Pragma("unroll") for (int i_ = 0; i_ < 2; ++i_) { \
      __builtin_amdgcn_global_load_lds((const unsigned*)(kt_ + gkn[i_]), (LAS unsigned*)(lds3 + OFF_K + (slot) * SLOT_K + (wid * 2 + i_) * 1024), 16, 0, 0); \
      __builtin_amdgcn_global_load_lds((const unsigned*)(vt_ + gv[i_]), (LAS unsigned*)(lds3 + OFF_V + (slot) * SLOT_V + (wid * 2 + i_) * 1024), 16, 0, 0); } \
    __builtin_amdgcn_global_load_lds((const unsigned*)(rt_ + gkr), (LAS unsigned*)(lds3 + OFF_K + (slot) * SLOT_K + KR_OFF + wid * 1024), 16, 0, 0); } while (0)
#define WAIT_BAR() asm volatile("s_waitcnt vmcnt(0) lgkmcnt(0)\n\ts_barrier" ::: "memory")
#define RESC(a) do { if (__any((a) < 1.f)) { if (hi == 0) al_l[r32] = (a); asm volatile("s_waitcnt lgkmcnt(0)" ::: "memory"); \
    _Pragma("unroll") for (int d = 0; d < 4; ++d) _Pragma("unroll") for (int r = 0; r < 16; ++r) o[d][r] *= al_l[crow(r, hi)]; } } while (0)
    f32x16 pA0, pA1, pB0, pB1; float mnA, mnB, alA, alB; bf16x8 pa0, pa1, pa2, pa3; const int NT = seq / KVBLK;
    DMA(0, 0); DMA(1, 1); WAIT_BAR();
    qkt(pA0, pA1, lds + OFF_K, qr, r32, hi); __builtin_amdgcn_s_setprio(0); partialSM<true>(pA0, pA1, m_reg, mnA, alA);
    int s_prev = 0, s_cur = 1, s_next = 2;
#define ROT() do { const int t_ = s_prev; s_prev = s_cur; s_cur = s_next; s_next = t_; } while (0)
    for (int j = 1; j + 1 < NT; j += 2) {
        DMA(j + 1, s_next); SBAR();
        qkt(pB0, pB1, lds + OFF_K + s_cur * SLOT_K, qr, r32, hi);
        finishSM(pA0, pA1, alA, l_reg, pa0, pa1, pa2, pa3); __builtin_amdgcn_s_setprio(0); SBAR();
        pv_d0(o, vb0 + s_prev * SLOT_V, pa0, pa1, pa2, pa3); partialSM<false>(pB0, pB1, m_reg, mnB, alB);
        RESC(alB); WAIT_BAR(); ROT();
        DMA(j + 2, s_next); SBAR();
        qkt(pA0, pA1, lds + OFF_K + s_cur * SLOT_K, qr, r32, hi);
        finishSM(pB0, pB1, alB, l_reg, pa0, pa1, pa2, pa3); __builtin_amdgcn_s_setprio(0); SBAR();
        pv_d0(o, vb0 + s_prev * SLOT_V, pa0, pa1, pa2, pa3); partialSM<false>(pA0, pA1, m_reg, mnA, alA);
        RESC(alA); WAIT_BAR(); ROT();
    }
    SBAR(); qkt(pB0, pB1, lds + OFF_K + s_cur * SLOT_K, qr, r32, hi);
    finishSM(pA0, pA1, alA, l_reg, pa0, pa1, pa2, pa3); __builtin_amdgcn_s_setprio(0); SBAR();
    pv_d0(o, vb0 + s_prev * SLOT_V, pa0, pa1, pa2, pa3); partialSM<false>(pB0, pB1, m_reg, mnB, alB);
    RESC(alB);
    finishSM(pB0, pB1, alB, l_reg, pa0, pa1, pa2, pa3); __builtin_amdgcn_s_setprio(0); SBAR();
    pv_d0(o, vb0 + s_cur * SLOT_V, pa0, pa1, pa2, pa3);
    if (hi == 0) li_l[r32] = l_reg; asm volatile("s_waitcnt lgkmcnt(0)" ::: "memory");
    float rli[16];
#pragma unroll
    for (int r = 0; r < 16; ++r) rli[r] = __builtin_amdgcn_rcpf(li_l[crow(r, hi)]);
    bf16_t* Ow = Ob + (long)(wid * QBLK) * LDO;
#pragma unroll
    for (int r = 0; r < 16; ++r) { const int orow = crow(r, hi);
#pragma unroll
        for (int d0 = 0; d0 < 4; ++d0) Ow[(long)orow * LDO + d0 * 32 + r32] = (bf16_t)(cvt_pk_bf16(o[d0][r] * rli[r], 0.f) & 0xffffu); }
    WAIT_BAR();
#undef DMA
#undef WAIT_BAR
#undef RESC
#undef ROT
}
}


#define XB_TMO      128
#define XB_XCNT(j)  (256  + 64 * (j))
#define XB_XSUB(j)  (1280 + 64 * (j))
#define XB_XGEN(j)  (2304 + 64 * (j))
#define XB_TOP      3328
#define XB_TOPGEN   3392
#define XCD_BAR_WORDS 3456
#define XB_SPIN_CAP (1u << 22)
__device__ __forceinline__ unsigned xb_ld(unsigned* p)              { return __hip_atomic_load(p, __ATOMIC_RELAXED, __HIP_MEMORY_SCOPE_AGENT); }
__device__ __forceinline__ unsigned xb_add(unsigned* p, unsigned v) { return __hip_atomic_fetch_add(p, v, __ATOMIC_RELAXED, __HIP_MEMORY_SCOPE_AGENT); }
__device__ __forceinline__ unsigned xb_xcc_id() { return (unsigned)__builtin_amdgcn_s_getreg((3 << 11) | 20) & 0xFu; }
#define XB_SPIN(cond, bar) do { unsigned _sp = 0; while (cond) { __builtin_amdgcn_s_sleep(1); \
    if ((++_sp & 255u) == 0u) { if (xb_ld(&(bar)[XB_TMO])) break; if (_sp > XB_SPIN_CAP) { atomicAdd(&(bar)[XB_TMO], 1u); break; } } } } while (0)
struct XcdBarrier { unsigned* bar; unsigned x; volatile LAS unsigned* st; };
__device__ __forceinline__ XcdBarrier xcd_barrier_post(unsigned* bar, volatile LAS unsigned* st) {
    XcdBarrier b; b.bar = bar; b.x = xb_xcc_id(); b.st = st;
    if (threadIdx.x == 0) (void)xb_add(&bar[XB_XCNT(b.x)], 1u);
    return b;
}
__device__ __forceinline__ void xcd_barrier_complete(unsigned* bar, unsigned x, unsigned& nloc, unsigned& nx) {
    const unsigned G = gridDim.x * gridDim.y * gridDim.z;
    unsigned sum, cnt, mine, sp = 0u;
    for (;;) {
        sum = 0u; cnt = 0u; mine = 0u;
#pragma unroll
        for (unsigned j = 0; j < 16; ++j) { const unsigned c = xb_ld(&bar[XB_XCNT(j)]); sum += c; cnt += (c > 0u) ? 1u : 0u; mine = (j == x) ? c : mine; }
        if (sum == G) break;
        __builtin_amdgcn_s_sleep(1);
        if ((++sp & 255u) == 0u) { if (xb_ld(&bar[XB_TMO])) break; if (sp > XB_SPIN_CAP) { atomicAdd(&bar[XB_TMO], 1u); break; } }
    }
    nloc = mine > 0u ? mine : 1u; nx = cnt > 0u ? cnt : 1u;
}
__device__ __forceinline__ void xcd_barrier(const XcdBarrier& b) {
    asm volatile("s_waitcnt vmcnt(0)" ::: "memory");
    __syncthreads();
    if (threadIdx.x == 0) {
        unsigned* bar = b.bar;
        __builtin_amdgcn_s_waitcnt(0);
        unsigned nloc = b.st[0], nx = b.st[1];
        if (nloc == 0u) { xcd_barrier_complete(bar, b.x, nloc, nx); b.st[0] = nloc; b.st[1] = nx; }
        const unsigned old = xb_add(&bar[XB_XSUB(b.x)], 1u);
        const unsigned gen = old / nloc;
        if (old + 1u == (gen + 1u) * nloc) {
            __builtin_amdgcn_fence(__ATOMIC_RELEASE, "agent");
            asm volatile("s_waitcnt vmcnt(0)" ::: "memory");
            const unsigned og = xb_add(&bar[XB_TOP], 1u);
            const unsigned tg = og / nx;
            if (og + 1u == (tg + 1u) * nx) xb_add(&bar[XB_TOPGEN], 1u);
            else XB_SPIN(xb_ld(&bar[XB_TOPGEN]) == tg, bar);
            __builtin_amdgcn_fence(__ATOMIC_ACQUIRE, "agent");
            xb_add(&bar[XB_XGEN(b.x)], 1u);
            asm volatile("s_waitcnt vmcnt(0)" ::: "memory");
        } else {
            XB_SPIN(xb_ld(&bar[XB_XGEN(b.x)]) == gen, bar);
            __builtin_amdgcn_fence(__ATOMIC_ACQUIRE, "agent");
            asm volatile("s_waitcnt vmcnt(0)" ::: "memory");
        }
    }
    __syncthreads();
}

struct Args { const float* in[27]; float* out; unsigned char* ws; int ph_lo, ph_hi; };

__device__ __forceinline__ int map_row(int mode, int row_off, int n) {
    if (mode == 0) return row_off + n;
    if (mode == 1) return (n >> 7) * 256 + row_off + (n & 127);
    if (mode == 2) { if (n >= C_KPE && n < C_KPE + 64) { const int j = n - C_KPE; return C_KPE + (j < 32 ? 2 * j : 2 * (j - 32) + 1); } return n; }
    { const int h = n / 192, d = n % 192; if (d < 128) return n; const int j = d - 128; return h * 192 + 128 + (j < 32 ? 2 * j : 2 * (j - 32) + 1); }
}
__device__ __forceinline__ void transpose_item(const float* W, int K, int N, bf16_t* WT, int mode, int row_off, LAS float* scr, int item, int lane) {
    const int nblk = N / 32, kb = item / nblk, nb = item % nblk, k0 = 64 * kb, n0 = 32 * nb;
    float wv[32];
#pragma unroll
    for (int i = 0; i < 32; ++i) { const int kk = 2 * i + (lane >> 5); wv[i] = W[(size_t)(k0 + kk) * N + n0 + (lane & 31)]; }
#pragma unroll
    for (int i = 0; i < 32; ++i) { const int kk = 2 * i + (lane >> 5); scr[kk * 33 + (lane & 31)] = wv[i]; }
    asm volatile("s_waitcnt lgkmcnt(0)" ::: "memory");
    const int c = lane & 7;
#pragma unroll
    for (int j = 0; j < 4; ++j) { const int n = (lane >> 3) + 8 * j; const LAS float* s = scr + (8 * c) * 33 + n;
        u32x4 o; o.x = cvt_pk_bf16(s[0 * 33], s[1 * 33]); o.y = cvt_pk_bf16(s[2 * 33], s[3 * 33]); o.z = cvt_pk_bf16(s[4 * 33], s[5 * 33]); o.w = cvt_pk_bf16(s[6 * 33], s[7 * 33]);
        *(u32x4*)(WT + (size_t)map_row(mode, row_off, n0 + n) * K + k0 + 8 * c) = o; }
    asm volatile("s_waitcnt lgkmcnt(0)" ::: "memory");
}

__device__ __forceinline__ void rms_row2_bf16(const float* xrow0, const float* xrow1, const float* g, bf16_t* orow0, bf16_t* orow1, int lane) {
    const f32x4* xr0 = (const f32x4*)xrow0 + lane; const f32x4* xr1 = (const f32x4*)xrow1 + lane; const f32x4* gr = (const f32x4*)g + lane;
    f32x4 v0[8], v1[8]; float s0 = 0.f, s1 = 0.f;
#pragma unroll
    for (int j = 0; j < 8; ++j) { v0[j] = __builtin_nontemporal_load(xr0 + 64 * j); v1[j] = __builtin_nontemporal_load(xr1 + 64 * j); }
#pragma unroll
    for (int j = 0; j < 8; ++j) { s0 += (v0[j].x * v0[j].x + v0[j].y * v0[j].y) + (v0[j].z * v0[j].z + v0[j].w * v0[j].w); s1 += (v1[j].x * v1[j].x + v1[j].y * v1[j].y) + (v1[j].z * v1[j].z + v1[j].w * v1[j].w); }
    const float r0 = rsqrtf(wave_sum(s0) * (1.f / DM) + RMS_EPS), r1 = rsqrtf(wave_sum(s1) * (1.f / DM) + RMS_EPS);
    u32x2* o0 = (u32x2*)orow0 + lane; u32x2* o1 = (u32x2*)orow1 + lane;
#pragma unroll
    for (int j = 0; j < 8; ++j) { const f32x4 gg = gr[64 * j]; u32x2 w;
        w.x = cvt_pk_bf16(v0[j].x * r0 * gg.x, v0[j].y * r0 * gg.y); w.y = cvt_pk_bf16(v0[j].z * r0 * gg.z, v0[j].w * r0 * gg.w); o0[64 * j] = w;
        w.x = cvt_pk_bf16(v1[j].x * r1 * gg.x, v1[j].y * r1 * gg.y); w.y = cvt_pk_bf16(v1[j].z * r1 * gg.z, v1[j].w * r1 * gg.w); o1[64 * j] = w; }
}
__device__ __forceinline__ void rms_row2_f32_inplace(float* xrow0, float* xrow1, const float* g, int lane) {
    f32x4* xr0 = (f32x4*)xrow0 + lane; f32x4* xr1 = (f32x4*)xrow1 + lane; const f32x4* gr = (const f32x4*)g + lane;
    f32x4 v0[8], v1[8]; float s0 = 0.f, s1 = 0.f;
#pragma unroll
    for (int j = 0; j < 8; ++j) { v0[j] = __builtin_nontemporal_load(xr0 + 64 * j); v1[j] = __builtin_nontemporal_load(xr1 + 64 * j); }
#pragma unroll
    for (int j = 0; j < 8; ++j) { s0 += (v0[j].x * v0[j].x + v0[j].y * v0[j].y) + (v0[j].z * v0[j].z + v0[j].w * v0[j].w); s1 += (v1[j].x * v1[j].x + v1[j].y * v1[j].y) + (v1[j].z * v1[j].z + v1[j].w * v1[j].w); }
    const float r0 = rsqrtf(wave_sum(s0) * (1.f / DM) + RMS_EPS), r1 = rsqrtf(wave_sum(s1) * (1.f / DM) + RMS_EPS);
#pragma unroll
    for (int j = 0; j < 8; ++j) { const f32x4 gg = gr[64 * j]; xr0[64 * j] = v0[j] * r0 * gg; xr1[64 * j] = v1[j] * r1 * gg; }
}

__device__ __forceinline__ void phase_prologue(const Args& a, LAS unsigned char* lds, int wv_) { LAUNDER_IDS;
    const int tid = tidx_, lane = tid & 63, wave = tid >> 6;
    unsigned char* ws = a.ws;
    LAS float* scr = (LAS float*)(lds + wave * 16384);
    const int gw = bidx_ * 8 + wave, NGW = gridDim.x * 8;
    constexpr int I_GU = (DM / 64) * (DFF / 32), I_D = (DFF / 64) * (DM / 32), I_IN = (DM / 64) * (NIN / 32), I_UQ = (512 / 64) * (NQ / 32), I_UKV = (512 / 64) * (NKV / 32),
                  I_SQ = (DM / 64) * (DM / 32), I_G = 64 * 8;
    constexpr int NITEMS = 4 * I_GU + 2 * I_D + I_IN + I_UQ + I_UKV + 3 * I_SQ + I_G;
    for (int it = gw; it < NITEMS; it += NGW) {
        int r = it;
        if (r < I_GU) { transpose_item(a.in[3], DM, DFF, (bf16_t*)(ws + WS_W1GU), 1, 0, scr, r, lane); continue; } r -= I_GU;
        if (r < I_GU) { transpose_item(a.in[4], DM, DFF, (bf16_t*)(ws + WS_W1GU), 1, 128, scr, r, lane); continue; } r -= I_GU;
        if (r < I_GU) { transpose_item(a.in[23], DM, DFF, (bf16_t*)(ws + WS_W2GU), 1, 0, scr, r, lane); continue; } r -= I_GU;
        if (r < I_GU) { transpose_item(a.in[24], DM, DFF, (bf16_t*)(ws + WS_W2GU), 1, 128, scr, r, lane); continue; } r -= I_GU;
        if (r < I_D) { transpose_item(a.in[5], DFF, DM, (bf16_t*)(ws + WS_W1D), 0, 0, scr, r, lane); continue; } r -= I_D;
        if (r < I_D) { transpose_item(a.in[25], DFF, DM, (bf16_t*)(ws + WS_W2D), 0, 0, scr, r, lane); continue; } r -= I_D;
        if (r < I_IN) { transpose_item(a.in[7], DM, NIN, (bf16_t*)(ws + WS_WIN), 2, 0, scr, r, lane); continue; } r -= I_IN;
        if (r < I_UQ) { transpose_item(a.in[9], 512, NQ, (bf16_t*)(ws + WS_WUQ), 3, 0, scr, r, lane); continue; } r -= I_UQ;
        if (r < I_UKV) { transpose_item(a.in[11], 512, NKV, (bf16_t*)(ws + WS_WUKV), 0, 0, scr, r, lane); continue; } r -= I_UKV;
        if (r < I_SQ) { transpose_item(a.in[12], DM, DM, (bf16_t*)(ws + WS_WOA), 0, 0, scr, r, lane); continue; } r -= I_SQ;
        if (r < I_SQ) { transpose_item(a.in[20], DM, DM, (bf16_t*)(ws + WS_WOR), 0, 0, scr, r, lane); continue; } r -= I_SQ;
        if (r < I_SQ) { transpose_item(a.in[21], DM, DM, (bf16_t*)(ws + WS_WOUT), 0, 0, scr, r, lane); continue; } r -= I_SQ;
        { const int mat = r >> 3, sub = r & 7, type = mat & 1, db = mat >> 1;
          transpose_item((type ? a.in[17] : a.in[15]) + (size_t)db * 128 * 128, 128, 128, (bf16_t*)(ws + WS_WG), 0, mat * 128, scr, sub, lane); }
    }
    { const int gt = bidx_ * 512 + tid, NT = gridDim.x * 512; u32x4* p = (u32x4*)((bf16_t*)(ws + WS_WIN) + (size_t)NIN * DM);
      unsigned z = 0u; asm volatile("" : "+v"(z));
      for (int i = gt; i < (NINP - NIN) * DM / 8; i += NT) p[i] = (u32x4){z, z, z, z}; }
    { const int gt = bidx_ * 512 + tid, NT = gridDim.x * 512; float* cosT = (float*)(ws + WS_COS); float* sinT = (float*)(ws + WS_SIN); float* c8 = (float*)(ws + WS_C8);
      for (int i = gt; i < SEQ * 32; i += NT) { const int pos = i >> 5, j = i & 31;
          const float inv = __builtin_amdgcn_exp2f(-(float)j * 0.41524101186092029f);
          const float ang = (float)pos * inv;
          const double t = (double)ang * 0.15915494309189535; const float fr = (float)(t - __builtin_floor(t));
          cosT[i] = __builtin_amdgcn_cosf(fr); sinT[i] = __builtin_amdgcn_sinf(fr); }
      for (int i = gt; i < 2 * DM; i += NT) { const float l = a.in[19][i]; const float x = __expf(-l);
          const float ser = x * (1.0f - x * (0.5f - x * (0.33333334f - x * (0.25f - x * 0.2f))));
          const float sp = (-l > 20.f) ? -l : (x < 0.05f ? ser : __logf(1.0f + x)); c8[i] = 8.0f * sp; } }
    for (int m = 2 * gw; m < MTOT; m += 2 * NGW) { const float* xr = m < SEQ ? a.in[0] + (size_t)m * DM : a.in[1] + (size_t)(m - SEQ) * DM;
        rms_row2_bf16(xr, xr + DM, a.in[2], (bf16_t*)(ws + WS_H) + (size_t)m * DM, (bf16_t*)(ws + WS_H) + (size_t)(m + 1) * DM, lane); }
}

__device__ __forceinline__ void phase_norm(const Args& a, const float* g, int wv_) { LAUNDER_IDS;
    const int lane = tidx_ & 63, gw = bidx_ * 8 + (tidx_ >> 6), NGW = gridDim.x * 8;
    for (int m = 2 * gw; m < MTOT; m += 2 * NGW) rms_row2_bf16(a.out + (size_t)m * DM, a.out + (size_t)(m + 1) * DM, g, (bf16_t*)(a.ws + WS_H) + (size_t)m * DM, (bf16_t*)(a.ws + WS_H) + (size_t)(m + 1) * DM, lane);
}
__device__ __forceinline__ void phase_final_norm(const Args& a, int wv_) { LAUNDER_IDS;
    const int lane = tidx_ & 63, gw = bidx_ * 8 + (tidx_ >> 6), NGW = gridDim.x * 8;
    for (int m = 2 * gw; m < MTOT; m += 2 * NGW) rms_row2_f32_inplace(a.out + (size_t)m * DM, a.out + (size_t)(m + 1) * DM, a.in[26], lane);
}

__device__ __forceinline__ void phase_small(const Args& a, int wv_) { LAUNDER_IDS;
    unsigned char* ws = a.ws; const int tid = tidx_, lane = tid & 63, gw = bidx_ * 8 + (tid >> 6), NGW = gridDim.x * 8;
    const bf16_t* proj = (const bf16_t*)(ws + WS_PROJ);
    for (int row = gw; row < SEQ; row += NGW) {
        const u32x4 wq = *(const u32x4*)(proj + (size_t)row * NINP + C_CQ + lane * 8), wk = *(const u32x4*)(proj + (size_t)row * NINP + C_CKV + lane * 8);
        const unsigned pw = *(const unsigned*)(proj + (size_t)row * NINP + C_KPE + 2 * (lane & 31));
        const f32x4 gq0 = *(const f32x4*)(a.in[8] + lane * 8), gq1 = *(const f32x4*)(a.in[8] + lane * 8 + 4), gk0 = *(const f32x4*)(a.in[10] + lane * 8), gk1 = *(const f32x4*)(a.in[10] + lane * 8 + 4);
        const float c = ((const float*)(ws + WS_COS))[row * 32 + (lane & 31)], sn = ((const float*)(ws + WS_SIN))[row * 32 + (lane & 31)];
        float vq[8] = {bf2f(wq.x & 0xffffu), bf2f(wq.x >> 16), bf2f(wq.y & 0xffffu), bf2f(wq.y >> 16), bf2f(wq.z & 0xffffu), bf2f(wq.z >> 16), bf2f(wq.w & 0xffffu), bf2f(wq.w >> 16)};
        float vk[8] = {bf2f(wk.x & 0xffffu), bf2f(wk.x >> 16), bf2f(wk.y & 0xffffu), bf2f(wk.y >> 16), bf2f(wk.z & 0xffffu), bf2f(wk.z >> 16), bf2f(wk.w & 0xffffu), bf2f(wk.w >> 16)};
        float sq = 0.f, sk = 0.f;
#pragma unroll
        for (int j = 0; j < 8; ++j) { sq += vq[j] * vq[j]; sk += vk[j] * vk[j]; }
        const float rq = rsqrtf(wave_sum(sq) * (1.f / 512.f) + RMS_EPS), rk = rsqrtf(wave_sum(sk) * (1.f / 512.f) + RMS_EPS);
        u32x4 oq, ok;
        oq.x = cvt_pk_bf16(vq[0] * rq * gq0.x, vq[1] * rq * gq0.y); oq.y = cvt_pk_bf16(vq[2] * rq * gq0.z, vq[3] * rq * gq0.w); oq.z = cvt_pk_bf16(vq[4] * rq * gq1.x, vq[5] * rq * gq1.y); oq.w = cvt_pk_bf16(vq[6] * rq * gq1.z, vq[7] * rq * gq1.w);
        ok.x = cvt_pk_bf16(vk[0] * rk * gk0.x, vk[1] * rk * gk0.y); ok.y = cvt_pk_bf16(vk[2] * rk * gk0.z, vk[3] * rk * gk0.w); ok.z = cvt_pk_bf16(vk[4] * rk * gk1.x, vk[5] * rk * gk1.y); ok.w = cvt_pk_bf16(vk[6] * rk * gk1.z, vk[7] * rk * gk1.w);
        *(u32x4*)((bf16_t*)(ws + WS_CQN) + (size_t)row * 512 + lane * 8) = oq; *(u32x4*)((bf16_t*)(ws + WS_CKVN) + (size_t)row * 512 + lane * 8) = ok;
        if (lane < 32) { const float x1 = bf2f(pw & 0xffffu), x2 = bf2f(pw >> 16); *(unsigned*)((bf16_t*)(ws + WS_KPE) + (size_t)row * 64 + 2 * lane) = cvt_pk_bf16(x1 * c - x2 * sn, x2 * c + x1 * sn); }
    }
    const int gt = bidx_ * 512 + tid, NT = gridDim.x * 512; bf16_t* xc = (bf16_t*)(ws + WS_XC);
    for (int i = gt; i < (SEQ / 4) * (DM / 8); i += NT) {
        const int r0 = (i >> 8) * 4, c0 = (i & 255) * 8;
        u32x4 xr[7]; unsigned z = 0u; asm volatile("" : "+v"(z));
#pragma unroll
        for (int k = 0; k < 7; ++k) { const int t = r0 + k - 2; xr[k] = (t >= 0 && t < SEQ) ? *(const u32x4*)(proj + (size_t)t * NINP + C_XREC + c0) : (u32x4){z, z, z, z}; }
        f32x4 wlo[4], whi[4];
#pragma unroll
        for (int k = 0; k < 4; ++k) { wlo[k] = *(const f32x4*)(a.in[13] + k * DM + c0); whi[k] = *(const f32x4*)(a.in[13] + k * DM + c0 + 4); }
        const f32x4 b0 = *(const f32x4*)(a.in[14] + c0), b1 = *(const f32x4*)(a.in[14] + c0 + 4);
#pragma unroll
        for (int r = 0; r < 4; ++r) { f32x4 lo = b0, hi = b1;
#pragma unroll
            for (int k = 0; k < 4; ++k) { const u32x4 w = xr[r + k];
                lo += (f32x4){bf2f(w.x & 0xffffu), bf2f(w.x >> 16), bf2f(w.y & 0xffffu), bf2f(w.y >> 16)} * wlo[k]; hi += (f32x4){bf2f(w.z & 0xffffu), bf2f(w.z >> 16), bf2f(w.w & 0xffffu), bf2f(w.w >> 16)} * whi[k]; }
            u32x4 o; o.x = cvt_pk_bf16(lo[0], lo[1]); o.y = cvt_pk_bf16(lo[2], lo[3]); o.z = cvt_pk_bf16(hi[0], hi[1]); o.w = cvt_pk_bf16(hi[2], hi[3]);
            *(u32x4*)(xc + (size_t)(r0 + r) * DM + c0) = o; }
    }
}

__device__ __forceinline__ void phase_scan1(const Args& a, int wv_) { LAUNDER_IDS;
    unsigned char* ws = a.ws; const int tid = tidx_;
    for (int it = bidx_; it < 1024; it += gridDim.x) {
        const int half = it & 1, dir = (it >> 1) & 1, c = it >> 2, ch = half * 1024 + tid * 2;
        const bf16_t* A = (const bf16_t*)(ws + (dir ? WS_AB : WS_AF)) + ch; const bf16_t* U = (const bf16_t*)(ws + (dir ? WS_UB : WS_UF)) + ch;
        f32x2 P = {1.f, 1.f}, Hh = {0.f, 0.f};
        unsigned awv[32], uwv[32];
#pragma unroll
        for (int i = 0; i < 32; ++i) { const int t = dir ? (c * 32 + 31 - i) : (c * 32 + i); awv[i] = *(const unsigned*)(A + (size_t)t * DM); uwv[i] = *(const unsigned*)(U + (size_t)t * DM); }
#pragma unroll
        for (int i = 0; i < 32; ++i) { const unsigned aw = awv[i], uw = uwv[i];
            const f32x2 av = {1.0f - bf2f(aw & 0xffffu), 1.0f - bf2f(aw >> 16)}, uv = {bf2f(uw & 0xffffu), bf2f(uw >> 16)}; Hh = av * Hh + uv; P = P * av; }
        *(f32x2*)((float*)(ws + WS_AGGA) + (size_t)(dir * 256 + c) * DM + ch) = P; *(f32x2*)((float*)(ws + WS_AGGB) + (size_t)(dir * 256 + c) * DM + ch) = Hh;
    }
}
__device__ __forceinline__ void phase_scan15(const Args& a, LAS unsigned char* lds, int wv_) { LAUNDER_IDS;
    if (bidx_ >= 32) return;
    unsigned char* ws = a.ws; const int tid = tidx_, seg = tid >> 6, cpl = tid & 63, idx = bidx_ * 64 + cpl, dir = idx >> 10, ch = (idx & 1023) * 2;
    const float* GA = (const float*)(ws + WS_AGGA) + (size_t)dir * 256 * DM + ch; const float* GB = (const float*)(ws + WS_AGGB) + (size_t)dir * 256 * DM + ch; float* CR = (float*)(ws + WS_CARRY) + (size_t)dir * 256 * DM + ch;
    LAS f32x4* seg_agg = (LAS f32x4*)lds;
    f32x2 A = {1.f, 1.f}, B = {0.f, 0.f};
#pragma unroll 8
    for (int i = 0; i < 32; ++i) { const int c = dir ? 255 - (seg * 32 + i) : seg * 32 + i; const f32x2 av = *(const f32x2*)(GA + (size_t)c * DM), bv = *(const f32x2*)(GB + (size_t)c * DM); B = av * B + bv; A = A * av; }
    seg_agg[seg * 64 + cpl] = (f32x4){A.x, A.y, B.x, B.y};
    __syncthreads();
    f32x2 carry = {0.f, 0.f};
    for (int k = 0; k < seg; ++k) { const f32x4 g = seg_agg[k * 64 + cpl]; carry = (f32x2){g.x, g.y} * carry + (f32x2){g.z, g.w}; }
    __syncthreads();
#pragma unroll 8
    for (int i = 0; i < 32; ++i) { const int c = dir ? 255 - (seg * 32 + i) : seg * 32 + i; *(f32x2*)(CR + (size_t)c * DM) = carry; const f32x2 av = *(const f32x2*)(GA + (size_t)c * DM), bv = *(const f32x2*)(GB + (size_t)c * DM); carry = av * carry + bv; }
}
__device__ __forceinline__ void phase_scan2(const Args& a, int wv_) { LAUNDER_IDS;
    unsigned char* ws = a.ws; const int tid = tidx_;
    const bf16_t* proj = (const bf16_t*)(ws + WS_PROJ); bf16_t* yg = (bf16_t*)(ws + WS_YG);
    for (int it = bidx_; it < 512; it += gridDim.x) {
        const int half = it & 1, c = it >> 1, ch = half * 1024 + tid * 2;
        const bf16_t* AF = (const bf16_t*)(ws + WS_AF) + ch; const bf16_t* UF = (const bf16_t*)(ws + WS_UF) + ch; const bf16_t* AB = (const bf16_t*)(ws + WS_AB) + ch; const bf16_t* UB = (const bf16_t*)(ws + WS_UB) + ch;
        f32x2 hf[32]; f32x2 h = *(const f32x2*)((const float*)(ws + WS_CARRY) + (size_t)c * DM + ch);
        { unsigned awv[32], uwv[32];
#pragma unroll
          for (int i = 0; i < 32; ++i) { const int t = c * 32 + i; awv[i] = *(const unsigned*)(AF + (size_t)t * DM); uwv[i] = *(const unsigned*)(UF + (size_t)t * DM); }
#pragma unroll
          for (int i = 0; i < 32; ++i) { const unsigned aw = awv[i], uw = uwv[i];
            const f32x2 av = {1.0f - bf2f(aw & 0xffffu), 1.0f - bf2f(aw >> 16)}, uv = {bf2f(uw & 0xffffu), bf2f(uw >> 16)}; h = av * h + uv; hf[i] = h; } }
        h = *(const f32x2*)((const float*)(ws + WS_CARRY) + (size_t)(256 + c) * DM + ch);
        { unsigned awv[32], uwv[32], gwv[32];
#pragma unroll
          for (int i = 0; i < 32; ++i) { const int t = c * 32 + i; awv[i] = *(const unsigned*)(AB + (size_t)t * DM); uwv[i] = *(const unsigned*)(UB + (size_t)t * DM); gwv[i] = *(const unsigned*)(proj + (size_t)t * NINP + C_GREC + ch); }
#pragma unroll
          for (int i = 31; i >= 0; --i) { const int t = c * 32 + i; const unsigned aw = awv[i], uw = uwv[i], gw = gwv[i];
            const f32x2 av = {1.0f - bf2f(aw & 0xffffu), 1.0f - bf2f(aw >> 16)}, uv = {bf2f(uw & 0xffffu), bf2f(uw >> 16)}; h = av * h + uv;
            const f32x2 hs = hf[i] + h;
            *(unsigned*)(yg + (size_t)t * DM + ch) = cvt_pk_bf16(gelu_tanh(bf2f(gw & 0xffffu)) * hs.x, gelu_tanh(bf2f(gw >> 16)) * hs.y); } }
    }
}

__device__ __forceinline__ void phase_attention(const Args& a, char* lds, int wv_) { LAUNDER_IDS;
    unsigned char* ws = a.ws; const int G = gridDim.x, bx = bidx_; const int vcu = (G % 8 == 0) ? (bx % 8) * (G / 8) + bx / 8 : bx;
    const bf16_t* Q = (const bf16_t*)(ws + WS_Q); const bf16_t* KV = (const bf16_t*)(ws + WS_KV); const bf16_t* KPE = (const bf16_t*)(ws + WS_KPE); bf16_t* O = (bf16_t*)(ws + WS_ATTO);
    for (int u = vcu; u < 512; u += G) { const int h = u >> 5, qb = u & 31;
        att::attn_unit(Q + (size_t)qb * 256 * NQ + h * 192, KV + h * 256, KV + h * 256 + 128, KPE, O + (size_t)qb * 256 * DM + h * 128, SEQ, lds, wv_); }
}

__device__ __forceinline__ void phase_ffn_up(const Args& a, LAS unsigned char* lds, int which, int wv_) {
    pg8::Gemm g{(const bf16_t*)(a.ws + WS_H), (const bf16_t*)(a.ws + (which ? WS_W2GU : WS_W1GU))};
    pg8::EpiSwiglu E{(bf16_t*)(a.ws + WS_ACT), DFF};
    pg8::gemm_phase<pg8::EpiSwiglu, MTOT, 2 * DFF, DM, DM, 0, 0, FFN_UP_WG>(lds, g, E, wv_);
}
__device__ __forceinline__ void phase_ffn_down(const Args& a, LAS unsigned char* lds, int which, int wv_) {
    pg8::Gemm g{(const bf16_t*)(a.ws + WS_ACT), (const bf16_t*)(a.ws + (which ? WS_W2D : WS_W1D))};
    pg8::EpiResid E{which ? a.out : a.in[0], which ? a.out : a.in[1], which ? MTOT : SEQ, a.out, 0.5f, 0};
    pg8::gemm_phase<pg8::EpiResid, MTOT, DM, DFF, DFF, 0, 0>(lds, g, E, wv_);
}
__device__ __forceinline__ void phase_wout(const Args& a, LAS unsigned char* lds, int s, int wv_) {
    pg8::Gemm g{(const bf16_t*)(a.ws + WS_H), (const bf16_t*)(a.ws + WS_WOUT)};
    pg8::EpiResid E{a.out, a.out, MTOT, a.out, 1.0f, 0};
    pg8::gemm_phase<pg8::EpiResid, MTOT, DM, DM, DM, 0, 0>(lds, g, E, wv_);
}
__device__ __forceinline__ void phase_win(const Args& a, LAS unsigned char* lds, int s, int wv_) {
    pg8::Gemm g{(const bf16_t*)(a.ws + WS_H) + (size_t)s * SEQ * DM, (const bf16_t*)(a.ws + WS_WIN)}; pg8::EpiBf16 E{(bf16_t*)(a.ws + WS_PROJ), NINP};
    pg8::gemm_phase<pg8::EpiBf16, SEQ, NINP, DM, DM, 0, 0>(lds, g, E, wv_);
}
__device__ __forceinline__ void phase_kv(const Args& a, LAS unsigned char* lds, int wv_) {
    pg8::Gemm g{(const bf16_t*)(a.ws + WS_CKVN), (const bf16_t*)(a.ws + WS_WUKV)}; pg8::EpiBf16 E{(bf16_t*)(a.ws + WS_KV), NKV};
    pg8::gemm_phase<pg8::EpiBf16, SEQ, NKV, 512, 512, 0, 0>(lds, g, E, wv_);
}

__device__ __forceinline__ void run_phase(const Args& a, int ph, unsigned char* lds_g, int wv_) {
    LAS unsigned char* lds = (LAS unsigned char*)lds_g; unsigned char* ws = a.ws;
    if (ph == 0) { if (PHM(0)) phase_prologue(a, lds, wv_); return; }
    if (ph == 1 || ph == 41) { if (PHM(1)) phase_ffn_up(a, lds, ph == 41, wv_); return; }
    if (ph == 2 || ph == 42) { if (PHM(2)) phase_ffn_down(a, lds, ph == 42, wv_); return; }
    if (ph == 3) { if (PHM(3)) phase_norm(a, a.in[6], wv_); return; }
    if (ph == 40) { if (PHM(3)) phase_norm(a, a.in[22], wv_); return; }
    if (ph == 39) { if (PHM(16)) phase_wout(a, lds, 0, wv_); return; }
    if (ph == 43) { if (PHM(4)) phase_final_norm(a, wv_); return; }
    const int s = (ph - 4) / 7, sub = (ph - 4) % 7;
    switch (sub) {
    case 0: if (PHM(5)) phase_win(a, lds, s, wv_); break;
    case 1: if (PHM(6)) phase_small(a, wv_); break;
    case 2: {
        if (PHM(7)) { pg8::Gemm g{(const bf16_t*)(ws + WS_CQN), (const bf16_t*)(ws + WS_WUQ)}; pg8::EpiQ E{(bf16_t*)(ws + WS_Q), (const float*)(ws + WS_COS), (const float*)(ws + WS_SIN)};
          pg8::gemm_phase<pg8::EpiQ, SEQ, NQ, 512, 512, 0, 0>(lds, g, E, wv_); }
        if (PHM(15)) phase_kv(a, lds, wv_);
        if (PHM(8)) { pg8::Gemm g{(const bf16_t*)(ws + WS_XC), (const bf16_t*)(ws + WS_WG)};
          pg8::EpiGates E{(const bf16_t*)(ws + WS_XC), a.in[16], a.in[18], (const float*)(ws + WS_C8), (bf16_t*)(ws + WS_AF), (bf16_t*)(ws + WS_UF), (size_t)(WS_AB - WS_AF) / 2};
          pg8::gemm_phase<pg8::EpiGates, SEQ, 8192, 128, DM, 16, 128>(lds, g, E, wv_); }
        break; }
    case 3: if (PHM(9)) phase_attention(a, (char*)lds_g, wv_); if (PHM(10)) phase_scan1(a, wv_); break;
    case 4: {
        if (PHM(11)) phase_scan15(a, lds, wv_);
        if (PHM(12)) { pg8::Gemm g{(const bf16_t*)(ws + WS_ATTO), (const bf16_t*)(ws + WS_WOA)}; pg8::EpiT1 E{(const bf16_t*)(ws + WS_PROJ) + C_GA, NINP, (bf16_t*)(ws + WS_T1)};
        pg8::gemm_phase<pg8::EpiT1, SEQ, DM, DM, DM, 0, 0>(lds, g, E, wv_); } break; }
    case 5: if (PHM(13)) phase_scan2(a, wv_); break;
    case 6: {
        if (PHM(14)) { pg8::Gemm g{(const bf16_t*)(ws + WS_YG), (const bf16_t*)(ws + WS_WOR)}; pg8::EpiMerge E{(const bf16_t*)(ws + WS_PROJ) + C_GR, NINP, (const bf16_t*)(ws + WS_T1), (bf16_t*)(ws + WS_H) + (size_t)s * SEQ * DM};
        pg8::gemm_phase<pg8::EpiMerge, SEQ, DM, DM, DM, 0, 0>(lds, g, E, wv_); } break; }
    default: break;
    }
}

__global__ void __launch_bounds__(512, 2) mega(Args a) {
    extern __shared__ __attribute__((aligned(16))) unsigned char lds[];
    cg::grid_group grid = cg::this_grid();
    const int wv_ = __builtin_amdgcn_readfirstlane(threadIdx.x >> 6);
    volatile LAS unsigned* misc = (volatile LAS unsigned*)((LAS unsigned char*)lds + (LDS_BYTES - 64));
    if (threadIdx.x < 2) misc[threadIdx.x] = 0u;
    __syncthreads();
    XcdBarrier bar = xcd_barrier_post((unsigned*)(a.ws + WS_CTL), misc);
    for (int ph = a.ph_lo; ph < a.ph_hi; ++ph) {
#ifdef PROBE_REPEAT
        if (PROBE_REPEAT(ph)) { run_phase(a, ph, lds, wv_); xcd_barrier(bar); }
#endif
        run_phase(a, ph, lds, wv_);
        if (ph + 1 < a.ph_hi) { if (ph == a.ph_lo) grid.sync(); else xcd_barrier(bar); }
    }
}

extern "C" void kernel_launch(void* const* d_in, const int* in_sizes, int n_in, void* d_out, int out_size, void* d_ws, size_t ws_size, hipStream_t stream) {
    static int grid = 0;
    if (grid == 0) {
        if (n_in != 27 || out_size != MTOT * DM || ws_size < WS_END) { fprintf(stderr, "kernel_launch: unexpected shapes: n_in %d out %d ws %zu (need %zu)\n", n_in, out_size, ws_size, (size_t)WS_END); grid = -1; return; }
        int dev = 0, cus = 0, per_cu = 0;
        (void)hipGetDevice(&dev); (void)hipDeviceGetAttribute(&cus, hipDeviceAttributeMultiprocessorCount, dev);
        if (hipFuncSetAttribute((const void*)mega, hipFuncAttributeMaxDynamicSharedMemorySize, LDS_BYTES) != hipSuccess) { fprintf(stderr, "kernel_launch: hipFuncSetAttribute failed\n"); grid = -1; return; }
        (void)hipOccupancyMaxActiveBlocksPerMultiprocessor(&per_cu, (const void*)mega, 512, LDS_BYTES);
        if (per_cu < 1) { fprintf(stderr, "kernel_launch: occupancy query says %d blocks/CU\n", per_cu); per_cu = 1; }
        (void)hipGetLastError();
        grid = cus;
    }
    if (grid < 0) return;
    if (hipMemsetAsync((char*)d_ws + WS_CTL, 0, CTL_BYTES, stream) != hipSuccess) { fprintf(stderr, "kernel_launch: hipMemsetAsync failed\n"); return; }
    Args a{};
    for (int i = 0; i < 27; ++i) a.in[i] = (const float*)d_in[i];
    a.out = (float*)d_out; a.ws = (unsigned char*)d_ws;
#if MK_ONE_LAUNCH
    a.ph_lo = 0; a.ph_hi = NPH;
    { void* args[] = {&a}; hipError_t e = hipLaunchCooperativeKernel((const void*)mega, dim3(grid), dim3(512), args, LDS_BYTES, stream);
      if (e != hipSuccess) fprintf(stderr, "cooperative launch failed: %s (grid %d)\n", hipGetErrorString(e), grid); }
#else
    for (int ph = 0; ph < NPH; ++ph) {
        a.ph_lo = ph; a.ph_hi = ph + 1;
        void* args[] = {&a}; hipError_t e = hipLaunchCooperativeKernel((const void*)mega, dim3(grid), dim3(512), args, LDS_BYTES, stream);
        if (e != hipSuccess) { fprintf(stderr, "cooperative launch %d failed: %s (grid %d)\n", ph, hipGetErrorString(e), grid); break; }
    }
#endif
}
```
